# Optimizing an MI355X kernel written in HIP

```python
import math
import jax, jax.numpy as jnp
from jax import lax
import numpy as np

D_MODEL = 2048
BATCH = 2
SEQ = 4096
DEPTH = 2

N_MIXERS = 2
HEAD_DIM = 64
ROPE_DIM = HEAD_DIM // 4
ROPE_THETA = 500000.0
ATTN_BLOCK = 128
SWA_Q_HEADS = 32
SWA_KV_HEADS = 4
SWA_WINDOW = 128
NSA_Q_HEADS = 32
NSA_KV_HEADS = 4
CMP_BLOCK = 32
CMP_STRIDE = 16
SEL_BLOCK = 64
SEL_TOPK = 16
NSA_WINDOW = 512
CMP_HIDDEN = 256
NSA_QCHUNK = 64
FORCE_BONUS = 1e4
N_GROUPS = 4
EXPERTS_PER_GROUP = 4
N_EXPERTS = N_GROUPS * EXPERTS_PER_GROUP
TOPK_IN_GROUP = 2
D_EXPERT = D_MODEL // 4
ALPHA = (2 * DEPTH) ** 0.25
BETA = (8 * DEPTH) ** -0.25
LN_EPS = 1e-5
NEG_INF = -1e30
N_SWA_LAYERS = (DEPTH + 1) // 2
N_NSA_LAYERS = DEPTH // 2
SWA_QKV_COLS = (SWA_Q_HEADS + 2 * SWA_KV_HEADS) * HEAD_DIM
NSA_IN_COLS = NSA_Q_HEADS * HEAD_DIM + 6 * NSA_KV_HEADS * HEAD_DIM + 3 * NSA_Q_HEADS

kernel_name = "hybrid_swa_nsa_hmoe_deepnorm_adaln"


def layer_norm(x, g, b):
    xf = x.astype(jnp.float32)
    mu = jnp.mean(xf, -1, keepdims=True)
    var = jnp.mean(jnp.square(xf - mu), -1, keepdims=True)
    y = (xf - mu) * lax.rsqrt(var + LN_EPS)
    return (y * g.astype(jnp.float32) + b.astype(jnp.float32)).astype(x.dtype)


def rope_tables(positions):
    inv_freq = ROPE_THETA ** (-jnp.arange(0, ROPE_DIM, 2, dtype=jnp.float32) / ROPE_DIM)
    ang = positions.astype(jnp.float32)[..., None] * inv_freq
    return jnp.cos(ang)[:, :, None, :], jnp.sin(ang)[:, :, None, :]


def apply_partial_rope(x, cos, sin):
    half = ROPE_DIM // 2
    x1 = x[..., :half].astype(jnp.float32)
    x2 = x[..., half:ROPE_DIM].astype(jnp.float32)
    rot = jnp.concatenate([x1 * cos - x2 * sin, x2 * cos + x1 * sin], -1).astype(x.dtype)
    return jnp.concatenate([rot, x[..., ROPE_DIM:]], -1)


def banded_attention(q, k, v, window, sinks=None):
    B, S, Hkv, G, D = q.shape
    n_blocks = S // ATTN_BLOCK
    halo = -(-window // ATTN_BLOCK) * ATTN_BLOCK
    span = ATTN_BLOCK + halo
    pad = ((0, 0), (halo, 0), (0, 0), (0, 0))
    kp = jnp.pad(k, pad)
    vp = jnp.pad(v, pad)
    scale = D ** -0.5

    def one_block(n):
        start = n * ATTN_BLOCK
        qb = lax.dynamic_slice_in_dim(q, start, ATTN_BLOCK, axis=1)
        kb = lax.dynamic_slice_in_dim(kp, start, span, axis=1)
        vb = lax.dynamic_slice_in_dim(vp, start, span, axis=1)
        s = jnp.einsum('bqhgd,bkhd->bhgqk', qb, kb).astype(jnp.float32) * scale
        qpos = start + jnp.arange(ATTN_BLOCK)
        kpos = start - halo + jnp.arange(span)
        rel = qpos[:, None] - kpos[None, :]
        mask = (rel >= 0) & (rel < window) & (kpos[None, :] >= 0)
        s = jnp.where(mask, s, NEG_INF)
        if sinks is not None:
            sink = jnp.broadcast_to(sinks.astype(jnp.float32)[None, :, :, None, None], s.shape[:-1] + (1,))
            p = jax.nn.softmax(jnp.concatenate([s, sink], -1), -1)[..., :-1]
        else:
            p = jax.nn.softmax(s, -1)
        return jnp.einsum('bhgqk,bkhd->bqhgd', p.astype(vb.dtype), vb)

    out = lax.map(one_block, jnp.arange(n_blocks))
    return jnp.moveaxis(out, 0, 1).reshape(B, S, Hkv, G, D)


def swa_mixer(h, cos, sin, w_qkv, b_qkv, sinks, w_o):
    B, S, _ = h.shape
    G = SWA_Q_HEADS // SWA_KV_HEADS
    qkv = h @ w_qkv + b_qkv
    q, k, v = jnp.split(qkv, [SWA_Q_HEADS * HEAD_DIM, (SWA_Q_HEADS + SWA_KV_HEADS) * HEAD_DIM], -1)
    q = apply_partial_rope(q.reshape(B, S, SWA_Q_HEADS, HEAD_DIM), cos, sin)
    k = apply_partial_rope(k.reshape(B, S, SWA_KV_HEADS, HEAD_DIM), cos, sin)
    v = v.reshape(B, S, SWA_KV_HEADS, HEAD_DIM)
    o = banded_attention(q.reshape(B, S, SWA_KV_HEADS, G, HEAD_DIM), k, v, SWA_WINDOW,
                         sinks.reshape(SWA_KV_HEADS, G))
    return o.reshape(B, S, SWA_Q_HEADS * HEAD_DIM) @ w_o


def compress_blocks(x, pe, w1, w2):
    B, S, H, D = x.shape
    chunks = x.reshape(B, S // CMP_STRIDE, CMP_STRIDE, H, D)
    blocks = jnp.concatenate([chunks[:, :-1], chunks[:, 1:]], axis=2)
    blocks = blocks + pe[None, None, :, None, :]
    n_cmp = blocks.shape[1]
    flat = jnp.moveaxis(blocks, 3, 2).reshape(B, n_cmp, H, CMP_BLOCK * D)
    return jax.nn.silu(flat @ w1) @ w2


def cmp_sel_overlap(n_cmp, n_sel):
    c0 = jnp.arange(n_cmp)[:, None] * CMP_STRIDE
    s0 = jnp.arange(n_sel)[None, :] * SEL_BLOCK
    ov = jnp.clip(jnp.minimum(c0 + CMP_BLOCK, s0 + SEL_BLOCK) - jnp.maximum(c0, s0), 0)
    return ov.astype(jnp.float32) / CMP_BLOCK


def nsa_mixer(h, cos, sin, w_in, pe_k, pe_v, phi_k1, phi_k2, phi_v1, phi_v2, w_o):
    B, S, _ = h.shape
    HQ, HKV, D = NSA_Q_HEADS, NSA_KV_HEADS, HEAD_DIM
    G = HQ // HKV
    kvw = HKV * D
    proj = h @ w_in
    q, k_c, v_c, k_s, v_s, k_w, v_w, gates = jnp.split(proj, [HQ * D + i * kvw for i in range(7)], -1)
    q = q.reshape(B, S, HQ, D)
    q_raw = q.reshape(B, S, HKV, G, D)
    q_rot = apply_partial_rope(q, cos, sin).reshape(B, S, HKV, G, D)
    shp = (B, S, HKV, D)
    k_s = apply_partial_rope(k_s.reshape(shp), cos, sin)
    k_w = apply_partial_rope(k_w.reshape(shp), cos, sin)
    v_s = v_s.reshape(shp)
    v_w = v_w.reshape(shp)
    kc = compress_blocks(k_c.reshape(shp), pe_k, phi_k1, phi_k2)
    vc = compress_blocks(v_c.reshape(shp), pe_v, phi_v1, phi_v2)
    n_cmp = kc.shape[1]
    n_sel = S // SEL_BLOCK
    top_k = min(SEL_TOPK, n_sel)
    ks_blocks = k_s.reshape(B, n_sel, SEL_BLOCK, HKV, D).transpose(0, 3, 1, 2, 4)
    vs_blocks = v_s.reshape(B, n_sel, SEL_BLOCK, HKV, D).transpose(0, 3, 1, 2, 4)
    overlap = cmp_sel_overlap(n_cmp, n_sel)
    cmp_end = jnp.arange(n_cmp) * CMP_STRIDE + CMP_BLOCK - 1
    sel_idx = jnp.arange(n_sel)
    scale = D ** -0.5
    bi = jnp.arange(B)[:, None, None, None]
    hi = jnp.arange(HKV)[None, :, None, None]

    def one_chunk(n):
        start = n * NSA_QCHUNK
        t = start + jnp.arange(NSA_QCHUNK)
        qc = lax.dynamic_slice_in_dim(q_raw, start, NSA_QCHUNK, axis=1)
        qr = lax.dynamic_slice_in_dim(q_rot, start, NSA_QCHUNK, axis=1)
        s = jnp.einsum('bthgd,bnhd->bhgtn', qc, kc).astype(jnp.float32) * scale
        valid = cmp_end[None, :] <= t[:, None]
        p = jax.nn.softmax(jnp.where(valid, s, NEG_INF), -1) * valid
        o_cmp = jnp.einsum('bhgtn,bnhd->bthgd', p.astype(vc.dtype), vc)
        imp = jnp.einsum('bhgtn,ns->bhts', p, overlap)
        cur = t[:, None] // SEL_BLOCK
        causal = sel_idx[None, :] * SEL_BLOCK <= t[:, None]
        forced = (sel_idx[None, :] == 0) | (sel_idx[None, :] == cur) | (sel_idx[None, :] == cur - 1)
        score = jnp.where(causal, imp + jnp.where(forced, FORCE_BONUS, 0.0), NEG_INF)
        _, idx = lax.top_k(score, top_k)
        ksel = ks_blocks[bi, hi, idx].reshape(B, HKV, NSA_QCHUNK, top_k * SEL_BLOCK, D)
        vsel = vs_blocks[bi, hi, idx].reshape(B, HKV, NSA_QCHUNK, top_k * SEL_BLOCK, D)
        kpos = (idx[..., None] * SEL_BLOCK + jnp.arange(SEL_BLOCK)).reshape(B, HKV, NSA_QCHUNK, top_k * SEL_BLOCK)
        m2 = (kpos <= t[:, None])[:, :, None]
        s2 = jnp.einsum('bthgd,bhtkd->bhgtk', qr, ksel).astype(jnp.float32) * scale
        p2 = jax.nn.softmax(jnp.where(m2, s2, NEG_INF), -1)
        o_sel = jnp.einsum('bhgtk,bhtkd->bthgd', p2.astype(vsel.dtype), vsel)
        return o_cmp, o_sel

    o_cmp, o_sel = lax.map(one_chunk, jnp.arange(S // NSA_QCHUNK))
    o_cmp = jnp.moveaxis(o_cmp, 0, 1).reshape(B, S, HKV, G, D)
    o_sel = jnp.moveaxis(o_sel, 0, 1).reshape(B, S, HKV, G, D)
    o_win = banded_attention(q_rot, k_w, v_w, NSA_WINDOW)
    g = jax.nn.sigmoid(gates.astype(jnp.float32)).reshape(B, S, HKV, G, 3).astype(h.dtype)
    o = g[..., 0:1] * o_cmp + g[..., 1:2] * o_sel + g[..., 2:3] * o_win
    return o.reshape(B, S, HQ * D) @ w_o


def hier_moe(h, w_group, b_group, w_router, b_router, w1, w3, w2):
    B, S, Dm = h.shape
    T = B * S
    t = h.reshape(T, Dm)
    pg = jax.nn.softmax((t @ w_group + b_group).astype(jnp.float32), -1)
    g_prob, g_idx = lax.top_k(pg, 1)
    le = (t @ w_router + b_router).astype(jnp.float32).reshape(T, N_GROUPS, EXPERTS_PER_GROUP)
    g_onehot = jax.nn.one_hot(g_idx[:, 0], N_GROUPS, dtype=jnp.float32)
    le = jnp.sum(g_onehot[:, :, None] * le, axis=1)
    pe = jax.nn.softmax(le, -1)
    e_prob, e_idx = lax.top_k(pe, TOPK_IN_GROUP)
    e_prob = e_prob / jnp.sum(e_prob, -1, keepdims=True)
    expert_id = g_idx * EXPERTS_PER_GROUP + e_idx
    weight = g_prob * e_prob
    combine = jnp.sum(jax.nn.one_hot(expert_id, N_EXPERTS, dtype=jnp.float32) * weight[..., None], axis=1)
    combine = combine.astype(t.dtype)
    y = jnp.zeros_like(t)
    for e in range(N_EXPERTS):
        he = jax.nn.silu(t @ w1[e]) * (t @ w3[e])
        y = y + combine[:, e:e + 1] * (he @ w2[e])
    return y.reshape(B, S, Dm)


def setup_inputs(seed: int = 0) -> dict:
    key = jax.random.key(seed)
    ks = jax.random.split(key, 32)
    f32 = jnp.float32
    D = D_MODEL
    nrm = lambda k, shape, s: jax.random.normal(k, shape, f32) * s
    x = nrm(ks[0], (BATCH, SEQ, D), 1.0)
    c = nrm(ks[1], (BATCH, D), 1.0)
    positions = jnp.broadcast_to(jnp.arange(SEQ, dtype=jnp.int32)[None, :], (BATCH, SEQ))
    w_ada = nrm(ks[2], (DEPTH, D, 6 * D), D ** -0.5)
    b_ada = nrm(ks[3], (DEPTH, 6 * D), 0.01)
    swa_scale = jnp.concatenate([jnp.ones(((SWA_Q_HEADS + SWA_KV_HEADS) * HEAD_DIM,), f32),
                                 jnp.full((SWA_KV_HEADS * HEAD_DIM,), BETA, f32)])
    swa_w_qkv = nrm(ks[4], (N_SWA_LAYERS, D, SWA_QKV_COLS), D ** -0.5) * swa_scale
    swa_b_qkv = nrm(ks[5], (N_SWA_LAYERS, SWA_QKV_COLS), 0.01)
    swa_sinks = nrm(ks[6], (N_SWA_LAYERS, SWA_Q_HEADS), 1.0)
    swa_w_o = nrm(ks[7], (N_SWA_LAYERS, SWA_Q_HEADS * HEAD_DIM, D), (SWA_Q_HEADS * HEAD_DIM) ** -0.5 * BETA)
    kvw = NSA_KV_HEADS * HEAD_DIM
    ones_kv = jnp.ones((kvw,), f32)
    beta_kv = jnp.full((kvw,), BETA, f32)
    nsa_scale = jnp.concatenate([jnp.ones((NSA_Q_HEADS * HEAD_DIM,), f32),
                                 ones_kv, beta_kv, ones_kv, beta_kv, ones_kv, beta_kv,
                                 jnp.ones((3 * NSA_Q_HEADS,), f32)])
    nsa_w_in = nrm(ks[8], (N_NSA_LAYERS, D, NSA_IN_COLS), D ** -0.5) * nsa_scale
    nsa_pe_k = nrm(ks[9], (N_NSA_LAYERS, CMP_BLOCK, HEAD_DIM), 0.1)
    nsa_pe_v = nrm(ks[10], (N_NSA_LAYERS, CMP_BLOCK, HEAD_DIM), 0.1)
    fan = CMP_BLOCK * HEAD_DIM
    nsa_phi_k1 = nrm(ks[11], (N_NSA_LAYERS, fan, CMP_HIDDEN), fan ** -0.5)
    nsa_phi_k2 = nrm(ks[12], (N_NSA_LAYERS, CMP_HIDDEN, HEAD_DIM), CMP_HIDDEN ** -0.5)
    nsa_phi_v1 = nrm(ks[13], (N_NSA_LAYERS, fan, CMP_HIDDEN), fan ** -0.5)
    nsa_phi_v2 = nrm(ks[14], (N_NSA_LAYERS, CMP_HIDDEN, HEAD_DIM), CMP_HIDDEN ** -0.5)
    nsa_w_o = nrm(ks[15], (N_NSA_LAYERS, NSA_Q_HEADS * HEAD_DIM, D), (NSA_Q_HEADS * HEAD_DIM) ** -0.5 * BETA)
    moe_w_group = nrm(ks[16], (DEPTH, D, N_GROUPS), D ** -0.5)
    moe_b_group = nrm(ks[17], (DEPTH, N_GROUPS), 0.01)
    moe_w_router = nrm(ks[18], (DEPTH, D, N_EXPERTS), D ** -0.5)
    moe_b_router = nrm(ks[19], (DEPTH, N_EXPERTS), 0.01)
    moe_w1 = nrm(ks[20], (DEPTH, N_EXPERTS, D, D_EXPERT), D ** -0.5)
    moe_w3 = nrm(ks[21], (DEPTH, N_EXPERTS, D, D_EXPERT), D ** -0.5)
    moe_w2 = nrm(ks[22], (DEPTH, N_EXPERTS, D_EXPERT, D), D_EXPERT ** -0.5 * BETA)
    ln_t_g = 1.0 + nrm(ks[23], (DEPTH, D), 0.01)
    ln_t_b = nrm(ks[24], (DEPTH, D), 0.01)
    ln_c_g = 1.0 + nrm(ks[25], (DEPTH, D), 0.01)
    ln_c_b = nrm(ks[26], (DEPTH, D), 0.01)
    return {"x": x, "c": c, "positions": positions, "w_ada": w_ada, "b_ada": b_ada,
            "swa_w_qkv": swa_w_qkv, "swa_b_qkv": swa_b_qkv, "swa_sinks": swa_sinks, "swa_w_o": swa_w_o,
            "nsa_w_in": nsa_w_in, "nsa_pe_k": nsa_pe_k, "nsa_pe_v": nsa_pe_v,
            "nsa_phi_k1": nsa_phi_k1, "nsa_phi_k2": nsa_phi_k2, "nsa_phi_v1": nsa_phi_v1, "nsa_phi_v2": nsa_phi_v2,
            "nsa_w_o": nsa_w_o,
            "moe_w_group": moe_w_group, "moe_b_group": moe_b_group,
            "moe_w_router": moe_w_router, "moe_b_router": moe_b_router,
            "moe_w1": moe_w1, "moe_w3": moe_w3, "moe_w2": moe_w2,
            "ln_t_g": ln_t_g, "ln_t_b": ln_t_b, "ln_c_g": ln_c_g, "ln_c_b": ln_c_b}


def reference(x, c, positions, w_ada, b_ada, swa_w_qkv, swa_b_qkv, swa_sinks, swa_w_o,
              nsa_w_in, nsa_pe_k, nsa_pe_v, nsa_phi_k1, nsa_phi_k2, nsa_phi_v1, nsa_phi_v2, nsa_w_o,
              moe_w_group, moe_b_group, moe_w_router, moe_b_router, moe_w1, moe_w3, moe_w2,
              ln_t_g, ln_t_b, ln_c_g, ln_c_b):
    cos, sin = rope_tables(positions)
    c_act = jax.nn.silu(c)
    for i in range(DEPTH):
        mod = (c_act @ w_ada[i] + b_ada[i])[:, None, :]
        sh_t, sc_t, g_t, sh_c, sc_c, g_c = jnp.split(mod, 6, -1)
        h = x * (1.0 + sc_t) + sh_t
        j = i // N_MIXERS
        if i % N_MIXERS == 0:
            out = swa_mixer(h, cos, sin, swa_w_qkv[j], swa_b_qkv[j], swa_sinks[j], swa_w_o[j])
        else:
            out = nsa_mixer(h, cos, sin, nsa_w_in[j], nsa_pe_k[j], nsa_pe_v[j], nsa_phi_k1[j], nsa_phi_k2[j],
                            nsa_phi_v1[j], nsa_phi_v2[j], nsa_w_o[j])
        x = layer_norm(ALPHA * x + g_t * out, ln_t_g[i], ln_t_b[i])
        h = x * (1.0 + sc_c) + sh_c
        out = hier_moe(h, moe_w_group[i], moe_b_group[i], moe_w_router[i], moe_b_router[i],
                       moe_w1[i], moe_w3[i], moe_w2[i])
        x = layer_norm(ALPHA * x + g_c * out, ln_c_g[i], ln_c_b[i])
    return x
```

```cpp
#include <hip/hip_runtime.h>
#include <hip/hip_bf16.h>
#include <cstdio>
#include <cstdint>
#include <cmath>
namespace pg8 {
#define PG8_LAS __attribute__((address_space(3)))
typedef unsigned short bf16_t;
typedef short bf16x8 __attribute__((ext_vector_type(8)));
typedef float f32x4 __attribute__((ext_vector_type(4)));
typedef unsigned u32x4 __attribute__((ext_vector_type(4)));
constexpr int BM = 256, BK = 64, HALF = 128, HTB = HALF * BK * 2  , STAGE_BYTES = 8 * HTB, NXCD = 8, WGM = 8;

__host__ __device__ __forceinline__ int lds_byte(int r, int c) { const int st = (r >> 4) * 2 + (c >> 5), rr = r & 15, cc = c & 31, ob = rr * 64 + cc * 2; return st * 1024 + (ob ^ (((ob >> 9) & 1) << 5)); }
__host__ __device__ __forceinline__ void stage_rc(int b, int& R, int& C) { const int st = b / 1024, sb = b % 1024, swz = sb ^ (((sb >> 9) & 1) << 5); R = (st >> 1) * 16 + swz / 64; C = (st & 1) * 32 + (swz % 64) / 2; }
__host__ __device__ __forceinline__ int perm32(int rho) { const int n = rho >> 4, i = rho & 15; return 8 * (i >> 2) + 4 * n + (i & 3); }

struct Unit { int pm, pn, pnl, nvalid; };
struct Gemm { const bf16_t* A; const bf16_t* Bt; int M, N, K; };

struct StaticOrder {
    int nM, nN, nwg, G, c;
    __host__ __device__ void init(int M, int N, int G_, int c_) { nM = M / BM; nN = N / BM; nwg = nM * nN; G = G_; c = c_; }
    __host__ __device__ bool next(int i, Unit& u) const {
        const long L = (long)i * G + c; if (L >= nwg) return false;
        int wgid = (int)L; { const int q = nwg / NXCD, r = nwg % NXCD, xcd = wgid % NXCD, off = wgid / NXCD; wgid = (xcd < r ? xcd * (q + 1) : r * (q + 1) + (xcd - r) * q) + off; }
        const int nig = WGM * nN, gid = wgid / nig, fm = gid * WGM, gsz = (nM - fm) < WGM ? (nM - fm) : WGM;
        u.pm = fm + ((wgid % nig) % gsz); u.pn = (wgid % nig) / gsz; return true;
    }
    __device__ __forceinline__ void a_ready(const Unit&) const {}
    __device__ __forceinline__ void done(const Unit&) const {}
};
__device__ __forceinline__ unsigned cvt_pk_bf16(float lo, float hi) { unsigned r; asm volatile("v_cvt_pk_bf16_f32 %0, %1, %2" : "=v"(r) : "v"(lo), "v"(hi)); return r; }
typedef float f32x2 __attribute__((ext_vector_type(2)));
typedef unsigned u32x2 __attribute__((ext_vector_type(2)));
__device__ __forceinline__ float silu_f(float a) { return a * __builtin_amdgcn_rcpf(1.0f + __builtin_amdgcn_exp2f(-1.4426950408889634f * a)); }
__device__ __forceinline__ float sigmoid_f(float a) { return __builtin_amdgcn_rcpf(1.0f + __builtin_amdgcn_exp2f(-1.4426950408889634f * a)); }
__device__ __forceinline__ u32x4 pack8(const f32x4& a, const f32x4& b) { u32x4 w; w.x = cvt_pk_bf16(a[0], a[1]); w.y = cvt_pk_bf16(a[2], a[3]); w.z = cvt_pk_bf16(b[0], b[1]); w.w = cvt_pk_bf16(b[2], b[3]); return w; }
__device__ __forceinline__ unsigned short bf1(float v) { return (unsigned short)(cvt_pk_bf16(v, 0.f) & 0xffffu); }

__device__ __forceinline__ void rope8(f32x4& v0, f32x4& v1, const float* ropeRow, int fq) {
    f32x4 p0, p1;
#pragma unroll
    for (int i = 0; i < 4; ++i) { p0[i] = __shfl_xor(v0[i], 16); p1[i] = __shfl_xor(v1[i], 16); }
    if (fq < 2) {
        const f32x4 c0 = *(const f32x4*)(ropeRow), c1 = *(const f32x4*)(ropeRow + 4), s0 = *(const f32x4*)(ropeRow + 8), s1 = *(const f32x4*)(ropeRow + 12);
        const float sg = fq == 0 ? -1.f : 1.f;
        v0 = v0 * c0 + (p0 * s0) * sg; v1 = v1 * c1 + (p1 * s1) * sg;
    }
}
__device__ __forceinline__ void store_vt8(bf16_t* VT, int b, int hk, int d0, int s, const f32x4& v0, const f32x4& v1) {
    bf16_t* p = VT + ((size_t)((b * 4 + hk) * 64 + d0)) * 4096 + s;
#pragma unroll
    for (int i = 0; i < 4; ++i) { p[(size_t)i * 4096] = bf1(v0[i]); p[(size_t)(i + 4) * 4096] = bf1(v1[i]); }
}

struct EpiQKV {
    static constexpr bool PERM = true, AFTER_DRAIN = false;
    bf16_t* Q; bf16_t* K; bf16_t* VT; const float* bias; const float* rope; float qscale;
    __device__ __forceinline__ void operator()(const f32x4 (&acc)[2][2][4][2], const Unit& u, int wr, int wc, int fr, int fq) const {
        const int pn = u.pn; const bool rot = (pn <= 8) && ((wc & 1) == 0);
        f32x4 bv[2][2];
#pragma unroll
        for (int bj = 0; bj < 2; ++bj)
#pragma unroll
            for (int n = 0; n < 2; ++n) bv[bj][n] = *(const f32x4*)(bias + pn * BM + bj * HALF + wc * 32 + 8 * fq + 4 * n);
#pragma unroll
        for (int ai = 0; ai < 2; ++ai)
#pragma unroll
            for (int m = 0; m < 4; ++m) {
                const int row = u.pm * BM + ai * HALF + wr * 64 + m * 16 + fr, b = row >> 12, s = row & 4095;
#pragma unroll
                for (int bj = 0; bj < 2; ++bj) {
                    const int col = bj * HALF + wc * 32 + 8 * fq;
                    f32x4 v0 = acc[ai][bj][m][0] + bv[bj][0], v1 = acc[ai][bj][m][1] + bv[bj][1];
                    if (rot) rope8(v0, v1, rope + (size_t)row * 16, fq);
                    if (pn < 8) { v0 = v0 * qscale; v1 = v1 * qscale; *(u32x4*)(Q + (size_t)row * 2048 + pn * BM + col) = pack8(v0, v1); }
                    else if (pn == 8) { *(u32x4*)(K + ((size_t)((b * 4 + (col >> 6)) * 4096 + s)) * 64 + (col & 63)) = pack8(v0, v1); }
                    else store_vt8(VT, b, col >> 6, col & 63, s, v0, v1);
                }
            }
    }
};
struct EpiNSA {
    static constexpr bool PERM = true, AFTER_DRAIN = false;
    bf16_t *QRAW, *QROT, *KC, *VC, *KS, *VST, *KW, *VWT; float* GATES; const float* rope; float qscale;
    __device__ __forceinline__ void operator()(const f32x4 (&acc)[2][2][4][2], const Unit& u, int wr, int wc, int fr, int fq) const {
        const int pn = u.pn; const bool rot = (pn < 8 || pn == 10 || pn == 12) && ((wc & 1) == 0);
#pragma unroll
        for (int ai = 0; ai < 2; ++ai)
#pragma unroll
            for (int m = 0; m < 4; ++m) {
                const int row = u.pm * BM + ai * HALF + wr * 64 + m * 16 + fr, b = row >> 12, s = row & 4095;
#pragma unroll
                for (int bj = 0; bj < 2; ++bj) {
                    const int col = bj * HALF + wc * 32 + 8 * fq;
                    f32x4 v0 = acc[ai][bj][m][0], v1 = acc[ai][bj][m][1];
                    if (pn < 8) { *(u32x4*)(QRAW + (size_t)row * 2048 + pn * BM + col) = pack8(v0 * qscale, v1 * qscale); }
                    if (rot) rope8(v0, v1, rope + (size_t)row * 16, fq);
                    if (pn < 8) { *(u32x4*)(QROT + (size_t)row * 2048 + pn * BM + col) = pack8(v0 * qscale, v1 * qscale); }
                    else if (pn == 8 || pn == 9 || pn == 10 || pn == 12) {
                        bf16_t* dst = pn == 8 ? KC : pn == 9 ? VC : pn == 10 ? KS : KW;
                        *(u32x4*)(dst + ((size_t)((b * 4 + (col >> 6)) * 4096 + s)) * 64 + (col & 63)) = pack8(v0, v1); }
                    else if (pn == 11 || pn == 13) store_vt8(pn == 11 ? VST : VWT, b, col >> 6, col & 63, s, v0, v1);
                    else if (col < 96) {
                        f32x4 g0, g1;
#pragma unroll
                        for (int i = 0; i < 4; ++i) { g0[i] = sigmoid_f(v0[i]); g1[i] = sigmoid_f(v1[i]); }
                        *(f32x4*)(GATES + (size_t)row * 96 + col) = g0; *(f32x4*)(GATES + (size_t)row * 96 + col + 4) = g1; }
                }
            }
    }
};
struct EpiWoRes {
    static constexpr bool PERM = false, AFTER_DRAIN = false;
    const float* x; const float* gate; int gstride; float* Y; float alpha;
    __device__ __forceinline__ void operator()(const f32x4 (&acc)[2][2][4][2], const Unit& u, int wr, int wc, int fr, int fq) const {
        const int b = (u.pm * BM) >> 12; const int col0 = u.pn * BM + wc * 32 + 4 * fq;
        f32x4 gv[2][2];
#pragma unroll
        for (int bj = 0; bj < 2; ++bj)
#pragma unroll
            for (int n = 0; n < 2; ++n) gv[bj][n] = *(const f32x4*)(gate + (size_t)b * gstride + col0 + bj * HALF + n * 16);
#pragma unroll
        for (int ai = 0; ai < 2; ++ai)
#pragma unroll
            for (int m = 0; m < 4; ++m) { const size_t off = (size_t)(u.pm * BM + ai * HALF + wr * 64 + m * 16 + fr) * 2048 + col0;
#pragma unroll
                for (int bj = 0; bj < 2; ++bj)
#pragma unroll
                    for (int n = 0; n < 2; ++n) { const f32x4 xs = *(const f32x4*)(x + off + bj * HALF + n * 16);
                        *(f32x4*)(Y + off + bj * HALF + n * 16) = xs * alpha + gv[bj][n] * acc[ai][bj][m][n]; }
                if (m & 1) asm volatile("" ::: "memory"); }
    }
};
struct EpiF32 {
    static constexpr bool PERM = false, AFTER_DRAIN = false;
    float* O; int ldc;
    __device__ __forceinline__ void operator()(const f32x4 (&acc)[2][2][4][2], const Unit& u, int wr, int wc, int fr, int fq) const {
        const int col0 = u.pn * BM + wc * 32 + 4 * fq;
#pragma unroll
        for (int ai = 0; ai < 2; ++ai)
#pragma unroll
            for (int m = 0; m < 4; ++m) { const size_t off = (size_t)(u.pm * BM + ai * HALF + wr * 64 + m * 16 + fr) * ldc + col0;
#pragma unroll
                for (int bj = 0; bj < 2; ++bj)
#pragma unroll
                    for (int n = 0; n < 2; ++n) *(f32x4*)(O + off + bj * HALF + n * 16) = acc[ai][bj][m][n]; }
    }
};
struct EpiUp {
    static constexpr bool PERM = true, AFTER_DRAIN = false;
    bf16_t* HE;
    __device__ __forceinline__ void operator()(const f32x4 (&acc)[2][2][4][2], const Unit& u, int wr, int wc, int fr, int fq) const {
#pragma unroll
        for (int ai = 0; ai < 2; ++ai)
#pragma unroll
            for (int m = 0; m < 4; ++m) { const int row = u.pm * BM + ai * HALF + wr * 64 + m * 16 + fr; f32x4 h[2];
#pragma unroll
                for (int n = 0; n < 2; ++n)
#pragma unroll
                    for (int i = 0; i < 4; ++i) h[n][i] = silu_f(acc[ai][0][m][n][i]) * acc[ai][1][m][n][i];
                *(u32x4*)(HE + (size_t)row * 512 + u.pnl * HALF + wc * 32 + 8 * fq) = pack8(h[0], h[1]); }
    }
};
struct EpiDown {
    static constexpr bool PERM = true, AFTER_DRAIN = false;
    bf16_t* YS; const int* rowtok; const float* roww;
    __device__ __forceinline__ void operator()(const f32x4 (&acc)[2][2][4][2], const Unit& u, int wr, int wc, int fr, int fq) const {
#pragma unroll
        for (int ai = 0; ai < 2; ++ai)
#pragma unroll
            for (int m = 0; m < 4; ++m) { const int lrow = ai * HALF + wr * 64 + m * 16 + fr;
                if (lrow < u.nvalid) { const int grow = u.pm * BM + lrow; const int tk = rowtok[grow]; const float w = roww[grow];
#pragma unroll
                    for (int bj = 0; bj < 2; ++bj)
                        *(u32x4*)(YS + (size_t)tk * 2048 + u.pnl * BM + bj * HALF + wc * 32 + 8 * fq) = pack8(acc[ai][bj][m][0] * w, acc[ai][bj][m][1] * w); } }
    }
};
struct GroupOrder {
    unsigned cnt[16]; int nT, nN, G, c;
    __device__ __forceinline__ bool next(int i, Unit& u) const {
        const int nwg = nT * nN, L = i * G + c; if (L >= nwg) return false;
        const int q = nwg / 8, r = nwg % 8, xcd = L % 8, off = L / 8; const int wgid = (xcd < r ? xcd * (q + 1) : r * (q + 1) + (xcd - r) * q) + off;
        const int pm = wgid / nN, pnl = wgid % nN; int run = 0, ee = 0, nv = 0;
#pragma unroll
        for (int e = 0; e < 16; ++e) { const int te = (int)((cnt[e] + 255u) >> 8); if (pm >= run && pm < run + te) { ee = e; const int left = (int)cnt[e] - (pm - run) * 256; nv = left < 256 ? left : 256; } run += te; }
        u.pm = pm; u.pn = ee * nN + pnl; u.pnl = pnl; u.nvalid = nv; return true;
    }
    __device__ __forceinline__ void a_ready(const Unit&) const {}
    __device__ __forceinline__ void done(const Unit&) const {}
};
template <class Epi, class Sched, bool ALIGN_EPI = false, bool SP2 = false>
__device__ __forceinline__ void gemm_phase(PG8_LAS unsigned char* lds, const Gemm g, const Sched& S, const Epi& E) {
    int tid_ = threadIdx.x; asm volatile("" : "+v"(tid_)); const int tid = tid_, wid = __builtin_amdgcn_readfirstlane(tid >> 6), lane = tid & 63, wr = wid >> 2, wc = wid & 3, fr = lane & 15, fq = lane >> 4;
    const int K = g.K, nt = K / BK;
    unsigned voffA[2], voffB[2];
#pragma unroll
    for (int i = 0; i < 2; ++i) { int R, C; stage_rc(tid * 16 + i * 8192, R, C); const int Rb = Epi::PERM ? ((R & ~31) + perm32(R & 31)) : R;
        voffA[i] = (unsigned)(R * K + C) * 2u; voffB[i] = (unsigned)(Rb * K + C) * 2u; }
    const size_t kstep = (size_t)(BK * 2);
    const size_t hstep = (size_t)HALF * K * 2;
    const size_t tstep = 2 * hstep;
    const unsigned ldsw = (unsigned)wid * 1024u;
    const int aoff = lds_byte(wr * 64 + fr, fq * 8), boff = lds_byte(wc * 32 + fr, fq * 8);
#define PG8_SA(b, h) (((b) * 2 + (h)) * HTB)
#define PG8_SB(b, h) ((4 + (b) * 2 + (h)) * HTB)
#define PG8_STAGE(bufoff, gbase, voff) do { _Pragma("unroll") for (int _i = 0; _i < 2; ++_i) \
        __builtin_amdgcn_global_load_lds((const unsigned*)((const char*)(gbase) + (voff)[_i]), (PG8_LAS unsigned*)(lds + (bufoff) + ldsw + _i * 8192), 16, 0, 0); } while (0)
#define PG8_LDA(dst, b, h) do { _Pragma("unroll") for (int m = 0; m < 4; ++m) _Pragma("unroll") for (int k = 0; k < 2; ++k) dst[m][k] = *(const PG8_LAS bf16x8*)(lds + PG8_SA(b, h) + aoff + m * 2048 + k * 1024); } while (0)
#define PG8_LDB(dst, b, h) do { _Pragma("unroll") for (int n = 0; n < 2; ++n) _Pragma("unroll") for (int k = 0; k < 2; ++k) dst[n][k] = *(const PG8_LAS bf16x8*)(lds + PG8_SB(b, h) + boff + n * 2048 + k * 1024); } while (0)
#define PG8_MMA(ai, bj, At, Bt) do { __builtin_amdgcn_s_setprio(1); _Pragma("unroll") for (int m = 0; m < 4; ++m) _Pragma("unroll") for (int n = 0; n < 2; ++n) _Pragma("unroll") for (int k = 0; k < 2; ++k) \
        acc[ai][bj][m][n] = __builtin_amdgcn_mfma_f32_16x16x32_bf16(Bt[n][k], At[m][k], acc[ai][bj][m][n], 0, 0, 0); __builtin_amdgcn_s_setprio(0); } while (0)
#define PG8_WAIT_V(n) asm volatile("s_waitcnt vmcnt(" #n ")" ::: "memory")
#define PG8_WAIT_L(n) asm volatile("s_waitcnt lgkmcnt(" #n ")" ::: "memory")
#define PG8_BAR __builtin_amdgcn_s_barrier()
#define PG8_SCHED __builtin_amdgcn_sched_barrier(0)
    Unit cur, nxt; int ui = 0;
    if (!S.next(0, cur)) return;
    f32x4 acc[2][2][4][2];
#pragma unroll
    for (int a = 0; a < 2; ++a)
#pragma unroll
        for (int b = 0; b < 2; ++b)
#pragma unroll
            for (int m = 0; m < 4; ++m)
#pragma unroll
                for (int n = 0; n < 2; ++n) acc[a][b][m][n] = (f32x4){0.f, 0.f, 0.f, 0.f};
    bf16x8 At[4][2], B0[2][2], B1[2][2];
    const char* cA = (const char*)g.A + (size_t)cur.pm * tstep; const char* cB = (const char*)g.Bt + (size_t)cur.pn * tstep;
    S.a_ready(cur);
    if constexpr (SP2) {
        PG8_STAGE(PG8_SB(0, 0), cB, voffB); PG8_STAGE(PG8_SB(0, 1), cB + hstep, voffB); PG8_STAGE(PG8_SA(0, 0), cA, voffA); PG8_STAGE(PG8_SA(0, 1), cA + hstep, voffA);
        if (wr == 1) PG8_BAR;
        PG8_WAIT_V(2); PG8_BAR;
        PG8_STAGE(PG8_SB(1, 0), cB + kstep, voffB); PG8_STAGE(PG8_SA(1, 0), cA + kstep, voffA); PG8_STAGE(PG8_SB(1, 1), cB + hstep + kstep, voffB);
        PG8_WAIT_V(6); PG8_BAR;
    } else {
        PG8_STAGE(PG8_SB(0, 0), cB, voffB); PG8_STAGE(PG8_SA(0, 0), cA, voffA); PG8_STAGE(PG8_SB(0, 1), cB + hstep, voffB); PG8_STAGE(PG8_SA(0, 1), cA + hstep, voffA);
        if (wr == 1) PG8_BAR;
        PG8_WAIT_V(4); PG8_BAR;
        PG8_STAGE(PG8_SB(1, 0), cB + kstep, voffB); PG8_STAGE(PG8_SA(1, 0), cA + kstep, voffA); PG8_STAGE(PG8_SB(1, 1), cB + hstep + kstep, voffB);
        PG8_WAIT_V(6); PG8_BAR;
    }
    for (;;) {
        const bool has_next = S.next(ui + 1, nxt);
        const char* nA = has_next ? (const char*)g.A + (size_t)nxt.pm * tstep : cA; const char* nB = has_next ? (const char*)g.Bt + (size_t)nxt.pn * tstep : cB;
        for (int t = 0; t < nt; t += 2) {
            const bool last = (t == nt - 2);
            const char* a1 = cA + (size_t)(t + 1) * kstep;
            const char* a2 = last ? nA : cA + (size_t)(t + 2) * kstep; const char* b2 = last ? nB : cB + (size_t)(t + 2) * kstep;
            const char* a3 = a2 + kstep; const char* b3 = b2 + kstep;
            if (last && has_next) S.a_ready(nxt);
            if constexpr (SP2) {
            PG8_LDB(B0, 0, 0); PG8_LDB(B1, 0, 1); PG8_SCHED; PG8_LDA(At, 0, 0); PG8_STAGE(PG8_SA(1, 1), a1 + hstep, voffA);
            PG8_WAIT_V(8); PG8_WAIT_L(0); PG8_BAR; PG8_MMA(0, 0, At, B0); PG8_MMA(0, 1, At, B1); PG8_BAR; PG8_SCHED;
            PG8_LDA(At, 0, 1); PG8_STAGE(PG8_SB(0, 0), b2, voffB); PG8_STAGE(PG8_SB(0, 1), b2 + hstep, voffB); PG8_STAGE(PG8_SA(0, 0), a2, voffA);
            PG8_WAIT_V(8); PG8_WAIT_L(0); PG8_BAR; PG8_MMA(1, 0, At, B0); PG8_MMA(1, 1, At, B1); PG8_BAR; PG8_SCHED;
            PG8_LDB(B0, 1, 0); PG8_LDB(B1, 1, 1); PG8_SCHED; PG8_LDA(At, 1, 0); PG8_STAGE(PG8_SA(0, 1), a2 + hstep, voffA);
            PG8_WAIT_V(8); PG8_WAIT_L(0); PG8_BAR; PG8_MMA(0, 0, At, B0); PG8_MMA(0, 1, At, B1); PG8_BAR; PG8_SCHED;
            PG8_LDA(At, 1, 1); PG8_STAGE(PG8_SB(1, 0), b3, voffB); PG8_STAGE(PG8_SB(1, 1), b3 + hstep, voffB); PG8_STAGE(PG8_SA(1, 0), a3, voffA);
            PG8_WAIT_V(8); PG8_WAIT_L(0); PG8_BAR; PG8_MMA(1, 0, At, B0); PG8_MMA(1, 1, At, B1); PG8_BAR; PG8_SCHED;
            } else {
            PG8_LDB(B0, 0, 0); PG8_SCHED; PG8_LDA(At, 0, 0); PG8_STAGE(PG8_SA(1, 1), a1 + hstep, voffA);
            PG8_WAIT_L(8); PG8_BAR; PG8_WAIT_L(0); PG8_MMA(0, 0, At, B0); PG8_BAR; PG8_SCHED;
            PG8_LDB(B1, 0, 1); PG8_STAGE(PG8_SB(0, 0), b2, voffB);
            PG8_BAR; PG8_WAIT_L(0); PG8_MMA(0, 1, At, B1); PG8_BAR;
            PG8_LDA(At, 0, 1); PG8_STAGE(PG8_SA(0, 0), a2, voffA);
            PG8_BAR; PG8_WAIT_L(0); PG8_MMA(1, 0, At, B0); PG8_BAR; PG8_SCHED;
            PG8_STAGE(PG8_SB(0, 1), b2 + hstep, voffB);
            PG8_WAIT_V(6); PG8_BAR; PG8_MMA(1, 1, At, B1); PG8_BAR;
            PG8_LDB(B0, 1, 0); PG8_SCHED; PG8_LDA(At, 1, 0); PG8_STAGE(PG8_SA(0, 1), a2 + hstep, voffA);
            PG8_WAIT_L(8); PG8_BAR; PG8_WAIT_L(0); PG8_MMA(0, 0, At, B0); PG8_BAR; PG8_SCHED;
            PG8_LDB(B1, 1, 1); PG8_STAGE(PG8_SB(1, 0), b3, voffB);
            PG8_BAR; PG8_WAIT_L(0); PG8_MMA(0, 1, At, B1); PG8_BAR;
            PG8_LDA(At, 1, 1); PG8_STAGE(PG8_SA(1, 0), a3, voffA);
            PG8_BAR; PG8_WAIT_L(0); PG8_MMA(1, 0, At, B0); PG8_BAR; PG8_SCHED;
            PG8_STAGE(PG8_SB(1, 1), b3 + hstep, voffB);
            PG8_WAIT_V(6); PG8_BAR; PG8_MMA(1, 1, At, B1); PG8_BAR;
            }
        }
        if constexpr (ALIGN_EPI) { if (wr == 0) PG8_BAR; }
        if constexpr (!Epi::AFTER_DRAIN) { E(acc, cur, wr, wc, fr, fq); S.done(cur); }
        if (!has_next) break;
#pragma unroll
        for (int a = 0; a < 2; ++a)
#pragma unroll
            for (int b = 0; b < 2; ++b)
#pragma unroll
                for (int m = 0; m < 4; ++m)
#pragma unroll
                    for (int n = 0; n < 2; ++n) acc[a][b][m][n] = (f32x4){0.f, 0.f, 0.f, 0.f};
        cur = nxt; cA = nA; cB = nB; ++ui;
        if constexpr (ALIGN_EPI) { if (wr == 1) PG8_BAR; }
    }
    PG8_WAIT_V(0);
    if constexpr (!ALIGN_EPI) { if (wr == 0) PG8_BAR; }
    PG8_BAR;
    if constexpr (Epi::AFTER_DRAIN) { E.fused(acc, cur, wr, wc, fr, fq, lds, wid, lane); S.done(cur); }
#undef PG8_SA
#undef PG8_SB
#undef PG8_STAGE
#undef PG8_LDA
#undef PG8_LDB
#undef PG8_MMA
#undef PG8_WAIT_V
#undef PG8_WAIT_L
#undef PG8_BAR
#undef PG8_SCHED
}
}
#define GAS __attribute__((address_space(1)))
#define LAS __attribute__((address_space(3)))
typedef unsigned short bf16;
typedef unsigned v4u __attribute__((ext_vector_type(4)));
typedef float f32x4 __attribute__((ext_vector_type(4)));
typedef short bf16x8 __attribute__((ext_vector_type(8)));
typedef GAS unsigned gu32;
typedef GAS unsigned long long gu64;
#define RLX_AGENT __ATOMIC_RELAXED, __HIP_MEMORY_SCOPE_AGENT
#define LDS_WAIT() asm volatile("s_waitcnt lgkmcnt(0)" ::: "memory")
#define VM_WAIT() asm volatile("s_waitcnt vmcnt(0)" ::: "memory")
__device__ __forceinline__ unsigned long long rt() { return __builtin_amdgcn_s_memrealtime(); }
__device__ __forceinline__ unsigned f2bf(float f) { unsigned u = __builtin_bit_cast(unsigned, f); return (u + 0x7fffu + ((u >> 16) & 1u)) >> 16; }
__device__ __forceinline__ unsigned pk2(float lo, float hi) { return f2bf(lo) | (f2bf(hi) << 16); }
#define XB_TMO      128
#define XB_XCNT(j)  (256  + 64 * (j))
#define XB_XSUB(j)  (1280 + 64 * (j))
#define XB_XGEN(j)  (2304 + 64 * (j))
#define XB_TOP      3328
#define XB_TOPGEN   3392
#define XCD_BAR_WORDS 3456
#define XB_SPIN_CAP (1u << 18)

__device__ __forceinline__ unsigned xb_ld(unsigned* p)              { return __hip_atomic_load(p, __ATOMIC_RELAXED, __HIP_MEMORY_SCOPE_AGENT); }
__device__ __forceinline__ unsigned xb_add(unsigned* p, unsigned v) { return __hip_atomic_fetch_add(p, v, __ATOMIC_RELAXED, __HIP_MEMORY_SCOPE_AGENT); }
__device__ __forceinline__ unsigned xb_xcc_id() { return (unsigned)__builtin_amdgcn_s_getreg((3 << 11) | 20) & 0xFu; }
#define XB_SPIN(cond, bar) do { unsigned _sp = 0; while (cond) { __builtin_amdgcn_s_sleep(1); \
    if ((++_sp & 255u) == 0u) { if (xb_ld(&(bar)[XB_TMO])) break; if (_sp > XB_SPIN_CAP) { atomicAdd(&(bar)[XB_TMO], 1u); break; } } } } while (0)

struct XcdBarrier {
    unsigned* bar; unsigned x;
    volatile LAS unsigned* st;
};

__device__ __forceinline__ XcdBarrier xcd_barrier_post(unsigned* bar, volatile LAS unsigned* st) {
    XcdBarrier b; b.bar = bar; b.x = xb_xcc_id(); b.st = st;
    if (threadIdx.x == 0) (void)xb_add(&bar[XB_XCNT(b.x)], 1u);
    return b;
}
__device__ __forceinline__ void xcd_barrier_complete(unsigned* bar, unsigned x, unsigned& nloc, unsigned& nx) {
    const unsigned G = gridDim.x * gridDim.y * gridDim.z;
    unsigned sum, cnt, mine, sp = 0u;
    for (;;) {
        sum = 0u; cnt = 0u; mine = 0u;
#pragma unroll
        for (unsigned j = 0; j < 16; ++j) { const unsigned c = xb_ld(&bar[XB_XCNT(j)]); sum += c; cnt += (c > 0u) ? 1u : 0u; mine = (j == x) ? c : mine; }
        if (sum == G) break;
        __builtin_amdgcn_s_sleep(1);
        if ((++sp & 255u) == 0u) { if (xb_ld(&bar[XB_TMO])) break; if (sp > XB_SPIN_CAP) { atomicAdd(&bar[XB_TMO], 1u); break; } }
    }
    nloc = mine > 0u ? mine : 1u; nx = cnt > 0u ? cnt : 1u;
}

__device__ __forceinline__ void xcd_barrier(const XcdBarrier& b) {
    asm volatile("s_waitcnt vmcnt(0)" ::: "memory");
    __syncthreads();
    if (threadIdx.x == 0) {
        unsigned* bar = b.bar;
        __builtin_amdgcn_s_waitcnt(0);
        unsigned nloc = b.st[0], nx = b.st[1];
        if (nloc == 0u) { xcd_barrier_complete(bar, b.x, nloc, nx); b.st[0] = nloc; b.st[1] = nx; }
        const unsigned old = xb_add(&bar[XB_XSUB(b.x)], 1u);
        const unsigned gen = old / nloc;
        if (old + 1u == (gen + 1u) * nloc) {
            __builtin_amdgcn_fence(__ATOMIC_RELEASE, "agent");
            asm volatile("s_waitcnt vmcnt(0)" ::: "memory");
            const unsigned og = xb_add(&bar[XB_TOP], 1u);
            const unsigned tg = og / nx;
            if (og + 1u == (tg + 1u) * nx) xb_add(&bar[XB_TOPGEN], 1u);
            else XB_SPIN(xb_ld(&bar[XB_TOPGEN]) == tg, bar);
            __builtin_amdgcn_fence(__ATOMIC_ACQUIRE, "agent");
            xb_add(&bar[XB_XGEN(b.x)], 1u);
            asm volatile("s_waitcnt vmcnt(0)" ::: "memory");
        } else {
            XB_SPIN(xb_ld(&bar[XB_XGEN(b.x)]) == gen, bar);
            __builtin_amdgcn_fence(__ATOMIC_ACQUIRE, "agent");
            asm volatile("s_waitcnt vmcnt(0)" ::: "memory");
        }
    }
    __syncthreads();
}
namespace fa {
typedef short bf16x8 __attribute__((ext_vector_type(8)));
typedef float f32x16 __attribute__((ext_vector_type(16)));
typedef float f32x2_t __attribute__((ext_vector_type(2))); typedef __bf16 bf16x2_t __attribute__((ext_vector_type(2)));
typedef unsigned u32x4 __attribute__((ext_vector_type(4)));
typedef unsigned u32x2 __attribute__((ext_vector_type(2)));
__device__ __forceinline__ unsigned cvtpk(float lo, float hi) { f32x2_t v = {lo, hi}; bf16x2_t b = __builtin_convertvector(v, bf16x2_t); return __builtin_bit_cast(unsigned, b); }
__device__ __forceinline__ int kap(int r32) { return (r32 & ~12) | ((r32 & 4) << 1) | ((r32 & 8) >> 1); }
__device__ __forceinline__ float xmax(float v) { auto rr = __builtin_amdgcn_permlane32_swap(__float_as_uint(v), __float_as_uint(v), false, false); return fmaxf(__uint_as_float(rr[0]), __uint_as_float(rr[1])); }
__device__ __forceinline__ float xsum(float v) { auto rr = __builtin_amdgcn_permlane32_swap(__float_as_uint(v), __float_as_uint(v), false, false); return __uint_as_float(rr[0]) + __uint_as_float(rr[1]); }
constexpr float NEGBIG = -1e30f;

struct Frag { bf16x8 k[4]; bf16x8 v[4]; };
struct State { f32x16 o0, o1; float m, l; };

__device__ __forceinline__ void load_tile(Frag& f, const bf16* Kbh, const bf16* Vbh, int VP, int key0, int r32, int hi) {
    const bf16* kp = Kbh + (size_t)(key0 + kap(r32)) * 64 + hi * 8;
#pragma unroll
    for (int d0 = 0; d0 < 4; ++d0) f.k[d0] = *(const bf16x8*)(kp + d0 * 16);
    const bf16* vp = Vbh + (size_t)r32 * VP + key0 + hi * 8;
#pragma unroll
    for (int db = 0; db < 2; ++db)
#pragma unroll
        for (int s = 0; s < 2; ++s) f.v[db * 2 + s] = *(const bf16x8*)(vp + (size_t)db * 32 * VP + s * 16);
}
__device__ __forceinline__ void scores(f32x16& p, const Frag& f, const bf16x8 (&qr)[4]) {
    p = f32x16{};
#pragma unroll
    for (int d0 = 0; d0 < 4; ++d0) p = __builtin_amdgcn_mfma_f32_32x32x16_bf16(f.k[d0], qr[d0], p, 0, 0, 0);
}
__device__ __forceinline__ void mask_range(f32x16& p, int key0, int hi, int lo, int hi_) {
#pragma unroll
    for (int r = 0; r < 16; ++r) { const int kpos = key0 + 16 * (r >> 3) + 8 * hi + (r & 7); p[r] = (kpos >= lo && kpos <= hi_) ? p[r] : -INFINITY; }
}
__device__ __forceinline__ void step(State& st, const Frag& f, const bf16x8 (&qr)[4], int key0, int hi, bool need_mask, int lo, int hi_) {
    f32x16 p; scores(p, f, qr);
    if (need_mask) mask_range(p, key0, hi, lo, hi_);
    float tm = fmaxf(p[0], p[1]);
#pragma unroll
    for (int r = 2; r < 16; ++r) tm = fmaxf(tm, p[r]);
    tm = xmax(tm);
    const float mn = fmaxf(st.m, tm); const float alpha = __builtin_amdgcn_exp2f(st.m - mn); st.m = mn;
    float rs = 0.f;
#pragma unroll
    for (int r = 0; r < 16; ++r) { p[r] = __builtin_amdgcn_exp2f(p[r] - mn); rs += p[r]; }
    st.l = st.l * alpha + rs;
    if (!__all(alpha == 1.0f)) { st.o0 = st.o0 * alpha; st.o1 = st.o1 * alpha; }
    u32x4 w0, w1;
    w0.x = cvtpk(p[0], p[1]); w0.y = cvtpk(p[2], p[3]); w0.z = cvtpk(p[4], p[5]); w0.w = cvtpk(p[6], p[7]);
    w1.x = cvtpk(p[8], p[9]); w1.y = cvtpk(p[10], p[11]); w1.z = cvtpk(p[12], p[13]); w1.w = cvtpk(p[14], p[15]);
    const bf16x8 pb0 = __builtin_bit_cast(bf16x8, w0), pb1 = __builtin_bit_cast(bf16x8, w1);
    st.o0 = __builtin_amdgcn_mfma_f32_32x32x16_bf16(f.v[0], pb0, st.o0, 0, 0, 0);
    st.o0 = __builtin_amdgcn_mfma_f32_32x32x16_bf16(f.v[1], pb1, st.o0, 0, 0, 0);
    st.o1 = __builtin_amdgcn_mfma_f32_32x32x16_bf16(f.v[2], pb0, st.o1, 0, 0, 0);
    st.o1 = __builtin_amdgcn_mfma_f32_32x32x16_bf16(f.v[3], pb1, st.o1, 0, 0, 0);
}
__device__ __forceinline__ void load_q(bf16x8 (&qr)[4], const bf16* Qrow  , int hi) {
#pragma unroll
    for (int d0 = 0; d0 < 4; ++d0) qr[d0] = *(const bf16x8*)(Qrow + d0 * 16 + hi * 8);
}
__device__ __forceinline__ float finish(State& st) { const float lt = xsum(st.l); return lt > 0.f ? 1.0f / lt : 0.f; }
__device__ __forceinline__ void store_o(const State& st, float inv, bf16* Orow  , int hi) {
#pragma unroll
    for (int g = 0; g < 4; ++g) {
        u32x2 a, b; a.x = cvtpk(st.o0[4 * g] * inv, st.o0[4 * g + 1] * inv); a.y = cvtpk(st.o0[4 * g + 2] * inv, st.o0[4 * g + 3] * inv);
        b.x = cvtpk(st.o1[4 * g] * inv, st.o1[4 * g + 1] * inv); b.y = cvtpk(st.o1[4 * g + 2] * inv, st.o1[4 * g + 3] * inv);
        *(u32x2*)(Orow + 8 * g + 4 * hi) = a; *(u32x2*)(Orow + 32 + 8 * g + 4 * hi) = b; }
}
__device__ __forceinline__ float bflo(unsigned w) { return __uint_as_float(w << 16); }
__device__ __forceinline__ float bfhi(unsigned w) { return __uint_as_float(w & 0xffff0000u); }
}
constexpr int NWAVES = 8;
constexpr int NB = 2, SEQ = 4096, DM = 2048, NTOK = NB * SEQ, NEXP = 16, DEXP = 512;
constexpr float ALPHA_RES = 1.4142135623730951f;
constexpr float LN_EPS = 1e-5f;
constexpr float QSCALE = 0.125f * 1.4426950408889634f;
constexpr float LOG2E = 1.4426950408889634f;
constexpr int NPHASE = 21;
#ifndef MK_N_LAUNCHES
#define MK_N_LAUNCHES 1
#endif
constexpr int N_LAUNCHES = MK_N_LAUNCHES;

constexpr size_t MiB = 1u << 20, KiB = 1u << 10;
constexpr size_t WS_CTL = 0, CTL_ZERO_BYTES = 1 * MiB;
constexpr size_t WS_MODP = 1 * MiB;
constexpr size_t WS_MOD = 4 * MiB;
constexpr size_t WS_ROPE = 4 * MiB + 512 * KiB;
constexpr size_t WS_CMPB = 5 * MiB;
constexpr size_t WS_TOKE = 5 * MiB + 256 * KiB;
constexpr size_t WS_TOKW = WS_TOKE + 64 * KiB;
constexpr size_t WS_TOKS = WS_TOKW + 64 * KiB;
constexpr size_t WS_ROWTOK = 5 * MiB + 512 * KiB;
constexpr size_t WS_ROWW = WS_ROWTOK + 128 * KiB;
constexpr size_t WS_SELM = 6 * MiB;
constexpr size_t WS_KCMP = 6 * MiB + 256 * KiB;
constexpr size_t WS_VCMPT = 6 * MiB + 512 * KiB;
constexpr size_t WS_GATES = 7 * MiB;
constexpr size_t WS_ULK = 10 * MiB, WS_ULV = 14 * MiB;
constexpr size_t WS_WQKV = 18 * MiB, WS_WO0 = 28 * MiB, WS_WIN = 36 * MiB, WS_WO1 = 51 * MiB, WS_PHIK = 59 * MiB, WS_PHIV = 60 * MiB;
constexpr size_t WS_W13 = 64 * MiB;
constexpr size_t WS_W2 = 192 * MiB;
constexpr size_t WS_H = 256 * MiB;
constexpr size_t WS_XA = 288 * MiB, WS_XB = 352 * MiB;
constexpr size_t WS_Q = 416 * MiB, WS_QRAW = 448 * MiB, WS_ATT = 480 * MiB;
constexpr size_t WS_HPERM = 416 * MiB;
constexpr size_t WS_OCMP = 512 * MiB, WS_OWIN = 544 * MiB;
constexpr size_t WS_K0 = 576 * MiB, WS_VT0 = 580 * MiB, WS_KC = 584 * MiB, WS_VC = 588 * MiB, WS_KS = 592 * MiB, WS_VST = 596 * MiB, WS_KW = 600 * MiB, WS_VWT = 604 * MiB;
constexpr size_t WS_HE = 608 * MiB;
constexpr size_t WS_YS = 628 * MiB;
constexpr size_t WS_END = 692 * MiB;
constexpr int CW_TMO = 0, CW_CODE = 1;
constexpr int CW_CNT = 64;
constexpr int CW_BAR = 4096;

constexpr int RING_OFF = 0, RING_BYTES = 131072;
constexpr int LDSCTL_OFF = RING_BYTES, MISC_OFF = LDSCTL_OFF + 320;
constexpr int LDS_BYTES = 147456;
typedef float f32x16g __attribute__((ext_vector_type(16)));
typedef unsigned u32x2g __attribute__((ext_vector_type(2)));
__device__ __forceinline__ float wave_sum(float v) {
#pragma unroll
    for (int o = 1; o < 64; o <<= 1) v += __shfl_xor(v, o);
    return v;
}
__device__ __forceinline__ unsigned ld_u32_agent(const unsigned* p) { return __hip_atomic_load(p, __ATOMIC_RELAXED, __HIP_MEMORY_SCOPE_AGENT); }

__device__ __forceinline__ void transpose_item(const float* W, int ldw, bf16* WT, int ldt, int k0, int n0, int drow0, LAS float* scr, int lane) {
#pragma unroll 8
    for (int i = 0; i < 32; ++i) { const int kk = 2 * i + (lane >> 5); scr[kk * 33 + (lane & 31)] = __builtin_nontemporal_load(W + (size_t)(k0 + kk) * ldw + n0 + (lane & 31)); }
    LDS_WAIT(); asm volatile("" ::: "memory");
    const int c = lane & 7;
#pragma unroll
    for (int j = 0; j < 4; ++j) { const int n = (lane >> 3) + 8 * j; const LAS float* s = scr + (8 * c) * 33 + n;
        v4u o; o.x = pk2(s[0 * 33], s[1 * 33]); o.y = pk2(s[2 * 33], s[3 * 33]); o.z = pk2(s[4 * 33], s[5 * 33]); o.w = pk2(s[6 * 33], s[7 * 33]);
        *(GAS v4u*)(WT + (size_t)(drow0 + n) * ldt + k0 + 8 * c) = o; }
    LDS_WAIT(); asm volatile("" ::: "memory");
}

__device__ __forceinline__ void phase_mod_partial(const float* c, const float* w_ada, float* modp, LAS float* scr, int gw, int NGW, int lane) {
    for (int task = gw; task < 1536; task += NGW) {
        const int ks = task & 15, chunk = (task >> 4) % 48, layer = task / 768, k0 = ks * 128;
        for (int i = lane; i < 256; i += 64) { const float v = c[(i >> 7) * DM + k0 + (i & 127)]; scr[i] = v / (1.0f + __expf(-v)); }
        LDS_WAIT(); asm volatile("" ::: "memory");
        const float* wp = w_ada + ((size_t)layer * DM + k0) * 12288 + chunk * 256 + lane * 4;
        f32x4 a0 = {0.f, 0.f, 0.f, 0.f}, a1 = {0.f, 0.f, 0.f, 0.f};
#pragma unroll 8
        for (int k = 0; k < 128; ++k) { const f32x4 w = __builtin_nontemporal_load((const f32x4*)(wp + (size_t)k * 12288)); const float s0 = scr[k], s1 = scr[128 + k]; a0 += w * s0; a1 += w * s1; }
        float* o = modp + ((size_t)((ks * 2 + layer) * 2) * 12288) + chunk * 256 + lane * 4;
        *(f32x4*)o = a0; *(f32x4*)(o + 12288) = a1;
        LDS_WAIT(); asm volatile("" ::: "memory");
    }
}
__device__ __forceinline__ void rope_table(const int* positions, float* rope, int gtid, int nthr) {
    for (int idx = gtid; idx < NTOK * 8; idx += nthr) {
        const int tok = idx >> 3, i = idx & 7;
        const double invf = i == 0 ? 1.0 : i == 1 ? 0.19392274474868576 : i == 2 ? 0.03760603093086393 : i == 3 ? 0.007292664737217109 : i == 4 ? 0.001414213562373095 : i == 5 ? 0.0002742481756762073 : i == 6 ? 5.318295896944988e-05 : 1.031338537721246e-05;
        const double a = (double)positions[tok] * invf;
        const double kq = __builtin_rint(a * 0.6366197723675814);
        double r = __builtin_fma(-kq, 1.5707963267948966, a); r = __builtin_fma(-kq, 6.123233995736766e-17, r);
        const double r2 = r * r;
        double sn = 1.0 / 6227020800.0; sn = sn * r2 - 1.0 / 39916800.0; sn = sn * r2 + 1.0 / 362880.0; sn = sn * r2 - 1.0 / 5040.0; sn = sn * r2 + 1.0 / 120.0; sn = sn * r2 - 1.0 / 6.0; sn = sn * r2 + 1.0; sn *= r;
        double cs = -1.0 / 87178291200.0; cs = cs * r2 + 1.0 / 479001600.0; cs = cs * r2 - 1.0 / 3628800.0; cs = cs * r2 + 1.0 / 40320.0; cs = cs * r2 - 1.0 / 720.0; cs = cs * r2 + 1.0 / 24.0; cs = cs * r2 - 0.5; cs = cs * r2 + 1.0;
        const int q = ((int)(long long)kq) & 3;
        const double co = q == 0 ? cs : q == 1 ? -sn : q == 2 ? -cs : sn, si = q == 0 ? sn : q == 1 ? cs : q == 2 ? -sn : -cs;
        rope[(size_t)tok * 16 + i] = (float)co; rope[(size_t)tok * 16 + 8 + i] = (float)si;
    }
}

__device__ __forceinline__ void modulate_row_lds(const float* xrow, const LAS float* sh, const LAS float* sc, bf16* orow, int lane) {
    const GAS f32x4* xr = (const GAS f32x4*)xrow + lane; GAS unsigned long long* o8 = (GAS unsigned long long*)orow + lane;
#pragma unroll
    for (int j = 0; j < 8; ++j) { const f32x4 v = xr[64 * j]; const f32x4 s = *(const LAS f32x4*)(sc + 256 * j + 4 * lane), h = *(const LAS f32x4*)(sh + 256 * j + 4 * lane);
        const f32x4 o = v * (s + 1.0f) + h; o8[64 * j] = (unsigned long long)pk2(o.x, o.y) | ((unsigned long long)pk2(o.z, o.w) << 32); }
}

struct In {
    const float *x, *c; const int* positions; const float *w_ada, *b_ada, *swa_w_qkv, *swa_b_qkv, *swa_sinks, *swa_w_o, *nsa_w_in, *nsa_pe_k, *nsa_pe_v, *nsa_phi_k1, *nsa_phi_k2, *nsa_phi_v1, *nsa_phi_v2, *nsa_w_o,
        *moe_w_group, *moe_b_group, *moe_w_router, *moe_b_router, *moe_w1, *moe_w3, *moe_w2, *ln_t_g, *ln_t_b, *ln_c_g, *ln_c_b;
};

__device__ __forceinline__ void phase_prologue(const In& I, unsigned char* ws, LAS unsigned char* lds, int tid, int lane, int wave, int vcu, int G) {
    const float* modp = (const float*)(ws + WS_MODP); float* mod = (float*)(ws + WS_MOD);
    LAS float* msm = (LAS float*)(lds + 65536);
    for (int idx = tid; idx < 2 * 4096; idx += NWAVES * 64) { const int b = idx >> 12, col = idx & 4095; float s = I.b_ada[col];
#pragma unroll
        for (int ks = 0; ks < 16; ++ks) s += modp[(size_t)((ks * 2 + 0) * 2 + b) * 12288 + col];
        msm[idx] = s; }
    { const int gidx = vcu * 192 + tid;
      if (tid < 192 && gidx < 2 * 2 * 12288) { const int layer = gidx / 24576, rem = gidx % 24576, b = rem / 12288, col = rem % 12288; float s = I.b_ada[layer * 12288 + col];
#pragma unroll
          for (int ks = 0; ks < 16; ++ks) s += modp[(size_t)((ks * 2 + layer) * 2 + b) * 12288 + col];
          mod[gidx] = s; } }
    __syncthreads();
    const int gw = vcu * NWAVES + wave, NGW = G * NWAVES;
    bf16* H = (bf16*)(ws + WS_H);
    for (int m = gw; m < NTOK; m += NGW) { const int b = m >> 12; modulate_row_lds(I.x + (size_t)m * DM, msm + b * 4096, msm + b * 4096 + 2048, H + (size_t)m * DM, lane); }
    if (gw < 512) { const int which = gw >> 8, cc = gw & 255; const float* pe = which ? I.nsa_pe_v : I.nsa_pe_k; const float* phi = which ? I.nsa_phi_v1 : I.nsa_phi_k1; float s = 0.f;
#pragma unroll 4
        for (int i = 0; i < 32; ++i) { const int k = lane + 64 * i; s += pe[k] * phi[(size_t)k * 256 + cc]; }
        s = wave_sum(s); if (lane == 0) ((float*)(ws + WS_CMPB))[which * 256 + cc] = s; }
    __syncthreads();
    LAS float* scr = (LAS float*)(lds + wave * 16384);
    constexpr int I_QKV = 32 * 80, I_WO = 32 * 64, I_WIN = 32 * 115, I_PHI = 16 * 8;
    constexpr int I_DENSE = I_QKV + 2 * I_WO + I_WIN + 4 * I_PHI;
    constexpr int I_W13 = 2 * 16 * 2 * 512, I_W2 = 2 * 16 * 512;
    constexpr int NITEMS = I_DENSE + I_W13 + I_W2;
    for (int it = gw; it < NITEMS; it += NGW) {
        int r = it;
        if (r < I_QKV) { transpose_item(I.swa_w_qkv, 2560, (bf16*)(ws + WS_WQKV), 2048, 64 * (r / 80), 32 * (r % 80), 32 * (r % 80), scr, lane); continue; } r -= I_QKV;
        if (r < I_WO) { transpose_item(I.swa_w_o, 2048, (bf16*)(ws + WS_WO0), 2048, 64 * (r / 64), 32 * (r % 64), 32 * (r % 64), scr, lane); continue; } r -= I_WO;
        if (r < I_WO) { transpose_item(I.nsa_w_o, 2048, (bf16*)(ws + WS_WO1), 2048, 64 * (r / 64), 32 * (r % 64), 32 * (r % 64), scr, lane); continue; } r -= I_WO;
        if (r < I_WIN) { transpose_item(I.nsa_w_in, 3680, (bf16*)(ws + WS_WIN), 2048, 64 * (r / 115), 32 * (r % 115), 32 * (r % 115), scr, lane); continue; } r -= I_WIN;
        if (r < 4 * I_PHI) { const int j = r / I_PHI, q = r % I_PHI, which = j >> 1, half = j & 1;
            transpose_item((which ? I.nsa_phi_v1 : I.nsa_phi_k1) + (size_t)half * 1024 * 256, 256, (bf16*)(ws + (which ? WS_PHIV : WS_PHIK)), 1024, 64 * (q / 8), 32 * (q % 8), half * 256 + 32 * (q % 8), scr, lane); continue; }
        r -= 4 * I_PHI;
        if (r < I_W13) { const int mat = r / 512, q = r % 512, le = mat >> 1, which = mat & 1;
            const int n0 = 32 * (q % 16);
            transpose_item((which ? I.moe_w3 : I.moe_w1) + (size_t)le * 2048 * 512, 512, (bf16*)(ws + WS_W13) + (size_t)le * 1024 * 2048, 2048, 64 * (q / 16), n0, (n0 >> 7) * 256 + which * 128 + (n0 & 127), scr, lane); continue; }
        r -= I_W13;
        { const int le = r / 512, q = r % 512;
          transpose_item(I.moe_w2 + (size_t)le * 512 * 2048, 2048, (bf16*)(ws + WS_W2) + (size_t)le * 2048 * 512, 512, 64 * (q / 64), 32 * (q % 64), 32 * (q % 64), scr, lane); }
    }
}

template <int W, bool SINK>
__device__ __forceinline__ void banded_unit(int b, int hkv, int tb, int g, int lane, const bf16* Q, const bf16* K, const bf16* VT, bf16* OUT, const float* sinks) {
    const int r32 = lane & 31, hi = lane >> 5, head = hkv * 8 + g, q0 = tb * 32, t = q0 + r32;
    const size_t row = (size_t)b * SEQ + t;
    fa::bf16x8 qr[4]; fa::load_q(qr, Q + row * DM + head * 64, hi);
    const bf16* Kbh = K + (size_t)(b * 4 + hkv) * SEQ * 64; const bf16* Vbh = VT + (size_t)(b * 4 + hkv) * 64 * SEQ;
    fa::State st; st.o0 = fa::f32x16{}; st.o1 = fa::f32x16{};
    if (SINK) { st.m = sinks[head] * LOG2E; st.l = hi == 0 ? 1.0f : 0.0f; } else { st.m = fa::NEGBIG; st.l = 0.f; }
    const int ktA = tb - W / 32 > 0 ? tb - W / 32 : 0;
    fa::Frag fc, fn; fa::load_tile(fc, Kbh, Vbh, SEQ, ktA * 32, r32, hi);
    for (int kt = ktA; kt <= tb; ++kt) {
        if (kt < tb) fa::load_tile(fn, Kbh, Vbh, SEQ, (kt + 1) * 32, r32, hi);
        const bool nm = (kt == tb) || (kt == tb - W / 32);
        fa::step(st, fc, qr, kt * 32, hi, nm, t - W + 1, t);
        fc = fn;
    }
    const float inv = fa::finish(st);
    fa::store_o(st, inv, OUT + row * DM + head * 64, hi);
}
template <int W, bool SINK>
__device__ __forceinline__ void phase_banded(int vcu, int G, int wave, int lane, const bf16* Q, const bf16* K, const bf16* VT, bf16* OUT, const float* sinks) {
    for (int u = vcu; u < 1024; u += G) { const int bh = (u >> 5) & 7, tb = ((u >> 8) << 5) | (u & 31); banded_unit<W, SINK>(bh >> 2, bh & 3, tb, wave, lane, Q, K, VT, OUT, sinks); }
}

__device__ __forceinline__ void phase_lnt(const In& I, unsigned char* ws, LAS float* hsm  , int layer, const float* Y, int gw, int lane) {
    const float* mod = (const float*)(ws + WS_MOD); float* XA = (float*)(ws + WS_XA); bf16* H = (bf16*)(ws + WS_H);
    const float* lng = I.ln_t_g + layer * DM; const float* lnb = I.ln_t_b + layer * DM;
    const float* wg = I.moe_w_group + (size_t)layer * DM * 4; const float* wr = I.moe_w_router + (size_t)layer * DM * 16;
    unsigned* cnt = (unsigned*)(ws + WS_CTL) + CW_CNT + layer * 16;
    int* tokE = (int*)(ws + WS_TOKE); float* tokW = (float*)(ws + WS_TOKW); int* tokS = (int*)(ws + WS_TOKS);
    for (int it = 0; it < 2; ++it) {
        const int rA = gw * 4 + it * 2, b = rA >> 12;
        const float* shc = mod + (size_t)(layer * 2 + b) * 12288 + 6144; const float* scc = shc + 2048;
        f32x4 v[2][8]; float rstd[2];
#pragma unroll
        for (int r = 0; r < 2; ++r) {
            const GAS f32x4* yr = (const GAS f32x4*)(Y + (size_t)(rA + r) * DM) + lane; float s = 0.f;
#pragma unroll
            for (int j = 0; j < 8; ++j) { v[r][j] = yr[64 * j]; s += (v[r][j].x + v[r][j].y) + (v[r][j].z + v[r][j].w); }
            const float mean = wave_sum(s) * (1.f / DM); float s2 = 0.f;
#pragma unroll
            for (int j = 0; j < 8; ++j) { v[r][j] = v[r][j] - mean; s2 += (v[r][j].x * v[r][j].x + v[r][j].y * v[r][j].y) + (v[r][j].z * v[r][j].z + v[r][j].w * v[r][j].w); }
            rstd[r] = 1.f / sqrtf(wave_sum(s2) * (1.f / DM) + LN_EPS);
        }
#pragma unroll
        for (int j = 0; j < 8; ++j) { const int col = 256 * j + 4 * lane;
            const f32x4 gg = *(const f32x4*)(lng + col), bb = *(const f32x4*)(lnb + col), sc = *(const f32x4*)(scc + col), sh = *(const f32x4*)(shc + col);
#pragma unroll
            for (int r = 0; r < 2; ++r) { const f32x4 x1 = v[r][j] * rstd[r] * gg + bb; ((GAS f32x4*)(XA + (size_t)(rA + r) * DM) + lane)[64 * j] = x1;
                const f32x4 h = x1 * (sc + 1.0f) + sh; *(LAS f32x4*)(hsm + r * 2048 + col) = h;
                ((GAS unsigned long long*)(H + (size_t)(rA + r) * DM) + lane)[64 * j] = (unsigned long long)pk2(h.x, h.y) | ((unsigned long long)pk2(h.z, h.w) << 32); } }
        LDS_WAIT(); asm volatile("" ::: "memory");
        float acc[2][20];
#pragma unroll
        for (int r = 0; r < 2; ++r)
#pragma unroll
            for (int e = 0; e < 20; ++e) acc[r][e] = 0.f;
#pragma unroll 1
        for (int j = 0; j < 8; ++j) { const int col = 256 * j + 4 * lane;
            const f32x4 h0 = *(const LAS f32x4*)(hsm + col), h1 = *(const LAS f32x4*)(hsm + 2048 + col);
#pragma unroll
            for (int i = 0; i < 4; ++i) {
                const float hA = h0[i], hB = h1[i];
#pragma unroll
                for (int q = 0; q < 4; ++q) { const f32x4 w = *(const f32x4*)(wr + (size_t)(col + i) * 16 + 4 * q);
#pragma unroll
                    for (int e = 0; e < 4; ++e) { acc[0][4 * q + e] += hA * w[e]; acc[1][4 * q + e] += hB * w[e]; } }
                const f32x4 w = *(const f32x4*)(wg + (size_t)(col + i) * 4);
#pragma unroll
                for (int e = 0; e < 4; ++e) { acc[0][16 + e] += hA * w[e]; acc[1][16 + e] += hB * w[e]; }
            } }
        LDS_WAIT(); asm volatile("" ::: "memory");
#pragma unroll
        for (int r = 0; r < 2; ++r)
#pragma unroll
            for (int e = 0; e < 20; ++e) acc[r][e] = wave_sum(acc[r][e]);
        if (lane < 2) {
            float a[20];
#pragma unroll
            for (int e = 0; e < 20; ++e) a[e] = lane == 0 ? acc[0][e] : acc[1][e];
            const int row = rA + lane;
            float gl[4];
#pragma unroll
            for (int e = 0; e < 4; ++e) gl[e] = a[16 + e] + I.moe_b_group[layer * 4 + e];
            int gi = 0; float gm = gl[0];
#pragma unroll
            for (int e = 1; e < 4; ++e) if (gl[e] > gm) { gm = gl[e]; gi = e; }
            float gs = 0.f;
#pragma unroll
            for (int e = 0; e < 4; ++e) gs += __expf(gl[e] - gm);
            const float gprob = 1.0f / gs;
            float le[4];
#pragma unroll
            for (int e = 0; e < 4; ++e) le[e] = (gi == 0 ? a[e] : gi == 1 ? a[4 + e] : gi == 2 ? a[8 + e] : a[12 + e]) + I.moe_b_router[layer * 16 + gi * 4 + e];
            int i1 = 0; float m1 = le[0];
#pragma unroll
            for (int e = 1; e < 4; ++e) if (le[e] > m1) { m1 = le[e]; i1 = e; }
            int i2 = -1; float m2 = -INFINITY;
#pragma unroll
            for (int e = 0; e < 4; ++e) if (e != i1 && le[e] > m2) { m2 = le[e]; i2 = e; }
            const float p2 = __expf(m2 - m1), den = 1.0f / (1.0f + p2);
            const int e1 = gi * 4 + i1, e2 = gi * 4 + i2; const float w1 = gprob * den, w2 = gprob * p2 * den;
            const unsigned s1 = atomicAdd(cnt + e1, 1u), s2 = atomicAdd(cnt + e2, 1u);
            tokE[row * 2] = e1; tokE[row * 2 + 1] = e2; tokW[row * 2] = w1; tokW[row * 2 + 1] = w2; tokS[row * 2] = (int)s1; tokS[row * 2 + 1] = (int)s2;
        }
    }
}

struct Seg { unsigned cnt[16]; };
__device__ __forceinline__ void seg_load(Seg& s, const unsigned* cnt) {
#pragma unroll
    for (int e = 0; e < 16; ++e) s.cnt[e] = ld_u32_agent(cnt + e);
}
__device__ __forceinline__ int seg_row_base(const Seg& s, int e) {
    int run = 0, base = 0;
#pragma unroll
    for (int k = 0; k < 16; ++k) { if (k == e) base = run; run += (int)((s.cnt[k] + 255u) >> 8); }
    return base * 256;
}
__device__ __forceinline__ void phase_permute(unsigned char* ws, int layer, int gw, int lane) {
    Seg sg; seg_load(sg, (const unsigned*)(ws + WS_CTL) + CW_CNT + layer * 16);
    const bf16* H = (const bf16*)(ws + WS_H); bf16* HP = (bf16*)(ws + WS_HPERM);
    const int* tokE = (const int*)(ws + WS_TOKE); const float* tokW = (const float*)(ws + WS_TOKW); const int* tokS = (const int*)(ws + WS_TOKS);
    int* rowtok = (int*)(ws + WS_ROWTOK); float* roww = (float*)(ws + WS_ROWW);
    for (int i = 0; i < 4; ++i) { const int row = gw * 4 + i;
        const GAS v4u* src = (const GAS v4u*)(H + (size_t)row * DM) + lane; v4u d[4];
#pragma unroll
        for (int j = 0; j < 4; ++j) d[j] = src[64 * j];
#pragma unroll
        for (int k = 0; k < 2; ++k) { const int e = tokE[row * 2 + k], dst = seg_row_base(sg, e) + tokS[row * 2 + k];
            GAS v4u* o = (GAS v4u*)(HP + (size_t)dst * DM) + lane;
#pragma unroll
            for (int j = 0; j < 4; ++j) o[64 * j] = d[j];
            if (lane == 0) { rowtok[dst] = row * 2 + k; roww[dst] = tokW[row * 2 + k]; } }
    }
}
__device__ __forceinline__ void build_units(pg8::GroupOrder& S, const Seg& sg, int nN, int G, int c) {
    int nT = 0;
#pragma unroll
    for (int e = 0; e < 16; ++e) { S.cnt[e] = (unsigned)__builtin_amdgcn_readfirstlane((int)sg.cnt[e]); nT += (int)((S.cnt[e] + 255u) >> 8); }
    S.nT = nT; S.nN = nN; S.G = G; S.c = c;
}

__device__ __forceinline__ void phase_lnc(const In& I, unsigned char* ws, int layer, float* xout, bool write_h, int gw, int lane) {
    const float* mod = (const float*)(ws + WS_MOD); const float* XA = (const float*)(ws + WS_XA); const bf16* YS = (const bf16*)(ws + WS_YS); bf16* H = (bf16*)(ws + WS_H);
    const float* lng = I.ln_c_g + layer * DM; const float* lnb = I.ln_c_b + layer * DM;
    for (int i = 0; i < 4; ++i) { const int row = gw * 4 + i, b = row >> 12;
        const float* gc = mod + (size_t)(layer * 2 + b) * 12288 + 10240;
        const float* shn = mod + (size_t)(2 + b) * 12288; const float* scn = shn + 2048;
        const GAS f32x4* xr = (const GAS f32x4*)(XA + (size_t)row * DM) + lane;
        const GAS u32x2g* s0 = (const GAS u32x2g*)(YS + (size_t)(row * 2) * DM) + lane; const GAS u32x2g* s1 = (const GAS u32x2g*)(YS + (size_t)(row * 2 + 1) * DM) + lane;
        f32x4 v[8]; float s = 0.f;
#pragma unroll
        for (int j = 0; j < 8; ++j) { const f32x4 x1 = xr[64 * j]; const u32x2g a = s0[64 * j], c = s1[64 * j]; const f32x4 g = *(const f32x4*)(gc + 256 * j + 4 * lane);
            f32x4 m; m.x = fa::bflo(a.x) + fa::bflo(c.x); m.y = fa::bfhi(a.x) + fa::bfhi(c.x); m.z = fa::bflo(a.y) + fa::bflo(c.y); m.w = fa::bfhi(a.y) + fa::bfhi(c.y);
            v[j] = x1 * ALPHA_RES + g * m; s += (v[j].x + v[j].y) + (v[j].z + v[j].w); }
        const float mean = wave_sum(s) * (1.f / DM); float s2 = 0.f;
#pragma unroll
        for (int j = 0; j < 8; ++j) { v[j] = v[j] - mean; s2 += (v[j].x * v[j].x + v[j].y * v[j].y) + (v[j].z * v[j].z + v[j].w * v[j].w); }
        const float rstd = 1.f / sqrtf(wave_sum(s2) * (1.f / DM) + LN_EPS);
        GAS f32x4* xo = (GAS f32x4*)(xout + (size_t)row * DM) + lane; GAS unsigned long long* ho = (GAS unsigned long long*)(H + (size_t)row * DM) + lane;
#pragma unroll
        for (int j = 0; j < 8; ++j) { const int col = 256 * j + 4 * lane; const f32x4 gg = *(const f32x4*)(lng + col), bb = *(const f32x4*)(lnb + col);
            const f32x4 x2 = v[j] * rstd * gg + bb; xo[64 * j] = x2;
            if (write_h) { const f32x4 sc = *(const f32x4*)(scn + col), sh = *(const f32x4*)(shn + col); const f32x4 h = x2 * (sc + 1.0f) + sh;
                ho[64 * j] = (unsigned long long)pk2(h.x, h.y) | ((unsigned long long)pk2(h.z, h.w) << 32); } }
    }
}

__device__ __forceinline__ void phase_cmp2(const In& I, unsigned char* ws, LAS float* hid  , int gw, int NGW, int lane) {
    for (int task = gw; task < 2 * 8 * 256; task += NGW) { const int which = task >> 11, bh = (task >> 8) & 7, n = task & 255;
        bf16* kc = (bf16*)(ws + WS_KCMP); bf16* vct = (bf16*)(ws + WS_VCMPT); float o = 0.f;
        if (n < 255) { const float* UL = (const float*)(ws + (which ? WS_ULV : WS_ULK)); const float* cb = (const float*)(ws + WS_CMPB) + which * 256; const float* phi2 = which ? I.nsa_phi_v2 : I.nsa_phi_k2;
            const f32x4 u = *(const f32x4*)(UL + (size_t)(bh * 256 + n) * 512 + 4 * lane), l = *(const f32x4*)(UL + (size_t)(bh * 256 + n + 1) * 512 + 256 + 4 * lane), bb = *(const f32x4*)(cb + 4 * lane);
            f32x4 h = u + l + bb;
#pragma unroll
            for (int i = 0; i < 4; ++i) h[i] = h[i] / (1.0f + __expf(-h[i]));
            *(LAS f32x4*)(hid + 4 * lane) = h; LDS_WAIT(); asm volatile("" ::: "memory");
#pragma unroll 8
            for (int cidx = 0; cidx < 256; ++cidx) o += hid[cidx] * phi2[cidx * 64 + lane];
            LDS_WAIT(); asm volatile("" ::: "memory"); }
        if (which == 0) kc[(size_t)(bh * 256 + n) * 64 + lane] = (bf16)f2bf(o); else vct[(size_t)(bh * 64 + lane) * 256 + n] = (bf16)f2bf(o);
    }
}

__device__ __forceinline__ void cmp_unit(unsigned char* ws, LAS unsigned char* lds, int b, int hkv, int tb, int tid, int wave, int lane) {
    const int r32 = lane & 31, hi = lane >> 5, head = hkv * 8 + wave, q0 = tb * 32, t = q0 + r32; const size_t row = (size_t)b * SEQ + t;
    const bf16* Q = (const bf16*)(ws + WS_QRAW); bf16* OUT = (bf16*)(ws + WS_OCMP);
    const bf16* Kbh = (const bf16*)(ws + WS_KCMP) + (size_t)(b * 4 + hkv) * 256 * 64; const bf16* Vbh = (const bf16*)(ws + WS_VCMPT) + (size_t)(b * 4 + hkv) * 64 * 256;
    LAS float* impw = (LAS float*)lds + wave * (32 * 66); LAS float* tot = (LAS float*)(lds + 69632);
    for (int i = lane; i < 32 * 66; i += 64) impw[i] = 0.f;
    fa::bf16x8 qr[4]; fa::load_q(qr, Q + row * DM + head * 64, hi);
    fa::State st; st.o0 = fa::f32x16{}; st.o1 = fa::f32x16{}; st.m = fa::NEGBIG; st.l = 0.f;
    const int nhi = (t - 31) >> 4;
    const int ntile = ((2 * tb) >> 5) + 1;
    fa::Frag fc, fn; fa::load_tile(fc, Kbh, Vbh, 256, 0, r32, hi);
    for (int kt = 0; kt < ntile; ++kt) {
        if (kt + 1 < ntile) fa::load_tile(fn, Kbh, Vbh, 256, (kt + 1) * 32, r32, hi);
        fa::step(st, fc, qr, kt * 32, hi, true, 0, nhi);
        fc = fn;
    }
    const float inv = fa::finish(st);
    fa::store_o(st, inv, OUT + row * DM + head * 64, hi);
    for (int kt = 0; kt < ntile; ++kt) {
        fa::Frag f; fa::load_tile(f, Kbh, Vbh, 256, kt * 32, r32, hi);
        fa::f32x16 p; fa::scores(p, f, qr); fa::mask_range(p, kt * 32, hi, 0, nhi);
#pragma unroll
        for (int r = 0; r < 16; ++r) p[r] = __builtin_amdgcn_exp2f(p[r] - st.m) * inv;
#pragma unroll
        for (int hh = 0; hh < 2; ++hh) {
            if (hi == hh) {
#pragma unroll
                for (int rg = 0; rg < 2; ++rg) { const int jA = (kt * 32 + 16 * rg + 8 * hi) >> 2; LAS float* ip = impw + r32 * 66 + jA;
                    const float e0 = p[8 * rg], e1 = p[8 * rg + 1], e2 = p[8 * rg + 2], e3 = p[8 * rg + 3], e4 = p[8 * rg + 4], e5 = p[8 * rg + 5], e6 = p[8 * rg + 6], e7 = p[8 * rg + 7];
                    ip[0] += (e0 + e1) + (e2 + 0.5f * e3); ip[1] += (0.5f * e3 + e4) + (e5 + e6) + 0.5f * e7; ip[2] += 0.5f * e7; }
            }
            LDS_WAIT(); asm volatile("" ::: "memory");
        }
    }
    __syncthreads();
    for (int i = tid; i < 32 * 64; i += NWAVES * 64) { const int q = i >> 6, j = i & 63; float s = 0.f;
#pragma unroll
        for (int w = 0; w < 8; ++w) s += ((LAS float*)lds)[w * (32 * 66) + q * 66 + j];
        tot[q * 66 + j] = s; }
    __syncthreads();
    {
        const int q = tid >> 4, part = tid & 15, tq = q0 + q, cur = tq >> 6;
        float sc[4];
#pragma unroll
        for (int i = 0; i < 4; ++i) { const int j = 4 * part + i; const bool causal = j * 64 <= tq, forced = (j == 0) || (j == cur) || (j == cur - 1);
            sc[i] = causal ? tot[q * 66 + j] + (forced ? 1e4f : 0.f) : -1e30f; }
        int rk[4] = {0, 0, 0, 0};
        for (int jp = 0; jp < 64; ++jp) { const bool causal = jp * 64 <= tq, forced = (jp == 0) || (jp == cur) || (jp == cur - 1);
            const float sp = causal ? tot[q * 66 + jp] + (forced ? 1e4f : 0.f) : -1e30f;
#pragma unroll
            for (int i = 0; i < 4; ++i) { const int j = 4 * part + i; rk[i] += (sp > sc[i] || (sp == sc[i] && jp < j)) ? 1 : 0; } }
        unsigned lo = 0u, hi32 = 0u;
#pragma unroll
        for (int i = 0; i < 4; ++i) { const int j = 4 * part + i; if (rk[i] < 16) { if (j < 32) lo |= 1u << j; else hi32 |= 1u << (j - 32); } }
#pragma unroll
        for (int o = 1; o < 16; o <<= 1) { lo |= __shfl_xor(lo, o); hi32 |= __shfl_xor(hi32, o); }
        if (part == 0) ((unsigned long long*)(ws + WS_SELM))[(size_t)(b * 4 + hkv) * SEQ + tq] = ((unsigned long long)hi32 << 32) | lo;
    }
    __syncthreads();
}

__device__ __forceinline__ void sel_unit(unsigned char* ws, int b, int hkv, int tb, int wave, int lane) {
    const int r32 = lane & 31, hi = lane >> 5, head = hkv * 8 + wave, q0 = tb * 32, t = q0 + r32; const size_t row = (size_t)b * SEQ + t;
    const bf16* Q = (const bf16*)(ws + WS_Q); bf16* OUT = (bf16*)(ws + WS_ATT);
    const bf16* Kbh = (const bf16*)(ws + WS_KS) + (size_t)(b * 4 + hkv) * SEQ * 64; const bf16* Vbh = (const bf16*)(ws + WS_VST) + (size_t)(b * 4 + hkv) * 64 * SEQ;
    const unsigned long long selm = ((const unsigned long long*)(ws + WS_SELM))[(size_t)(b * 4 + hkv) * SEQ + t];
    unsigned ulo = (unsigned)selm, uhi = (unsigned)(selm >> 32);
#pragma unroll
    for (int o = 1; o < 64; o <<= 1) { ulo |= __shfl_xor(ulo, o); uhi |= __shfl_xor(uhi, o); }
    const unsigned long long U = ((unsigned long long)(unsigned)__builtin_amdgcn_readfirstlane((int)uhi) << 32) | (unsigned)__builtin_amdgcn_readfirstlane((int)ulo);
    fa::bf16x8 qr[4]; fa::load_q(qr, Q + row * DM + head * 64, hi);
    fa::State st; st.o0 = fa::f32x16{}; st.o1 = fa::f32x16{}; st.m = fa::NEGBIG; st.l = 0.f;
    int kt = 0; while (kt <= tb && !((U >> (kt >> 1)) & 1ull)) ++kt;
    fa::Frag fc, fn; if (kt <= tb) fa::load_tile(fc, Kbh, Vbh, SEQ, kt * 32, r32, hi);
    while (kt <= tb) {
        int kn = kt + 1; while (kn <= tb && !((U >> (kn >> 1)) & 1ull)) ++kn;
        if (kn <= tb) fa::load_tile(fn, Kbh, Vbh, SEQ, kn * 32, r32, hi);
        const bool mine = (selm >> (kt >> 1)) & 1ull;
        const bool nm = (kt == tb) || !__all(mine);
        fa::step(st, fc, qr, kt * 32, hi, nm, 0, mine ? t : -1);
        fc = fn; kt = kn;
    }
    const float inv = fa::finish(st);
    const float* gates = (const float*)(ws + WS_GATES) + row * 96 + head * 3; const float g0 = gates[0], g1 = gates[1] * inv, g2 = gates[2];
    const bf16* oc = (const bf16*)(ws + WS_OCMP) + row * DM + head * 64; const bf16* ow = (const bf16*)(ws + WS_OWIN) + row * DM + head * 64; bf16* od = OUT + row * DM + head * 64;
#pragma unroll
    for (int g = 0; g < 4; ++g)
#pragma unroll
        for (int db = 0; db < 2; ++db) { const int d = 32 * db + 8 * g + 4 * hi; const u32x2g c = *(const u32x2g*)(oc + d), w = *(const u32x2g*)(ow + d);
            const fa::f32x16& oo = db ? st.o1 : st.o0;
            const float v0 = g0 * fa::bflo(c.x) + g1 * oo[4 * g] + g2 * fa::bflo(w.x), v1 = g0 * fa::bfhi(c.x) + g1 * oo[4 * g + 1] + g2 * fa::bfhi(w.x);
            const float v2 = g0 * fa::bflo(c.y) + g1 * oo[4 * g + 2] + g2 * fa::bflo(w.y), v3 = g0 * fa::bfhi(c.y) + g1 * oo[4 * g + 3] + g2 * fa::bfhi(w.y);
            u32x2g o; o.x = fa::cvtpk(v0, v1); o.y = fa::cvtpk(v2, v3); *(u32x2g*)(od + d) = o; }
}
typedef const void* const __attribute__((address_space(4))) * karg_ptr_t;
__device__ __forceinline__ void load_in(In& I) {
    karg_ptr_t ap = (karg_ptr_t)__builtin_amdgcn_kernarg_segment_ptr(); asm volatile("" : "+s"(ap));
    I.x = (const float*)ap[0]; I.c = (const float*)ap[1]; I.positions = (const int*)ap[2]; I.w_ada = (const float*)ap[3]; I.b_ada = (const float*)ap[4];
    I.swa_w_qkv = (const float*)ap[5]; I.swa_b_qkv = (const float*)ap[6]; I.swa_sinks = (const float*)ap[7]; I.swa_w_o = (const float*)ap[8];
    I.nsa_w_in = (const float*)ap[9]; I.nsa_pe_k = (const float*)ap[10]; I.nsa_pe_v = (const float*)ap[11]; I.nsa_phi_k1 = (const float*)ap[12]; I.nsa_phi_k2 = (const float*)ap[13];
    I.nsa_phi_v1 = (const float*)ap[14]; I.nsa_phi_v2 = (const float*)ap[15]; I.nsa_w_o = (const float*)ap[16];
    I.moe_w_group = (const float*)ap[17]; I.moe_b_group = (const float*)ap[18]; I.moe_w_router = (const float*)ap[19]; I.moe_b_router = (const float*)ap[20];
    I.moe_w1 = (const float*)ap[21]; I.moe_w3 = (const float*)ap[22]; I.moe_w2 = (const float*)ap[23];
    I.ln_t_g = (const float*)ap[24]; I.ln_t_b = (const float*)ap[25]; I.ln_c_g = (const float*)ap[26]; I.ln_c_b = (const float*)ap[27];
}
struct Args { const void* in[28]; float* out; unsigned char* ws; int ph_lo, ph_hi, li, pad; };
__global__ void __launch_bounds__(NWAVES * 64, 2) hyb_fwd(Args args) {
    extern __shared__ __attribute__((aligned(16))) unsigned char lds_raw[];
    LAS unsigned char* lds = (LAS unsigned char*)lds_raw;
    volatile LAS unsigned* MISC = (volatile LAS unsigned*)(lds + MISC_OFF);
    const int tid0 = threadIdx.x;
    const int G0 = gridDim.x, bx0 = blockIdx.x; const int vcu0 = (G0 % 8 == 0) ? (bx0 % 8) * (G0 / 8) + bx0 / 8 : bx0;
    unsigned char* const ws0 = args.ws; gu32* ctl = (gu32*)(ws0 + WS_CTL);
    for (int u = tid0; u < (LDS_BYTES - LDSCTL_OFF) / 4; u += NWAVES * 64) ((LAS unsigned*)(lds + LDSCTL_OFF))[u] = 0u;
    __syncthreads();
    XcdBarrier bar; bar.bar = (unsigned*)(ctl + CW_BAR); bar.x = 0; bar.st = nullptr;
    if (N_LAUNCHES == 1) bar = xcd_barrier_post((unsigned*)(ctl + CW_BAR), MISC + 8);
    const int lo = args.ph_lo, hi = args.ph_hi;
    float* const out0 = args.out;
    if (lo == 0) { In I; load_in(I); rope_table(I.positions, (float*)(ws0 + WS_ROPE), vcu0 * (NWAVES * 64) + tid0, G0 * NWAVES * 64); }
#pragma unroll 1
    for (int ph = lo; ph < hi; ++ph) {
        unsigned char* ws = ws0; int G = G0, bx = bx0, vcu = vcu0; float* outp = out0; int phx = ph;
        int tid = tid0;
        asm volatile("" : "+s"(ws), "+s"(G), "+s"(bx), "+s"(vcu), "+s"(outp), "+s"(phx), "+v"(tid));
        const int lane = tid & 63, wave = __builtin_amdgcn_readfirstlane(tid >> 6);
        const int gw = vcu * NWAVES + wave, NGW = G * NWAVES;
        const int layer = phx >= 10 ? 1 : 0, cp = phx - (layer ? 15 : 4);
        if (phx == 0) {
            In I; load_in(I); phase_mod_partial(I.c, I.w_ada, (float*)(ws + WS_MODP), (LAS float*)(lds + wave * 16384), gw, NGW, lane);
        } else if (phx == 1) {
            In I; load_in(I); phase_prologue(I, ws, lds, tid, lane, wave, vcu, G);
        } else if (phx == 2) {
            In I; load_in(I); pg8::Gemm g{(const bf16*)(ws + WS_H), (const bf16*)(ws + WS_WQKV), NTOK, 2560, DM}; pg8::StaticOrder S; S.init(NTOK, 2560, G, bx);
            pg8::EpiQKV E{(bf16*)(ws + WS_Q), (bf16*)(ws + WS_K0), (bf16*)(ws + WS_VT0), I.swa_b_qkv, (const float*)(ws + WS_ROPE), QSCALE};
            pg8::gemm_phase<pg8::EpiQKV, pg8::StaticOrder, true, true>(lds + RING_OFF, g, S, E);
        } else if (phx == 3) {
            In I; load_in(I); phase_banded<128, true>(vcu, G, wave, lane, (const bf16*)(ws + WS_Q), (const bf16*)(ws + WS_K0), (const bf16*)(ws + WS_VT0), (bf16*)(ws + WS_ATT), I.swa_sinks);
        } else if (phx == 10) {
            pg8::Gemm g{(const bf16*)(ws + WS_H), (const bf16*)(ws + WS_WIN), NTOK, 3840, DM}; pg8::StaticOrder S; S.init(NTOK, 3840, G, bx);
            pg8::EpiNSA E{(bf16*)(ws + WS_QRAW), (bf16*)(ws + WS_Q), (bf16*)(ws + WS_KC), (bf16*)(ws + WS_VC), (bf16*)(ws + WS_KS), (bf16*)(ws + WS_VST), (bf16*)(ws + WS_KW), (bf16*)(ws + WS_VWT), (float*)(ws + WS_GATES), (const float*)(ws + WS_ROPE), QSCALE};
            pg8::gemm_phase<pg8::EpiNSA, pg8::StaticOrder, true, true>(lds + RING_OFF, g, S, E);
        } else if (phx == 11) {
#pragma unroll 1
            for (int which = 0; which < 2; ++which) {
                pg8::Gemm g{(const bf16*)(ws + (which ? WS_VC : WS_KC)), (const bf16*)(ws + (which ? WS_PHIV : WS_PHIK)), 2048, 512, 1024}; pg8::StaticOrder S; S.init(2048, 512, G, which ? (bx + G - 16) % G : bx);
                pg8::EpiF32 E{(float*)(ws + (which ? WS_ULV : WS_ULK)), 512};
                pg8::gemm_phase<pg8::EpiF32, pg8::StaticOrder, false, true>(lds + RING_OFF, g, S, E); }
            phase_banded<512, false>(vcu, G, wave, lane, (const bf16*)(ws + WS_Q), (const bf16*)(ws + WS_KW), (const bf16*)(ws + WS_VWT), (bf16*)(ws + WS_OWIN), nullptr);
        } else if (phx == 12) {
            In I; load_in(I); phase_cmp2(I, ws, (LAS float*)(lds + wave * 1024), gw, NGW, lane);
        } else if (phx == 13) {
            for (int u = vcu; u < 1024; u += G) cmp_unit(ws, lds, (u >> 7) & 1, (u >> 5) & 3, ((u >> 8) << 5) | (u & 31), tid, wave, lane);
        } else if (phx == 14) {
            for (int i = 0; i * G + vcu < 1024; ++i) { const int u = i * G + vcu, bh = (u >> 5) & 7, x = u & 31, ii = u >> 8; const int tb = (ii & 1) ? 32 * ii + 31 - x : 32 * ii + x;
                sel_unit(ws, bh >> 2, bh & 3, tb, wave, lane); }
        } else if (cp == 0) {
            In I; load_in(I); pg8::Gemm g{(const bf16*)(ws + WS_ATT), (const bf16*)(ws + (layer ? WS_WO1 : WS_WO0)), NTOK, DM, DM}; pg8::StaticOrder S; S.init(NTOK, DM, G, bx);
            pg8::EpiWoRes E{layer ? (const float*)(ws + WS_XB) : I.x, (const float*)(ws + WS_MOD) + (size_t)layer * 2 * 12288 + 4096, 12288, outp, ALPHA_RES};
            pg8::gemm_phase<pg8::EpiWoRes, pg8::StaticOrder, false, true>(lds + RING_OFF, g, S, E);
        } else if (cp == 1) {
            In I; load_in(I); for (int rb = gw; rb < NTOK / 4; rb += NGW) phase_lnt(I, ws, (LAS float*)(lds + wave * 16384), layer, outp, rb, lane);
        } else if (cp == 2) {
            for (int rb = gw; rb < NTOK / 4; rb += NGW) phase_permute(ws, layer, rb, lane);
        } else if (cp == 3) {
            Seg sg; seg_load(sg, (const unsigned*)(ws + WS_CTL) + CW_CNT + layer * 16); pg8::GroupOrder S; build_units(S, sg, 4, G, bx);
            pg8::Gemm g{(const bf16*)(ws + WS_HPERM), (const bf16*)(ws + WS_W13) + (size_t)layer * 16 * 1024 * 2048, 0, 0, DM}; pg8::EpiUp E{(bf16*)(ws + WS_HE)};
            pg8::gemm_phase<pg8::EpiUp, pg8::GroupOrder, true, true>(lds + RING_OFF, g, S, E);
        } else if (cp == 4) {
            Seg sg; seg_load(sg, (const unsigned*)(ws + WS_CTL) + CW_CNT + layer * 16); pg8::GroupOrder S; build_units(S, sg, 8, G, bx);
            pg8::Gemm g{(const bf16*)(ws + WS_HE), (const bf16*)(ws + WS_W2) + (size_t)layer * 16 * 2048 * 512, 0, 0, DEXP}; pg8::EpiDown E{(bf16*)(ws + WS_YS), (const int*)(ws + WS_ROWTOK), (const float*)(ws + WS_ROWW)};
            pg8::gemm_phase<pg8::EpiDown, pg8::GroupOrder, true, true>(lds + RING_OFF, g, S, E);
        } else if (cp == 5) {
            In I; load_in(I); for (int rb = gw; rb < NTOK / 4; rb += NGW) phase_lnc(I, ws, layer, layer ? outp : (float*)(ws + WS_XB), layer == 0, rb, lane);
        }
        if (ph + 1 < hi) { XcdBarrier b2 = bar; asm volatile("" : "+s"(b2.bar)); xcd_barrier(b2); }
    }
}

extern "C" void kernel_launch(void* const* d_in, const int* in_sizes, int n_in, void* d_out, int out_size, void* d_ws, size_t ws_size, hipStream_t stream) {
    static int grid = 0;
    if (grid == 0) {
        if (n_in != 28 || in_sizes[0] != NTOK * DM || out_size != NTOK * DM || ws_size < WS_END) { fprintf(stderr, "kernel_launch: built for 28 inputs, x/out of %d floats, >= %zu bytes of workspace; got n_in %d, in0 %d, out %d, ws %zu; nothing launched\n", NTOK * DM, (size_t)WS_END, n_in, n_in > 0 ? in_sizes[0] : -1, out_size, ws_size); grid = -1; return; }
        int dev = 0, cus = 0, per_cu = 0;
        if (hipGetDevice(&dev) != hipSuccess || hipDeviceGetAttribute(&cus, hipDeviceAttributeMultiprocessorCount, dev) != hipSuccess) { fprintf(stderr, "kernel_launch: device query failed\n"); grid = -1; return; }
        if (hipFuncSetAttribute((const void*)hyb_fwd, hipFuncAttributeMaxDynamicSharedMemorySize, LDS_BYTES) != hipSuccess) { fprintf(stderr, "kernel_launch: hipFuncSetAttribute failed\n"); grid = -1; return; }
        if (hipOccupancyMaxActiveBlocksPerMultiprocessor(&per_cu, (const void*)hyb_fwd, NWAVES * 64, LDS_BYTES) != hipSuccess || per_cu < 1) { fprintf(stderr, "kernel_launch: occupancy query reports %d workgroups per CU\n", per_cu); }
        (void)hipGetLastError();
        grid = cus;
        if (grid != 256) fprintf(stderr, "kernel_launch: %d CUs (expected 256)\n", grid);
    }
    if (grid < 0) return;
    if (hipMemsetAsync((char*)d_ws + WS_CTL, 0, CTL_ZERO_BYTES, stream) != hipSuccess) { fprintf(stderr, "kernel_launch: memset failed\n"); return; }
    Args a{};
    for (int i = 0; i < 28; ++i) a.in[i] = d_in[i];
    a.out = (float*)d_out; a.ws = (unsigned char*)d_ws;
    for (int li = 0; li < N_LAUNCHES; ++li) {
        if (N_LAUNCHES == 1) { a.ph_lo = 0; a.ph_hi = NPHASE; } else { a.ph_lo = li; a.ph_hi = li + 1; }
        a.li = li;
        hipLaunchKernelGGL(hyb_fwd, dim3(grid), dim3(NWAVES * 64), LDS_BYTES, stream, a);
        const hipError_t le = hipPeekAtLastError();
        if (le != hipSuccess) { fprintf(stderr, "kernel_launch: launch %d failed: %s\n", li, hipGetErrorName(le)); break; }
    }
}
```

```cpp
#include <hip/hip_runtime.h>
#include <hip/hip_bf16.h>
#include <cstdio>
#include <cstdint>
#include <cmath>
namespace pg8 {
#define PG8_LAS __attribute__((address_space(3)))
typedef unsigned short bf16_t;
typedef short bf16x8 __attribute__((ext_vector_type(8)));
typedef float f32x4 __attribute__((ext_vector_type(4)));
typedef unsigned u32x4 __attribute__((ext_vector_type(4)));
constexpr int BM = 256, BK = 64, HALF = 128, HTB = HALF * BK * 2  , STAGE_BYTES = 8 * HTB, NXCD = 8, WGM = 8;

__host__ __device__ __forceinline__ int lds_byte(int r, int c) { const int st = (r >> 4) * 2 + (c >> 5), rr = r & 15, cc = c & 31, ob = rr * 64 + cc * 2; return st * 1024 + (ob ^ (((ob >> 9) & 1) << 5)); }
__host__ __device__ __forceinline__ void stage_rc(int b, int& R, int& C) { const int st = b / 1024, sb = b % 1024, swz = sb ^ (((sb >> 9) & 1) << 5); R = (st >> 1) * 16 + swz / 64; C = (st & 1) * 32 + (swz % 64) / 2; }
__host__ __device__ __forceinline__ int perm32(int rho) { const int n = rho >> 4, i = rho & 15; return 8 * (i >> 2) + 4 * n + (i & 3); }

struct Unit { int pm, pn, pnl, nvalid; };
struct Gemm { const bf16_t* A; const bf16_t* Bt; int M, N, K; const int* rowmap; };

struct StaticOrder {
    int nM, nN, nwg, G, c;
    __host__ __device__ void init(int M, int N, int G_, int c_) { nM = M / BM; nN = N / BM; nwg = nM * nN; G = G_; c = c_; }
    __host__ __device__ bool next(int i, Unit& u) const {
        const long L = (long)i * G + c; if (L >= nwg) return false;
        int wgid = (int)L; { const int q = nwg / NXCD, r = nwg % NXCD, xcd = wgid % NXCD, off = wgid / NXCD; wgid = (xcd < r ? xcd * (q + 1) : r * (q + 1) + (xcd - r) * q) + off; }
        const int nig = WGM * nN, gid = wgid / nig, fm = gid * WGM, gsz = (nM - fm) < WGM ? (nM - fm) : WGM;
        u.pm = fm + ((wgid % nig) % gsz); u.pn = (wgid % nig) / gsz; return true;
    }
    __device__ __forceinline__ void a_ready(const Unit&) const {}
    __device__ __forceinline__ void done(const Unit&) const {}
};
__device__ __forceinline__ unsigned cvt_pk_bf16(float lo, float hi) { unsigned r; asm volatile("v_cvt_pk_bf16_f32 %0, %1, %2" : "=v"(r) : "v"(lo), "v"(hi)); return r; }
typedef float f32x2 __attribute__((ext_vector_type(2)));
typedef unsigned u32x2 __attribute__((ext_vector_type(2)));
__device__ __forceinline__ float silu_f(float a) { return a * __builtin_amdgcn_rcpf(1.0f + __builtin_amdgcn_exp2f(-1.4426950408889634f * a)); }
__device__ __forceinline__ float sigmoid_f(float a) { return __builtin_amdgcn_rcpf(1.0f + __builtin_amdgcn_exp2f(-1.4426950408889634f * a)); }
__device__ __forceinline__ u32x4 pack8(const f32x4& a, const f32x4& b) { u32x4 w; w.x = cvt_pk_bf16(a[0], a[1]); w.y = cvt_pk_bf16(a[2], a[3]); w.z = cvt_pk_bf16(b[0], b[1]); w.w = cvt_pk_bf16(b[2], b[3]); return w; }
__device__ __forceinline__ unsigned short bf1(float v) { return (unsigned short)(cvt_pk_bf16(v, 0.f) & 0xffffu); }

__device__ __forceinline__ void rope8(f32x4& v0, f32x4& v1, const f32x4 (&cs)[4], int fq) {
    f32x4 p0, p1;
#pragma unroll
    for (int i = 0; i < 4; ++i) { p0[i] = __shfl_xor(v0[i], 16); p1[i] = __shfl_xor(v1[i], 16); }
    if (fq < 2) { const float sg = fq == 0 ? -1.f : 1.f; v0 = v0 * cs[0] + (p0 * cs[2]) * sg; v1 = v1 * cs[1] + (p1 * cs[3]) * sg; }
}
__device__ __forceinline__ void rope_ld(f32x4 (&cs)[4], const float* ropeRow, bool want) {
    if (want) { cs[0] = *(const f32x4*)(ropeRow); cs[1] = *(const f32x4*)(ropeRow + 4); cs[2] = *(const f32x4*)(ropeRow + 8); cs[3] = *(const f32x4*)(ropeRow + 12); }
}
__device__ __forceinline__ void store_vt8(bf16_t* VT, int b, int hk, int d0, int s, const f32x4& v0, const f32x4& v1) {
    bf16_t* p = VT + ((size_t)((b * 4 + hk) * 64 + d0)) * 4096 + s;
#pragma unroll
    for (int i = 0; i < 4; ++i) { p[(size_t)i * 4096] = bf1(v0[i]); p[(size_t)(i + 4) * 4096] = bf1(v1[i]); }
}

struct EpiQKV {
    static constexpr bool PERM = true, AFTER_DRAIN = false;
    bf16_t* Q; bf16_t* K; bf16_t* VT; const float* bias; const float* rope; float qscale;
    __device__ __forceinline__ void operator()(const f32x4 (&acc)[2][2][4][2], const Unit& u, int wr, int wc, int fr, int fq) const {
        const int pn = u.pn; const bool rot = (pn <= 8) && ((wc & 1) == 0);
        f32x4 bv[2][2];
#pragma unroll
        for (int bj = 0; bj < 2; ++bj)
#pragma unroll
            for (int n = 0; n < 2; ++n) bv[bj][n] = *(const f32x4*)(bias + pn * BM + bj * HALF + wc * 32 + 8 * fq + 4 * n);
        const bool wantr = rot && fq < 2; const int rowb = u.pm * BM + wr * 64 + fr;
        f32x4 cs[4] = {}; rope_ld(cs, rope + (size_t)rowb * 16, wantr);
#pragma unroll
        for (int ai = 0; ai < 2; ++ai)
#pragma unroll
            for (int m = 0; m < 4; ++m) {
                const int row = rowb + ai * HALF + m * 16, b = row >> 12, s = row & 4095;
                f32x4 w0[2], w1[2];
#pragma unroll
                for (int bj = 0; bj < 2; ++bj) { w0[bj] = acc[ai][bj][m][0] + bv[bj][0]; w1[bj] = acc[ai][bj][m][1] + bv[bj][1]; if (rot) rope8(w0[bj], w1[bj], cs, fq); }
                if (ai * 4 + m < 7) { const int nx = ai * 4 + m + 1; rope_ld(cs, rope + (size_t)(rowb + (nx >> 2) * HALF + (nx & 3) * 16) * 16, wantr); }
#pragma unroll
                for (int bj = 0; bj < 2; ++bj) {
                    const int col = bj * HALF + wc * 32 + 8 * fq;
                    f32x4 v0 = w0[bj], v1 = w1[bj];
                    if (pn < 8) { v0 = v0 * qscale; v1 = v1 * qscale; *(u32x4*)(Q + (size_t)row * 2048 + pn * BM + col) = pack8(v0, v1); }
                    else if (pn == 8) { *(u32x4*)(K + ((size_t)((b * 4 + (col >> 6)) * 4096 + s)) * 64 + (col & 63)) = pack8(v0, v1); }
                    else store_vt8(VT, b, col >> 6, col & 63, s, v0, v1);
                }
            }
    }
};
struct EpiNSA {
    static constexpr bool PERM = true, AFTER_DRAIN = false;
    bf16_t *QRAW, *QROT, *KC, *VC, *KS, *VST, *KW, *VWT; float* GATES; const float* rope; float qscale; int ablate;
    __device__ __forceinline__ void operator()(const f32x4 (&acc)[2][2][4][2], const Unit& u, int wr, int wc, int fr, int fq) const {
        if (ablate & 2) return;
        const int pn = u.pn; const bool rot = (pn < 8 || pn == 10 || pn == 12) && ((wc & 1) == 0);
        const bool wantr = rot && fq < 2; const int rowb = u.pm * BM + wr * 64 + fr;
        f32x4 cs[4] = {}; rope_ld(cs, rope + (size_t)rowb * 16, wantr);
#pragma unroll
        for (int ai = 0; ai < 2; ++ai)
#pragma unroll
            for (int m = 0; m < 4; ++m) {
                const int row = rowb + ai * HALF + m * 16, b = row >> 12, s = row & 4095;
                f32x4 w0[2], w1[2];
#pragma unroll
                for (int bj = 0; bj < 2; ++bj) { w0[bj] = acc[ai][bj][m][0]; w1[bj] = acc[ai][bj][m][1]; if (rot) rope8(w0[bj], w1[bj], cs, fq); }
                if (ai * 4 + m < 7) { const int nx = ai * 4 + m + 1; rope_ld(cs, rope + (size_t)(rowb + (nx >> 2) * HALF + (nx & 3) * 16) * 16, wantr); }
#pragma unroll
                for (int bj = 0; bj < 2; ++bj) {
                    const int col = bj * HALF + wc * 32 + 8 * fq;
                    f32x4 v0 = w0[bj], v1 = w1[bj];
                    if (pn < 8) { *(u32x4*)(QROT + (size_t)row * 2048 + pn * BM + col) = pack8(v0 * qscale, v1 * qscale); }
                    else if (pn == 8 || pn == 9 || pn == 10 || pn == 12) {
                        bf16_t* dst = pn == 8 ? KC : pn == 9 ? VC : pn == 10 ? KS : KW;
                        *(u32x4*)(dst + ((size_t)((b * 4 + (col >> 6)) * 4096 + s)) * 64 + (col & 63)) = pack8(v0, v1); }
                    else if ((pn == 11 || pn == 13) && (ablate & 1)) {}
                    else if (pn == 11 || pn == 13) store_vt8(pn == 11 ? VST : VWT, b, col >> 6, col & 63, s, v0, v1);
                    else if (col < 96) {
                        f32x4 g0, g1;
#pragma unroll
                        for (int i = 0; i < 4; ++i) { g0[i] = sigmoid_f(v0[i]); g1[i] = sigmoid_f(v1[i]); }
                        *(f32x4*)(GATES + (size_t)row * 96 + col) = g0; *(f32x4*)(GATES + (size_t)row * 96 + col + 4) = g1; }
                }
            }
    }
};
__device__ __forceinline__ float bf_lo(unsigned w) { return __uint_as_float(w << 16); }
__device__ __forceinline__ float bf_hi(unsigned w) { return __uint_as_float(w & 0xffff0000u); }
struct EpiWoRes {
    static constexpr bool PERM = true, AFTER_DRAIN = false;
    const float* x32; const bf16_t* x16; const float* gate; int gstride; bf16_t* Y; float alpha;
    __device__ __forceinline__ void operator()(const f32x4 (&acc)[2][2][4][2], const Unit& u, int wr, int wc, int fr, int fq) const {
        const int b = (u.pm * BM) >> 12; const int col0 = u.pn * BM + wc * 32 + 8 * fq;
        f32x4 gv[2][2];
#pragma unroll
        for (int bj = 0; bj < 2; ++bj)
#pragma unroll
            for (int n = 0; n < 2; ++n) gv[bj][n] = *(const f32x4*)(gate + (size_t)b * gstride + col0 + bj * HALF + n * 4);
#pragma unroll
        for (int ai = 0; ai < 2; ++ai)
#pragma unroll
            for (int m = 0; m < 4; ++m) { const size_t off = (size_t)(u.pm * BM + ai * HALF + wr * 64 + m * 16 + fr) * 2048 + col0;
#pragma unroll
                for (int bj = 0; bj < 2; ++bj) { f32x4 x0, x1;
                    if (x32) { x0 = *(const f32x4*)(x32 + off + bj * HALF); x1 = *(const f32x4*)(x32 + off + bj * HALF + 4); }
                    else { const u32x4 w = *(const u32x4*)(x16 + off + bj * HALF); x0 = (f32x4){bf_lo(w.x), bf_hi(w.x), bf_lo(w.y), bf_hi(w.y)}; x1 = (f32x4){bf_lo(w.z), bf_hi(w.z), bf_lo(w.w), bf_hi(w.w)}; }
                    *(u32x4*)(Y + off + bj * HALF) = pack8(x0 * alpha + gv[bj][0] * acc[ai][bj][m][0], x1 * alpha + gv[bj][1] * acc[ai][bj][m][1]); }
                if (m & 1) asm volatile("" ::: "memory"); }
    }
};
struct EpiF32 {
    static constexpr bool PERM = false, AFTER_DRAIN = false;
    float* O; int ldc;
    __device__ __forceinline__ void operator()(const f32x4 (&acc)[2][2][4][2], const Unit& u, int wr, int wc, int fr, int fq) const {
        const int col0 = u.pn * BM + wc * 32 + 4 * fq;
#pragma unroll
        for (int ai = 0; ai < 2; ++ai)
#pragma unroll
            for (int m = 0; m < 4; ++m) { const size_t off = (size_t)(u.pm * BM + ai * HALF + wr * 64 + m * 16 + fr) * ldc + col0;
#pragma unroll
                for (int bj = 0; bj < 2; ++bj)
#pragma unroll
                    for (int n = 0; n < 2; ++n) *(f32x4*)(O + off + bj * HALF + n * 16) = acc[ai][bj][m][n]; }
    }
};
struct EpiUp {
    static constexpr bool PERM = true, AFTER_DRAIN = false;
    bf16_t* HE;
    __device__ __forceinline__ void operator()(const f32x4 (&acc)[2][2][4][2], const Unit& u, int wr, int wc, int fr, int fq) const {
#pragma unroll
        for (int ai = 0; ai < 2; ++ai)
#pragma unroll
            for (int m = 0; m < 4; ++m) { const int row = u.pm * BM + ai * HALF + wr * 64 + m * 16 + fr; f32x4 h[2];
#pragma unroll
                for (int n = 0; n < 2; ++n)
#pragma unroll
                    for (int i = 0; i < 4; ++i) h[n][i] = silu_f(acc[ai][0][m][n][i]) * acc[ai][1][m][n][i];
                *(u32x4*)(HE + (size_t)row * 512 + u.pnl * HALF + wc * 32 + 8 * fq) = pack8(h[0], h[1]); }
    }
};
struct EpiDown {
    static constexpr bool PERM = true, AFTER_DRAIN = false;
    bf16_t* YS; const int* rowtok; const float* roww;
    __device__ __forceinline__ void operator()(const f32x4 (&acc)[2][2][4][2], const Unit& u, int wr, int wc, int fr, int fq) const {
#pragma unroll
        for (int ai = 0; ai < 2; ++ai)
#pragma unroll
            for (int m = 0; m < 4; ++m) { const int lrow = ai * HALF + wr * 64 + m * 16 + fr;
                if (lrow < u.nvalid) { const int grow = u.pm * BM + lrow; const int tk = rowtok[grow]; const float w = roww[grow];
#pragma unroll
                    for (int bj = 0; bj < 2; ++bj)
                        *(u32x4*)(YS + (size_t)tk * 2048 + u.pnl * BM + bj * HALF + wc * 32 + 8 * fq) = pack8(acc[ai][bj][m][0] * w, acc[ai][bj][m][1] * w); } }
    }
};
struct GroupOrder {
    unsigned cnt[16]; int nT, nN, G, c;
    __device__ __forceinline__ bool next(int i, Unit& u) const {
        const int nwg = nT * nN, L = i * G + c; if (L >= nwg) return false;
        const int q = nwg / 8, r = nwg % 8, xcd = L % 8, off = L / 8; const int wgid = (xcd < r ? xcd * (q + 1) : r * (q + 1) + (xcd - r) * q) + off;
        const int pm = wgid / nN, pnl = wgid % nN; int run = 0, ee = 0, nv = 0;
#pragma unroll
        for (int e = 0; e < 16; ++e) { const int te = (int)((cnt[e] + 255u) >> 8); if (pm >= run && pm < run + te) { ee = e; const int left = (int)cnt[e] - (pm - run) * 256; nv = left < 256 ? left : 256; } run += te; }
        u.pm = pm; u.pn = ee * nN + pnl; u.pnl = pnl; u.nvalid = nv; return true;
    }
    __device__ __forceinline__ void a_ready(const Unit&) const {}
    __device__ __forceinline__ void done(const Unit&) const {}
};
template <class Epi, class Sched, bool ALIGN_EPI = false, bool SP2 = false, bool GATHER = false>
__device__ __forceinline__ void gemm_phase(PG8_LAS unsigned char* lds, const Gemm g, const Sched& S, const Epi& E, int tid_in) {
    int tid_ = tid_in; asm volatile("" : "+v"(tid_)); const int tid = tid_, wid = __builtin_amdgcn_readfirstlane(tid >> 6), lane = tid & 63, wr = wid >> 2, wc = wid & 3, fr = lane & 15, fq = lane >> 4;
    const int K = g.K, nt = K / BK;
    unsigned voffA[2], voffB[2];
#pragma unroll
    for (int i = 0; i < 2; ++i) { int R, C; stage_rc(tid * 16 + i * 8192, R, C); const int Rb = Epi::PERM ? ((R & ~31) + perm32(R & 31)) : R;
        voffA[i] = (unsigned)(R * K + C) * 2u; voffB[i] = (unsigned)(Rb * K + C) * 2u; }
    static_assert(!GATHER || SP2, "GATHER is wired into the SP2 loop only");
    unsigned gc0[2] = {0u, 0u}, gc1[2] = {0u, 0u}, gn0[2] = {0u, 0u}, gn1[2] = {0u, 0u};
#define PG8_GOFF(pm_, o0, o1) do { _Pragma("unroll") for (int _i = 0; _i < 2; ++_i) { int R_, C_; stage_rc(tid * 16 + _i * 8192, R_, C_); \
        const int r0_ = g.rowmap[(pm_) * BM + R_], r1_ = g.rowmap[(pm_) * BM + HALF + R_]; o0[_i] = (unsigned)(r0_ * K + C_) * 2u; o1[_i] = (unsigned)(r1_ * K + C_) * 2u; } } while (0)
#define PG8_STAGE_A(bufoff, base, half, nx) do { if constexpr (GATHER) { unsigned vo_[2]; \
        vo_[0] = (nx) ? ((half) ? gn1[0] : gn0[0]) : ((half) ? gc1[0] : gc0[0]); vo_[1] = (nx) ? ((half) ? gn1[1] : gn0[1]) : ((half) ? gc1[1] : gc0[1]); PG8_STAGE(bufoff, base, vo_); } \
        else { PG8_STAGE(bufoff, (base) + ((half) ? hstep : (size_t)0), voffA); } } while (0)
    const size_t kstep = (size_t)(BK * 2);
    const size_t hstep = (size_t)HALF * K * 2;
    const size_t tstep = 2 * hstep;
    const unsigned ldsw = (unsigned)wid * 1024u;
    const int aoff = lds_byte(wr * 64 + fr, fq * 8), boff = lds_byte(wc * 32 + fr, fq * 8);
#define PG8_SA(b, h) (((b) * 2 + (h)) * HTB)
#define PG8_SB(b, h) ((4 + (b) * 2 + (h)) * HTB)
#define PG8_STAGE(bufoff, gbase, voff) do { _Pragma("unroll") for (int _i = 0; _i < 2; ++_i) \
        __builtin_amdgcn_global_load_lds((const unsigned*)((const char*)(gbase) + (voff)[_i]), (PG8_LAS unsigned*)(lds + (bufoff) + ldsw + _i * 8192), 16, 0, 0); } while (0)
#define PG8_LDA(dst, b, h) do { _Pragma("unroll") for (int m = 0; m < 4; ++m) _Pragma("unroll") for (int k = 0; k < 2; ++k) dst[m][k] = *(const PG8_LAS bf16x8*)(lds + PG8_SA(b, h) + aoff + m * 2048 + k * 1024); } while (0)
#define PG8_LDB(dst, b, h) do { _Pragma("unroll") for (int n = 0; n < 2; ++n) _Pragma("unroll") for (int k = 0; k < 2; ++k) dst[n][k] = *(const PG8_LAS bf16x8*)(lds + PG8_SB(b, h) + boff + n * 2048 + k * 1024); } while (0)
#define PG8_MMA(ai, bj, At, Bt) do { __builtin_amdgcn_s_setprio(1); _Pragma("unroll") for (int m = 0; m < 4; ++m) _Pragma("unroll") for (int n = 0; n < 2; ++n) _Pragma("unroll") for (int k = 0; k < 2; ++k) \
        acc[ai][bj][m][n] = __builtin_amdgcn_mfma_f32_16x16x32_bf16(Bt[n][k], At[m][k], acc[ai][bj][m][n], 0, 0, 0); __builtin_amdgcn_s_setprio(0); } while (0)
#define PG8_WAIT_V(n) asm volatile("s_waitcnt vmcnt(" #n ")" ::: "memory")
#define PG8_WAIT_L(n) asm volatile("s_waitcnt lgkmcnt(" #n ")" ::: "memory")
#define PG8_BAR __builtin_amdgcn_s_barrier()
#define PG8_SCHED __builtin_amdgcn_sched_barrier(0)
    Unit cur, nxt; int ui = 0;
    if (!S.next(0, cur)) return;
    f32x4 acc[2][2][4][2];
#pragma unroll
    for (int a = 0; a < 2; ++a)
#pragma unroll
        for (int b = 0; b < 2; ++b)
#pragma unroll
            for (int m = 0; m < 4; ++m)
#pragma unroll
                for (int n = 0; n < 2; ++n) acc[a][b][m][n] = (f32x4){0.f, 0.f, 0.f, 0.f};
    bf16x8 At[4][2], B0[2][2], B1[2][2];
    const char* cA = (const char*)g.A + (GATHER ? (size_t)0 : (size_t)cur.pm * tstep); const char* cB = (const char*)g.Bt + (size_t)cur.pn * tstep;
    S.a_ready(cur);
    if constexpr (SP2) {
        if constexpr (GATHER) PG8_GOFF(cur.pm, gc0, gc1);
        PG8_STAGE(PG8_SB(0, 0), cB, voffB); PG8_STAGE(PG8_SB(0, 1), cB + hstep, voffB); PG8_STAGE_A(PG8_SA(0, 0), cA, 0, false); PG8_STAGE_A(PG8_SA(0, 1), cA, 1, false);
        if (wr == 1) PG8_BAR;
        PG8_WAIT_V(2); PG8_BAR;
        PG8_STAGE(PG8_SB(1, 0), cB + kstep, voffB); PG8_STAGE_A(PG8_SA(1, 0), cA + kstep, 0, false); PG8_STAGE(PG8_SB(1, 1), cB + hstep + kstep, voffB);
        PG8_WAIT_V(6); PG8_BAR;
    } else {
        PG8_STAGE(PG8_SB(0, 0), cB, voffB); PG8_STAGE(PG8_SA(0, 0), cA, voffA); PG8_STAGE(PG8_SB(0, 1), cB + hstep, voffB); PG8_STAGE(PG8_SA(0, 1), cA + hstep, voffA);
        if (wr == 1) PG8_BAR;
        PG8_WAIT_V(4); PG8_BAR;
        PG8_STAGE(PG8_SB(1, 0), cB + kstep, voffB); PG8_STAGE(PG8_SA(1, 0), cA + kstep, voffA); PG8_STAGE(PG8_SB(1, 1), cB + hstep + kstep, voffB);
        PG8_WAIT_V(6); PG8_BAR;
    }
    for (;;) {
        const bool has_next = S.next(ui + 1, nxt);
        if constexpr (GATHER) { if (has_next) PG8_GOFF(nxt.pm, gn0, gn1); else { gn0[0] = gc0[0]; gn0[1] = gc0[1]; gn1[0] = gc1[0]; gn1[1] = gc1[1]; } }
        const char* nA = GATHER ? (const char*)g.A : (has_next ? (const char*)g.A + (size_t)nxt.pm * tstep : cA); const char* nB = has_next ? (const char*)g.Bt + (size_t)nxt.pn * tstep : cB;
        for (int t = 0; t < nt; t += 2) {
            const bool last = (t == nt - 2);
            const char* a1 = cA + (size_t)(t + 1) * kstep;
            const char* a2 = last ? nA : cA + (size_t)(t + 2) * kstep; const char* b2 = last ? nB : cB + (size_t)(t + 2) * kstep;
            const char* a3 = a2 + kstep; const char* b3 = b2 + kstep;
            if (last && has_next) S.a_ready(nxt);
            if constexpr (SP2) {
            PG8_LDB(B0, 0, 0); PG8_LDB(B1, 0, 1); PG8_SCHED; PG8_LDA(At, 0, 0); PG8_STAGE_A(PG8_SA(1, 1), a1, 1, false);
            PG8_WAIT_V(8); PG8_WAIT_L(0); PG8_BAR; PG8_MMA(0, 0, At, B0); PG8_MMA(0, 1, At, B1); PG8_BAR; PG8_SCHED;
            PG8_LDA(At, 0, 1); PG8_STAGE(PG8_SB(0, 0), b2, voffB); PG8_STAGE(PG8_SB(0, 1), b2 + hstep, voffB); PG8_STAGE_A(PG8_SA(0, 0), a2, 0, last);
            PG8_WAIT_V(8); PG8_WAIT_L(0); PG8_BAR; PG8_MMA(1, 0, At, B0); PG8_MMA(1, 1, At, B1); PG8_BAR; PG8_SCHED;
            PG8_LDB(B0, 1, 0); PG8_LDB(B1, 1, 1); PG8_SCHED; PG8_LDA(At, 1, 0); PG8_STAGE_A(PG8_SA(0, 1), a2, 1, last);
            PG8_WAIT_V(8); PG8_WAIT_L(0); PG8_BAR; PG8_MMA(0, 0, At, B0); PG8_MMA(0, 1, At, B1); PG8_BAR; PG8_SCHED;
            PG8_LDA(At, 1, 1); PG8_STAGE(PG8_SB(1, 0), b3, voffB); PG8_STAGE(PG8_SB(1, 1), b3 + hstep, voffB); PG8_STAGE_A(PG8_SA(1, 0), a3, 0, last);
            PG8_WAIT_V(8); PG8_WAIT_L(0); PG8_BAR; PG8_MMA(1, 0, At, B0); PG8_MMA(1, 1, At, B1); PG8_BAR; PG8_SCHED;
            } else {
            PG8_LDB(B0, 0, 0); PG8_SCHED; PG8_LDA(At, 0, 0); PG8_STAGE(PG8_SA(1, 1), a1 + hstep, voffA);
            PG8_WAIT_L(8); PG8_BAR; PG8_WAIT_L(0); PG8_MMA(0, 0, At, B0); PG8_BAR; PG8_SCHED;
            PG8_LDB(B1, 0, 1); PG8_STAGE(PG8_SB(0, 0), b2, voffB);
            PG8_BAR; PG8_WAIT_L(0); PG8_MMA(0, 1, At, B1); PG8_BAR;
            PG8_LDA(At, 0, 1); PG8_STAGE(PG8_SA(0, 0), a2, voffA);
            PG8_BAR; PG8_WAIT_L(0); PG8_MMA(1, 0, At, B0); PG8_BAR; PG8_SCHED;
            PG8_STAGE(PG8_SB(0, 1), b2 + hstep, voffB);
            PG8_WAIT_V(6); PG8_BAR; PG8_MMA(1, 1, At, B1); PG8_BAR;
            PG8_LDB(B0, 1, 0); PG8_SCHED; PG8_LDA(At, 1, 0); PG8_STAGE(PG8_SA(0, 1), a2 + hstep, voffA);
            PG8_WAIT_L(8); PG8_BAR; PG8_WAIT_L(0); PG8_MMA(0, 0, At, B0); PG8_BAR; PG8_SCHED;
            PG8_LDB(B1, 1, 1); PG8_STAGE(PG8_SB(1, 0), b3, voffB);
            PG8_BAR; PG8_WAIT_L(0); PG8_MMA(0, 1, At, B1); PG8_BAR;
            PG8_LDA(At, 1, 1); PG8_STAGE(PG8_SA(1, 0), a3, voffA);
            PG8_BAR; PG8_WAIT_L(0); PG8_MMA(1, 0, At, B0); PG8_BAR; PG8_SCHED;
            PG8_STAGE(PG8_SB(1, 1), b3 + hstep, voffB);
            PG8_WAIT_V(6); PG8_BAR; PG8_MMA(1, 1, At, B1); PG8_BAR;
            }
        }
        if constexpr (ALIGN_EPI) { if (wr == 0) PG8_BAR; }
        if constexpr (!Epi::AFTER_DRAIN) { E(acc, cur, wr, wc, fr, fq); S.done(cur); }
        if (!has_next) break;
#pragma unroll
        for (int a = 0; a < 2; ++a)
#pragma unroll
            for (int b = 0; b < 2; ++b)
#pragma unroll
                for (int m = 0; m < 4; ++m)
#pragma unroll
                    for (int n = 0; n < 2; ++n) acc[a][b][m][n] = (f32x4){0.f, 0.f, 0.f, 0.f};
        cur = nxt; cA = nA; cB = nB; ++ui;
        if constexpr (GATHER) { gc0[0] = gn0[0]; gc0[1] = gn0[1]; gc1[0] = gn1[0]; gc1[1] = gn1[1]; }
        if constexpr (ALIGN_EPI) { if (wr == 1) PG8_BAR; }
    }
    PG8_WAIT_V(0);
    if constexpr (!ALIGN_EPI) { if (wr == 0) PG8_BAR; }
    PG8_BAR;
    if constexpr (Epi::AFTER_DRAIN) { E.fused(acc, cur, wr, wc, fr, fq, lds, wid, lane); S.done(cur); }
#undef PG8_SA
#undef PG8_SB
#undef PG8_STAGE
#undef PG8_STAGE_A
#undef PG8_GOFF
#undef PG8_LDA
#undef PG8_LDB
#undef PG8_MMA
#undef PG8_WAIT_V
#undef PG8_WAIT_L
#undef PG8_BAR
#undef PG8_SCHED
}
}
#define GAS __attribute__((address_space(1)))
#define LAS __attribute__((address_space(3)))
typedef unsigned short bf16;
typedef unsigned v4u __attribute__((ext_vector_type(4)));
typedef float f32x4 __attribute__((ext_vector_type(4)));
typedef short bf16x8 __attribute__((ext_vector_type(8)));
typedef GAS unsigned gu32;
typedef GAS unsigned long long gu64;
#define RLX_AGENT __ATOMIC_RELAXED, __HIP_MEMORY_SCOPE_AGENT
#define LDS_WAIT() asm volatile("s_waitcnt lgkmcnt(0)" ::: "memory")
#define VM_WAIT() asm volatile("s_waitcnt vmcnt(0)" ::: "memory")
__device__ __forceinline__ unsigned long long rt() { return __builtin_amdgcn_s_memrealtime(); }
__device__ __forceinline__ unsigned f2bf(float f) { unsigned u = __builtin_bit_cast(unsigned, f); return (u + 0x7fffu + ((u >> 16) & 1u)) >> 16; }
__device__ __forceinline__ unsigned pk2(float lo, float hi) { return f2bf(lo) | (f2bf(hi) << 16); }
#define XB_TMO      128
#define XB_XCNT(j)  (256  + 64 * (j))
#define XB_XSUB(j)  (1280 + 64 * (j))
#define XB_XGEN(j)  (2304 + 64 * (j))
#define XB_TOP      3328
#define XB_TOPGEN   3392
#define XCD_BAR_WORDS 3456
#define XB_SPIN_CAP (1u << 18)

__device__ __forceinline__ unsigned xb_ld(unsigned* p)              { return __hip_atomic_load(p, __ATOMIC_RELAXED, __HIP_MEMORY_SCOPE_AGENT); }
__device__ __forceinline__ unsigned xb_add(unsigned* p, unsigned v) { return __hip_atomic_fetch_add(p, v, __ATOMIC_RELAXED, __HIP_MEMORY_SCOPE_AGENT); }
__device__ __forceinline__ unsigned xb_xcc_id() { return (unsigned)__builtin_amdgcn_s_getreg((3 << 11) | 20) & 0xFu; }
#define XB_SPIN(cond, bar) do { unsigned _sp = 0; while (cond) { __builtin_amdgcn_s_sleep(1); \
    if ((++_sp & 255u) == 0u) { if (xb_ld(&(bar)[XB_TMO])) break; if (_sp > XB_SPIN_CAP) { atomicAdd(&(bar)[XB_TMO], 1u); break; } } } } while (0)

struct XcdBarrier {
    unsigned* bar; unsigned x;
    volatile LAS unsigned* st;
};

__device__ __forceinline__ XcdBarrier xcd_barrier_post(unsigned* bar, volatile LAS unsigned* st, int tid) {
    XcdBarrier b; b.bar = bar; b.x = xb_xcc_id(); b.st = st;
    if (tid == 0) (void)xb_add(&bar[XB_XCNT(b.x)], 1u);
    return b;
}
__device__ __forceinline__ void xcd_barrier_complete(unsigned* bar, unsigned x, unsigned& nloc, unsigned& nx) {
    const unsigned G = gridDim.x * gridDim.y * gridDim.z;
    unsigned sum, cnt, mine, sp = 0u;
    for (;;) {
        sum = 0u; cnt = 0u; mine = 0u;
#pragma unroll
        for (unsigned j = 0; j < 16; ++j) { const unsigned c = xb_ld(&bar[XB_XCNT(j)]); sum += c; cnt += (c > 0u) ? 1u : 0u; mine = (j == x) ? c : mine; }
        if (sum == G) break;
        __builtin_amdgcn_s_sleep(1);
        if ((++sp & 255u) == 0u) { if (xb_ld(&bar[XB_TMO])) break; if (sp > XB_SPIN_CAP) { atomicAdd(&bar[XB_TMO], 1u); break; } }
    }
    nloc = mine > 0u ? mine : 1u; nx = cnt > 0u ? cnt : 1u;
}

__device__ __forceinline__ void xcd_barrier(const XcdBarrier& b, int tid) {
    asm volatile("s_waitcnt vmcnt(0)" ::: "memory");
    __syncthreads();
    if (tid == 0) {
        unsigned* bar = b.bar;
        __builtin_amdgcn_s_waitcnt(0);
        unsigned nloc = b.st[0], nx = b.st[1];
        if (nloc == 0u) { xcd_barrier_complete(bar, b.x, nloc, nx); b.st[0] = nloc; b.st[1] = nx; }
        const unsigned old = xb_add(&bar[XB_XSUB(b.x)], 1u);
        const unsigned gen = old / nloc;
        if (old + 1u == (gen + 1u) * nloc) {
            __builtin_amdgcn_fence(__ATOMIC_RELEASE, "agent");
            asm volatile("s_waitcnt vmcnt(0)" ::: "memory");
            const unsigned og = xb_add(&bar[XB_TOP], 1u);
            const unsigned tg = og / nx;
            if (og + 1u == (tg + 1u) * nx) xb_add(&bar[XB_TOPGEN], 1u);
            else XB_SPIN(xb_ld(&bar[XB_TOPGEN]) == tg, bar);
            __builtin_amdgcn_fence(__ATOMIC_ACQUIRE, "agent");
            xb_add(&bar[XB_XGEN(b.x)], 1u);
            asm volatile("s_waitcnt vmcnt(0)" ::: "memory");
        } else {
            XB_SPIN(xb_ld(&bar[XB_XGEN(b.x)]) == gen, bar);
            __builtin_amdgcn_fence(__ATOMIC_ACQUIRE, "agent");
            asm volatile("s_waitcnt vmcnt(0)" ::: "memory");
        }
    }
    __syncthreads();
}
namespace fa {
typedef short bf16x8 __attribute__((ext_vector_type(8)));
typedef float f32x16 __attribute__((ext_vector_type(16)));
typedef float f32x2_t __attribute__((ext_vector_type(2))); typedef __bf16 bf16x2_t __attribute__((ext_vector_type(2)));
typedef unsigned u32x4 __attribute__((ext_vector_type(4)));
typedef unsigned u32x2 __attribute__((ext_vector_type(2)));
__device__ __forceinline__ unsigned cvtpk(float lo, float hi) { f32x2_t v = {lo, hi}; bf16x2_t b = __builtin_convertvector(v, bf16x2_t); return __builtin_bit_cast(unsigned, b); }
__device__ __forceinline__ int kap(int r32) { return (r32 & ~12) | ((r32 & 4) << 1) | ((r32 & 8) >> 1); }
__device__ __forceinline__ float xmax(float v) { auto rr = __builtin_amdgcn_permlane32_swap(__float_as_uint(v), __float_as_uint(v), false, false); return fmaxf(__uint_as_float(rr[0]), __uint_as_float(rr[1])); }
__device__ __forceinline__ float xsum(float v) { auto rr = __builtin_amdgcn_permlane32_swap(__float_as_uint(v), __float_as_uint(v), false, false); return __uint_as_float(rr[0]) + __uint_as_float(rr[1]); }
constexpr float NEGBIG = -1e30f;

struct Frag { bf16x8 k[4]; bf16x8 v[4]; };
struct State { f32x16 o0, o1; float m, l; };

__device__ __forceinline__ void load_tile(Frag& f, const bf16* Kbh, const bf16* Vbh, int VP, int key0, int r32, int hi) {
    const bf16* kp = Kbh + (size_t)(key0 + kap(r32)) * 64 + hi * 8;
#pragma unroll
    for (int d0 = 0; d0 < 4; ++d0) f.k[d0] = *(const bf16x8*)(kp + d0 * 16);
    const bf16* vp = Vbh + (size_t)r32 * VP + key0 + hi * 8;
#pragma unroll
    for (int db = 0; db < 2; ++db)
#pragma unroll
        for (int s = 0; s < 2; ++s) f.v[db * 2 + s] = *(const bf16x8*)(vp + (size_t)db * 32 * VP + s * 16);
}
__device__ __forceinline__ void load_v(Frag& f, const bf16* Vbh, int VP, int key0, int r32, int hi) {
    const bf16* vp = Vbh + (size_t)r32 * VP + key0 + hi * 8;
#pragma unroll
    for (int db = 0; db < 2; ++db)
#pragma unroll
        for (int s = 0; s < 2; ++s) f.v[db * 2 + s] = *(const bf16x8*)(vp + (size_t)db * 32 * VP + s * 16);
}
__device__ __forceinline__ void load_k(Frag& f, const bf16* Kbh, int key0, int r32, int hi) {
    const bf16* kp = Kbh + (size_t)(key0 + kap(r32)) * 64 + hi * 8;
#pragma unroll
    for (int d0 = 0; d0 < 4; ++d0) f.k[d0] = *(const bf16x8*)(kp + d0 * 16);
}
__device__ __forceinline__ void scores(f32x16& p, const Frag& f, const bf16x8 (&qr)[4]) {
    p = f32x16{};
#pragma unroll
    for (int d0 = 0; d0 < 4; ++d0) p = __builtin_amdgcn_mfma_f32_32x32x16_bf16(f.k[d0], qr[d0], p, 0, 0, 0);
}
__device__ __forceinline__ void mask_range(f32x16& p, int key0, int hi, int lo, int hi_) {
#pragma unroll
    for (int r = 0; r < 16; ++r) { const int kpos = key0 + 16 * (r >> 3) + 8 * hi + (r & 7); p[r] = (kpos >= lo && kpos <= hi_) ? p[r] : -INFINITY; }
}
__device__ __forceinline__ void step(State& st, const Frag& f, const bf16x8 (&qr)[4], int key0, int hi, bool need_mask, int lo, int hi_) {
    f32x16 p; scores(p, f, qr);
    if (need_mask) mask_range(p, key0, hi, lo, hi_);
    float tm = fmaxf(p[0], p[1]);
#pragma unroll
    for (int r = 2; r < 16; ++r) tm = fmaxf(tm, p[r]);
    tm = xmax(tm);
    const float mn = fmaxf(st.m, tm); const float alpha = __builtin_amdgcn_exp2f(st.m - mn); st.m = mn;
    float rs = 0.f;
#pragma unroll
    for (int r = 0; r < 16; ++r) { p[r] = __builtin_amdgcn_exp2f(p[r] - mn); rs += p[r]; }
    st.l = st.l * alpha + rs;
    if (!__all(alpha == 1.0f)) { st.o0 = st.o0 * alpha; st.o1 = st.o1 * alpha; }
    u32x4 w0, w1;
    w0.x = cvtpk(p[0], p[1]); w0.y = cvtpk(p[2], p[3]); w0.z = cvtpk(p[4], p[5]); w0.w = cvtpk(p[6], p[7]);
    w1.x = cvtpk(p[8], p[9]); w1.y = cvtpk(p[10], p[11]); w1.z = cvtpk(p[12], p[13]); w1.w = cvtpk(p[14], p[15]);
    const bf16x8 pb0 = __builtin_bit_cast(bf16x8, w0), pb1 = __builtin_bit_cast(bf16x8, w1);
    st.o0 = __builtin_amdgcn_mfma_f32_32x32x16_bf16(f.v[0], pb0, st.o0, 0, 0, 0);
    st.o0 = __builtin_amdgcn_mfma_f32_32x32x16_bf16(f.v[1], pb1, st.o0, 0, 0, 0);
    st.o1 = __builtin_amdgcn_mfma_f32_32x32x16_bf16(f.v[2], pb0, st.o1, 0, 0, 0);
    st.o1 = __builtin_amdgcn_mfma_f32_32x32x16_bf16(f.v[3], pb1, st.o1, 0, 0, 0);
}
__device__ __forceinline__ void load_q(bf16x8 (&qr)[4], const bf16* Qrow  , int hi) {
#pragma unroll
    for (int d0 = 0; d0 < 4; ++d0) qr[d0] = *(const bf16x8*)(Qrow + d0 * 16 + hi * 8);
}
__device__ __forceinline__ float finish(State& st) { const float lt = xsum(st.l); return lt > 0.f ? 1.0f / lt : 0.f; }
__device__ __forceinline__ void store_o(const State& st, float inv, bf16* Orow  , int hi) {
#pragma unroll
    for (int g = 0; g < 4; ++g) {
        u32x2 a, b; a.x = cvtpk(st.o0[4 * g] * inv, st.o0[4 * g + 1] * inv); a.y = cvtpk(st.o0[4 * g + 2] * inv, st.o0[4 * g + 3] * inv);
        b.x = cvtpk(st.o1[4 * g] * inv, st.o1[4 * g + 1] * inv); b.y = cvtpk(st.o1[4 * g + 2] * inv, st.o1[4 * g + 3] * inv);
        *(u32x2*)(Orow + 8 * g + 4 * hi) = a; *(u32x2*)(Orow + 32 + 8 * g + 4 * hi) = b; }
}
__device__ __forceinline__ float bflo(unsigned w) { return __uint_as_float(w << 16); }
__device__ __forceinline__ float bfhi(unsigned w) { return __uint_as_float(w & 0xffff0000u); }
}
constexpr int NWAVES = 8;
constexpr int NB = 2, SEQ = 4096, DM = 2048, NTOK = NB * SEQ, NEXP = 16, DEXP = 512;
constexpr float ALPHA_RES = 1.4142135623730951f;
constexpr float LN_EPS = 1e-5f;
constexpr float QSCALE = 0.125f * 1.4426950408889634f;
constexpr float LOG2E = 1.4426950408889634f;
constexpr int NPHASE = 21;
#ifndef MK_N_LAUNCHES
#define MK_N_LAUNCHES 1
#endif
constexpr int N_LAUNCHES = MK_N_LAUNCHES;

constexpr size_t MiB = 1u << 20, KiB = 1u << 10;
constexpr size_t WS_CTL = 0, CTL_ZERO_BYTES = 32 * KiB;
constexpr size_t WS_MODP = 1 * MiB;
constexpr size_t WS_MOD = 4 * MiB;
constexpr size_t WS_ROPE = 4 * MiB + 512 * KiB;
constexpr size_t WS_CMPB = 5 * MiB;
constexpr size_t WS_TOKE = 5 * MiB + 256 * KiB;
constexpr size_t WS_TOKW = WS_TOKE + 64 * KiB;
constexpr size_t WS_TOKS = WS_TOKW + 64 * KiB;
constexpr size_t WS_ROWTOK = 5 * MiB + 512 * KiB;
constexpr size_t WS_ROWW = WS_ROWTOK + 128 * KiB;
constexpr size_t WS_BCNT = WS_ROWW + 128 * KiB;
constexpr size_t WS_ROWSRC = WS_BCNT + 64 * KiB;
constexpr size_t WS_SELM = 6 * MiB;
constexpr size_t WS_KCMP = 6 * MiB + 256 * KiB;
constexpr size_t WS_VCMPT = 6 * MiB + 512 * KiB;
constexpr size_t WS_GATES = 7 * MiB;
constexpr size_t WS_ULK = 10 * MiB, WS_ULV = 14 * MiB;
constexpr size_t WS_WQKV = 18 * MiB, WS_WO0 = 28 * MiB, WS_WIN = 36 * MiB, WS_WO1 = 51 * MiB, WS_PHIK = 59 * MiB, WS_PHIV = 60 * MiB;
constexpr size_t WS_W13 = 64 * MiB;
constexpr size_t WS_W2 = 192 * MiB;
constexpr size_t WS_H = 256 * MiB;
constexpr size_t WS_XA = 288 * MiB, WS_Y = 320 * MiB, WS_XB = 352 * MiB;
constexpr size_t WS_Q = 416 * MiB, WS_QRAW = 448 * MiB, WS_ATT = 480 * MiB;
constexpr size_t WS_HPERM = 416 * MiB;
constexpr size_t WS_OCMP = 512 * MiB, WS_OWIN = 544 * MiB;
constexpr size_t WS_K0 = 576 * MiB, WS_VT0 = 580 * MiB, WS_KC = 584 * MiB, WS_VC = 588 * MiB, WS_KS = 592 * MiB, WS_VST = 596 * MiB, WS_KW = 600 * MiB, WS_VWT = 604 * MiB;
constexpr size_t WS_HE = 608 * MiB;
constexpr size_t WS_YS = 628 * MiB;
constexpr size_t WS_END = 692 * MiB;
constexpr int CW_TMO = 0, CW_CODE = 1;
constexpr int CW_DONE = 512;
constexpr int CW_FQ = 128;
constexpr int CW_CNT = 64;
constexpr int CW_BAR = 4096;

constexpr int RING_OFF = 0, RING_BYTES = 131072;
constexpr int LDSCTL_OFF = RING_BYTES, MISC_OFF = LDSCTL_OFF + 320;
constexpr int LDS_BYTES = 147456;
typedef float f32x16g __attribute__((ext_vector_type(16)));
typedef unsigned u32x2g __attribute__((ext_vector_type(2)));
__device__ __forceinline__ float wave_sum(float v) {
#pragma unroll
    for (int o = 1; o < 64; o <<= 1) v += __shfl_xor(v, o);
    return v;
}
__device__ __forceinline__ unsigned ld_u32_agent(const unsigned* p) { return __hip_atomic_load(p, __ATOMIC_RELAXED, __HIP_MEMORY_SCOPE_AGENT); }

__device__ __forceinline__ void transpose_item(const float* W, int ldw, bf16* WT, int ldt, int k0, int n0, int drow0, LAS float* scr, int lane) {
    float t[32]; const float* wp = W + (size_t)(k0 + (lane >> 5)) * ldw + n0 + (lane & 31);
#pragma unroll
    for (int i = 0; i < 32; ++i) t[i] = __builtin_nontemporal_load(wp + (size_t)(2 * i) * ldw);
#pragma unroll
    for (int i = 0; i < 32; ++i) scr[(2 * i + (lane >> 5)) * 33 + (lane & 31)] = t[i];
    LDS_WAIT(); asm volatile("" ::: "memory");
    const int c = lane & 7;
#pragma unroll
    for (int j = 0; j < 4; ++j) { const int n = (lane >> 3) + 8 * j; const LAS float* s = scr + (8 * c) * 33 + n;
        v4u o; o.x = pk2(s[0 * 33], s[1 * 33]); o.y = pk2(s[2 * 33], s[3 * 33]); o.z = pk2(s[4 * 33], s[5 * 33]); o.w = pk2(s[6 * 33], s[7 * 33]);
        *(GAS v4u*)(WT + (size_t)(drow0 + n) * ldt + k0 + 8 * c) = o; }
    LDS_WAIT(); asm volatile("" ::: "memory");
}

__device__ __forceinline__ void phase_mod_partial(const float* c, const float* w_ada, float* modp, LAS float* scr, int gw, int NGW, int lane) {
    for (int task = gw; task < 1536; task += NGW) {
        const int ks = task & 15, chunk = (task >> 4) % 48, layer = task / 768, k0 = ks * 128;
        for (int i = lane; i < 256; i += 64) { const float v = c[(i >> 7) * DM + k0 + (i & 127)]; scr[i] = v / (1.0f + __expf(-v)); }
        LDS_WAIT(); asm volatile("" ::: "memory");
        const float* wp = w_ada + ((size_t)layer * DM + k0) * 12288 + chunk * 256 + lane * 4;
        f32x4 a0 = {0.f, 0.f, 0.f, 0.f}, a1 = {0.f, 0.f, 0.f, 0.f};
#pragma unroll 8
        for (int k = 0; k < 128; ++k) { const f32x4 w = __builtin_nontemporal_load((const f32x4*)(wp + (size_t)k * 12288)); const float s0 = scr[k], s1 = scr[128 + k]; a0 += w * s0; a1 += w * s1; }
        float* o = modp + ((size_t)((ks * 2 + layer) * 2) * 12288) + chunk * 256 + lane * 4;
        *(f32x4*)o = a0; *(f32x4*)(o + 12288) = a1;
        LDS_WAIT(); asm volatile("" ::: "memory");
    }
}
__device__ __forceinline__ void rope_table(const int* positions, float* rope, int gtid, int nthr) {
    for (int idx = gtid; idx < NTOK * 8; idx += nthr) {
        const int tok = idx >> 3, i = idx & 7;
        const double invf = i == 0 ? 1.0 : i == 1 ? 0.19392274474868576 : i == 2 ? 0.03760603093086393 : i == 3 ? 0.007292664737217109 : i == 4 ? 0.001414213562373095 : i == 5 ? 0.0002742481756762073 : i == 6 ? 5.318295896944988e-05 : 1.031338537721246e-05;
        const double a = (double)positions[tok] * invf;
        const double kq = __builtin_rint(a * 0.6366197723675814);
        double r = __builtin_fma(-kq, 1.5707963267948966, a); r = __builtin_fma(-kq, 6.123233995736766e-17, r);
        const double r2 = r * r;
        double sn = 1.0 / 6227020800.0; sn = sn * r2 - 1.0 / 39916800.0; sn = sn * r2 + 1.0 / 362880.0; sn = sn * r2 - 1.0 / 5040.0; sn = sn * r2 + 1.0 / 120.0; sn = sn * r2 - 1.0 / 6.0; sn = sn * r2 + 1.0; sn *= r;
        double cs = -1.0 / 87178291200.0; cs = cs * r2 + 1.0 / 479001600.0; cs = cs * r2 - 1.0 / 3628800.0; cs = cs * r2 + 1.0 / 40320.0; cs = cs * r2 - 1.0 / 720.0; cs = cs * r2 + 1.0 / 24.0; cs = cs * r2 - 0.5; cs = cs * r2 + 1.0;
        const int q = ((int)(long long)kq) & 3;
        const double co = q == 0 ? cs : q == 1 ? -sn : q == 2 ? -cs : sn, si = q == 0 ? sn : q == 1 ? cs : q == 2 ? -sn : -cs;
        rope[(size_t)tok * 16 + i] = (float)co; rope[(size_t)tok * 16 + 8 + i] = (float)si;
    }
}

__device__ __forceinline__ void modulate_row_lds(const float* xrow, const LAS float* sh, const LAS float* sc, bf16* orow, int lane) {
    const GAS f32x4* xr = (const GAS f32x4*)xrow + lane; GAS unsigned long long* o8 = (GAS unsigned long long*)orow + lane;
#pragma unroll
    for (int j = 0; j < 8; ++j) { const f32x4 v = xr[64 * j]; const f32x4 s = *(const LAS f32x4*)(sc + 256 * j + 4 * lane), h = *(const LAS f32x4*)(sh + 256 * j + 4 * lane);
        const f32x4 o = v * (s + 1.0f) + h; o8[64 * j] = (unsigned long long)pk2(o.x, o.y) | ((unsigned long long)pk2(o.z, o.w) << 32); }
}

struct In {
    const float *x, *c; const int* positions; const float *w_ada, *b_ada, *swa_w_qkv, *swa_b_qkv, *swa_sinks, *swa_w_o, *nsa_w_in, *nsa_pe_k, *nsa_pe_v, *nsa_phi_k1, *nsa_phi_k2, *nsa_phi_v1, *nsa_phi_v2, *nsa_w_o,
        *moe_w_group, *moe_b_group, *moe_w_router, *moe_b_router, *moe_w1, *moe_w3, *moe_w2, *ln_t_g, *ln_t_b, *ln_c_g, *ln_c_b;
};

constexpr int CV_QKV = 32 * 80, CV_WO = 32 * 64, CV_WIN = 32 * 115, CV_PHI = 16 * 8, CV_MOE = 16 * 3 * 512;
constexpr int CV_A = CV_QKV + CV_WO;
constexpr int CV_B = CV_A + CV_MOE;
constexpr int CV_C = CV_B + CV_WIN + CV_WO + 4 * CV_PHI;
constexpr int CV_D = CV_C + CV_MOE;
__device__ __forceinline__ void conv_moe_item(const In& I, unsigned char* ws, int layer, int r, LAS float* scr, int lane) {
    if (r < 16 * 2 * 512) { const int mat = r / 512, q = r % 512, le = layer * 16 + (mat >> 1), which = mat & 1;
        const int n0 = 32 * (q % 16);
        transpose_item((which ? I.moe_w3 : I.moe_w1) + (size_t)le * 2048 * 512, 512, (bf16*)(ws + WS_W13) + (size_t)le * 1024 * 2048, 2048, 64 * (q / 16), n0, (n0 >> 7) * 256 + which * 128 + (n0 & 127), scr, lane); return; }
    r -= 16 * 2 * 512;
    { const int le = layer * 16 + r / 512, q = r % 512;
      transpose_item(I.moe_w2 + (size_t)le * 512 * 2048, 2048, (bf16*)(ws + WS_W2) + (size_t)le * 2048 * 512, 512, 64 * (q / 64), 32 * (q % 64), 32 * (q % 64), scr, lane); }
}
__device__ __forceinline__ void conv_item(const In& I, unsigned char* ws, int it, LAS float* scr, int lane) {
    int r = it;
    if (r < CV_QKV) { transpose_item(I.swa_w_qkv, 2560, (bf16*)(ws + WS_WQKV), 2048, 64 * (r / 80), 32 * (r % 80), 32 * (r % 80), scr, lane); return; } r -= CV_QKV;
    if (r < CV_WO) { transpose_item(I.swa_w_o, 2048, (bf16*)(ws + WS_WO0), 2048, 64 * (r / 64), 32 * (r % 64), 32 * (r % 64), scr, lane); return; } r -= CV_WO;
    if (r < CV_MOE) { conv_moe_item(I, ws, 0, r, scr, lane); return; } r -= CV_MOE;
    if (r < CV_WIN) { transpose_item(I.nsa_w_in, 3680, (bf16*)(ws + WS_WIN), 2048, 64 * (r / 115), 32 * (r % 115), 32 * (r % 115), scr, lane); return; } r -= CV_WIN;
    if (r < CV_WO) { transpose_item(I.nsa_w_o, 2048, (bf16*)(ws + WS_WO1), 2048, 64 * (r / 64), 32 * (r % 64), 32 * (r % 64), scr, lane); return; } r -= CV_WO;
    if (r < 4 * CV_PHI) { const int j = r / CV_PHI, q = r % CV_PHI, which = j >> 1, half = j & 1;
        transpose_item((which ? I.nsa_phi_v1 : I.nsa_phi_k1) + (size_t)half * 1024 * 256, 256, (bf16*)(ws + (which ? WS_PHIV : WS_PHIK)), 1024, 64 * (q / 8), 32 * (q % 8), half * 256 + 32 * (q % 8), scr, lane); return; }
    r -= 4 * CV_PHI;
    if (r < CV_MOE) conv_moe_item(I, ws, 1, r, scr, lane);
}
__device__ __forceinline__ bool conv_batch(const In& I, unsigned char* ws, LAS unsigned char* lds, int limit, const unsigned* donew, unsigned done_target, int tid, int wave, int lane) {
    volatile LAS int* sb = (volatile LAS int*)(lds + 131072 + 2048);
    if (tid == 0) { const bool stop = donew && ld_u32_agent(donew) >= done_target;
        sb[0] = stop ? 0x7fffffff : (int)atomicAdd((unsigned*)(ws + WS_CTL) + CW_FQ, 8u); }
    LDS_WAIT(); __syncthreads();
    const int sv = sb[0];
    __syncthreads();
    if (sv == 0x7fffffff) return false;
    const int base = CV_A + sv, it = base + wave;
    if (it < CV_D) conv_item(I, ws, it, (LAS float*)(lds + wave * 16384), lane);
    return base < limit;
}
__device__ __forceinline__ void conv_fill(const In& I, unsigned char* ws, LAS unsigned char* lds, int slot, int G, int tid, int wave, int lane) {
    unsigned* donew = (unsigned*)(ws + WS_CTL) + CW_DONE + 64 * slot;
    if (tid == 0) atomicAdd(donew, 1u);
    for (int n = 0; n < 64; ++n) if (!conv_batch(I, ws, lds, CV_D, donew, (unsigned)G, tid, wave, lane)) break;
    __syncthreads();
}
__device__ __forceinline__ void conv_drain(const In& I, unsigned char* ws, LAS unsigned char* lds, int limit, int tid, int wave, int lane) {
    while (conv_batch(I, ws, lds, limit, nullptr, 0u, tid, wave, lane)) {}
    __syncthreads();
}

__device__ __forceinline__ void phase_prologue(const In& I, unsigned char* ws, LAS unsigned char* lds, int tid, int lane, int wave, int vcu, int G) {
    const float* modp = (const float*)(ws + WS_MODP); float* mod = (float*)(ws + WS_MOD);
    LAS float* msm = (LAS float*)(lds + 65536);
#pragma unroll 1
    for (int it = 0; it < 2; ++it) {
        f32x4 pv[2][16];
#pragma unroll
        for (int u = 0; u < 2; ++u) { const int i4 = tid + (NWAVES * 64) * (2 * it + u), b = i4 >> 10, col = (i4 & 1023) * 4;
#pragma unroll
            for (int ks = 0; ks < 16; ++ks) pv[u][ks] = *(const f32x4*)(modp + (size_t)((ks * 2 + 0) * 2 + b) * 12288 + col); }
#pragma unroll
        for (int u = 0; u < 2; ++u) { const int i4 = tid + (NWAVES * 64) * (2 * it + u), col = (i4 & 1023) * 4; f32x4 sacc = *(const f32x4*)(I.b_ada + col);
#pragma unroll
            for (int ks = 0; ks < 16; ++ks) sacc += pv[u][ks];
            *(LAS f32x4*)(msm + 4 * i4) = sacc; } }
    { const int gidx = vcu * 192 + tid;
      if (tid < 192 && gidx < 2 * 2 * 12288) { const int layer = gidx / 24576, rem = gidx % 24576, b = rem / 12288, col = rem % 12288; float s = I.b_ada[layer * 12288 + col];
#pragma unroll
          for (int ks = 0; ks < 16; ++ks) s += modp[(size_t)((ks * 2 + layer) * 2 + b) * 12288 + col];
          mod[gidx] = s; } }
    __syncthreads();
    const int gw = vcu * NWAVES + wave, NGW = G * NWAVES;
    bf16* H = (bf16*)(ws + WS_H);
    for (int m0 = gw; m0 < NTOK; m0 += 4 * NGW) {
        f32x4 xv[4][8];
#pragma unroll
        for (int r = 0; r < 4; ++r) { const int m = m0 + r * NGW; if (m < NTOK) { const GAS f32x4* xr = (const GAS f32x4*)(I.x + (size_t)m * DM) + lane;
#pragma unroll
            for (int j = 0; j < 8; ++j) xv[r][j] = __builtin_nontemporal_load(xr + 64 * j); } }
#pragma unroll
        for (int r = 0; r < 4; ++r) { const int m = m0 + r * NGW; if (m < NTOK) { const int b = m >> 12; const LAS float* sh = msm + b * 4096; const LAS float* sc = sh + 2048;
            GAS unsigned long long* o8 = (GAS unsigned long long*)(H + (size_t)m * DM) + lane;
#pragma unroll
            for (int j = 0; j < 8; ++j) { const f32x4 sv = *(const LAS f32x4*)(sc + 256 * j + 4 * lane), hv = *(const LAS f32x4*)(sh + 256 * j + 4 * lane);
                const f32x4 o = xv[r][j] * (sv + 1.0f) + hv; o8[64 * j] = (unsigned long long)pk2(o.x, o.y) | ((unsigned long long)pk2(o.z, o.w) << 32); } } }
    }
    if (gw < 512) { const int which = gw >> 8, cc = gw & 255; const float* pe = which ? I.nsa_pe_v : I.nsa_pe_k; const float* phi = which ? I.nsa_phi_v1 : I.nsa_phi_k1; float s = 0.f;
#pragma unroll 4
        for (int i = 0; i < 32; ++i) { const int k = lane + 64 * i; s += pe[k] * phi[(size_t)k * 256 + cc]; }
        s = wave_sum(s); if (lane == 0) ((float*)(ws + WS_CMPB))[which * 256 + cc] = s; }
    __syncthreads();
    LAS float* scr = (LAS float*)(lds + wave * 16384);
    for (int it = gw; it < CV_A; it += NGW) conv_item(I, ws, it, scr, lane);
}

template <int W, bool SINK>
__device__ __forceinline__ void banded_unit(int b, int hkv, int tb, int g, int lane, const bf16* Q, const bf16* K, const bf16* VT, bf16* OUT, const float* sinks) {
    const int r32 = lane & 31, hi = lane >> 5, head = hkv * 8 + g, q0 = tb * 32, t = q0 + r32;
    const size_t row = (size_t)b * SEQ + t;
    fa::bf16x8 qr[4]; fa::load_q(qr, Q + row * DM + head * 64, hi);
    const bf16* Kbh = K + (size_t)(b * 4 + hkv) * SEQ * 64; const bf16* Vbh = VT + (size_t)(b * 4 + hkv) * 64 * SEQ;
    fa::State st; st.o0 = fa::f32x16{}; st.o1 = fa::f32x16{};
    if (SINK) { st.m = sinks[head] * LOG2E; st.l = hi == 0 ? 1.0f : 0.0f; } else { st.m = fa::NEGBIG; st.l = 0.f; }
    const int ktA = tb - W / 32 > 0 ? tb - W / 32 : 0;
    fa::Frag fc, fn; fa::load_tile(fc, Kbh, Vbh, SEQ, ktA * 32, r32, hi);
    for (int kt = ktA; kt <= tb; ++kt) {
        if (kt < tb) fa::load_tile(fn, Kbh, Vbh, SEQ, (kt + 1) * 32, r32, hi);
        const bool nm = (kt == tb) || (kt == tb - W / 32);
        fa::step(st, fc, qr, kt * 32, hi, nm, t - W + 1, t);
        fc = fn;
    }
    const float inv = fa::finish(st);
    fa::store_o(st, inv, OUT + row * DM + head * 64, hi);
}
template <int W, bool SINK>
__device__ __forceinline__ void phase_banded(int vcu, int G, int wave, int lane, const bf16* Q, const bf16* K, const bf16* VT, bf16* OUT, const float* sinks) {
    for (int u = vcu; u < 1024; u += G) { const int bh = (u >> 5) & 7, tb = ((u >> 8) << 5) | (u & 31); banded_unit<W, SINK>(bh >> 2, bh & 3, tb, wave, lane, Q, K, VT, OUT, sinks); }
}

__device__ __forceinline__ void phase_lnt(const In& I, unsigned char* ws, LAS unsigned char* wsm  , LAS int* esm  , int layer, const bf16* Y, int gw, int lane_in, int tid, int vcu) {
    const float* mod = (const float*)(ws + WS_MOD); bf16* XA = (bf16*)(ws + WS_XA); bf16* H = (bf16*)(ws + WS_H);
    const float* lng = I.ln_t_g + layer * DM; const float* lnb = I.ln_t_b + layer * DM;
    const float* wg = I.moe_w_group + (size_t)layer * DM * 4; const float* wr = I.moe_w_router + (size_t)layer * DM * 16;
    int* tokE = (int*)(ws + WS_TOKE); float* tokW = (float*)(ws + WS_TOKW); int* tokS = (int*)(ws + WS_TOKS);
    constexpr int WCH = 64 * 272 + 64 * 80;
    f32x4 sr0, sr1, sgp = {0.f, 0.f, 0.f, 0.f};
    const int sk0 = tid >> 2, sk1 = (tid + 512) >> 2, sq = tid & 3;
    const float* srp0 = wr + (size_t)sk0 * 16 + 4 * sq; const float* srp1 = wr + (size_t)sk1 * 16 + 4 * sq; const float* sgpp = wg + (size_t)tid * 4;
    const int so0 = (sk0 >> 2) * 272 + (sk0 & 3) * 64 + sq * 16, so1 = (sk1 >> 2) * 272 + (sk1 & 3) * 64 + sq * 16, sog = 64 * 272 + (tid >> 2) * 80 + (tid & 3) * 16;
#define STAGE_LD(ch) do { sr0 = *(const f32x4*)(srp0 + (size_t)(ch) * 4096); sr1 = *(const f32x4*)(srp1 + (size_t)(ch) * 4096); if (tid < 256) sgp = *(const f32x4*)(sgpp + (size_t)(ch) * 1024); } while (0)
#define STAGE_ST(buf) do { LAS unsigned char* base_ = wsm + (buf) * WCH; *(LAS f32x4*)(base_ + so0) = sr0; *(LAS f32x4*)(base_ + so1) = sr1; if (tid < 256) *(LAS f32x4*)(base_ + sog) = sgp; } while (0)
    STAGE_LD(0); STAGE_ST(0); LDS_WAIT(); __syncthreads();
#pragma unroll 1
    for (int it = 0; it < 2; ++it) {
        int lane_o = lane_in; asm volatile("" : "+v"(lane_o)); const int lane = lane_o;
        const int rA = gw * 4 + it * 2, b = rA >> 12;
        const float* shc = mod + (size_t)(layer * 2 + b) * 12288 + 6144; const float* scc = shc + 2048;
        f32x4 v[2][8]; float rstd[2];
#pragma unroll
        for (int r = 0; r < 2; ++r) {
            const GAS u32x2g* yr = (const GAS u32x2g*)(Y + (size_t)(rA + r) * DM) + lane; float s = 0.f;
#pragma unroll
            for (int j = 0; j < 8; ++j) { const u32x2g w = yr[64 * j]; v[r][j] = (f32x4){fa::bflo(w.x), fa::bfhi(w.x), fa::bflo(w.y), fa::bfhi(w.y)}; s += (v[r][j].x + v[r][j].y) + (v[r][j].z + v[r][j].w); }
            const float mean = wave_sum(s) * (1.f / DM); float s2 = 0.f;
#pragma unroll
            for (int j = 0; j < 8; ++j) { v[r][j] = v[r][j] - mean; s2 += (v[r][j].x * v[r][j].x + v[r][j].y * v[r][j].y) + (v[r][j].z * v[r][j].z + v[r][j].w * v[r][j].w); }
            rstd[r] = 1.f / sqrtf(wave_sum(s2) * (1.f / DM) + LN_EPS);
        }
        float acc[2][20];
#pragma unroll
        for (int r = 0; r < 2; ++r)
#pragma unroll
            for (int e = 0; e < 20; ++e) acc[r][e] = 0.f;
#pragma unroll
        for (int j = 0; j < 8; ++j) { const int col = 256 * j + 4 * lane; const int step = it * 8 + j;
            const f32x4 gg = *(const f32x4*)(lng + col), bb = *(const f32x4*)(lnb + col), sc = *(const f32x4*)(scc + col), sh = *(const f32x4*)(shc + col);
            f32x4 h[2];
#pragma unroll
            for (int r = 0; r < 2; ++r) { const f32x4 x1 = v[r][j] * rstd[r] * gg + bb; ((GAS unsigned long long*)(XA + (size_t)(rA + r) * DM) + lane)[64 * j] = (unsigned long long)pk2(x1.x, x1.y) | ((unsigned long long)pk2(x1.z, x1.w) << 32);
                h[r] = x1 * (sc + 1.0f) + sh;
                ((GAS unsigned long long*)(H + (size_t)(rA + r) * DM) + lane)[64 * j] = (unsigned long long)pk2(h[r].x, h[r].y) | ((unsigned long long)pk2(h[r].z, h[r].w) << 32); }
            if (step < 15) STAGE_LD((j + 1) & 7);
            const LAS unsigned char* cb = wsm + (step & 1) * WCH;
#pragma unroll 1
            for (int i = 0; i < 4; ++i) {
                const float hA = i == 0 ? h[0][0] : i == 1 ? h[0][1] : i == 2 ? h[0][2] : h[0][3], hB = i == 0 ? h[1][0] : i == 1 ? h[1][1] : i == 2 ? h[1][2] : h[1][3];
#pragma unroll
                for (int q = 0; q < 4; ++q) { const f32x4 w = *(const LAS f32x4*)(cb + lane * 272 + i * 64 + q * 16);
#pragma unroll
                    for (int e = 0; e < 4; ++e) { acc[0][4 * q + e] += hA * w[e]; acc[1][4 * q + e] += hB * w[e]; } }
                const f32x4 w = *(const LAS f32x4*)(cb + 64 * 272 + lane * 80 + i * 16);
#pragma unroll
                for (int e = 0; e < 4; ++e) { acc[0][16 + e] += hA * w[e]; acc[1][16 + e] += hB * w[e]; }
            }
            if (step < 15) STAGE_ST((step + 1) & 1);
            LDS_WAIT(); __syncthreads(); __builtin_amdgcn_sched_barrier(0);
        }
#pragma unroll
        for (int r = 0; r < 2; ++r)
#pragma unroll
            for (int e = 0; e < 20; ++e) acc[r][e] = wave_sum(acc[r][e]);
        if (lane < 2) {
            float a[20];
#pragma unroll
            for (int e = 0; e < 20; ++e) a[e] = lane == 0 ? acc[0][e] : acc[1][e];
            const int row = rA + lane;
            float gl[4];
#pragma unroll
            for (int e = 0; e < 4; ++e) gl[e] = a[16 + e] + I.moe_b_group[layer * 4 + e];
            int gi = 0; float gm = gl[0];
#pragma unroll
            for (int e = 1; e < 4; ++e) if (gl[e] > gm) { gm = gl[e]; gi = e; }
            float gs = 0.f;
#pragma unroll
            for (int e = 0; e < 4; ++e) gs += __expf(gl[e] - gm);
            const float gprob = 1.0f / gs;
            float le[4];
#pragma unroll
            for (int e = 0; e < 4; ++e) le[e] = (gi == 0 ? a[e] : gi == 1 ? a[4 + e] : gi == 2 ? a[8 + e] : a[12 + e]) + I.moe_b_router[layer * 16 + gi * 4 + e];
            int i1 = 0; float m1 = le[0];
#pragma unroll
            for (int e = 1; e < 4; ++e) if (le[e] > m1) { m1 = le[e]; i1 = e; }
            int i2 = -1; float m2 = -INFINITY;
#pragma unroll
            for (int e = 0; e < 4; ++e) if (e != i1 && le[e] > m2) { m2 = le[e]; i2 = e; }
            const float p2 = __expf(m2 - m1), den = 1.0f / (1.0f + p2);
            const int e1 = gi * 4 + i1, e2 = gi * 4 + i2; const float w1 = gprob * den, w2 = gprob * p2 * den;
            tokE[row * 2] = e1; tokE[row * 2 + 1] = e2; tokW[row * 2] = w1; tokW[row * 2 + 1] = w2;
            esm[(row & 31) * 2] = e1; esm[(row & 31) * 2 + 1] = e2;
        }
    }
    LDS_WAIT(); __syncthreads();
    {
        int* tokS = (int*)(ws + WS_TOKS); int* bcnt = (int*)(ws + WS_BCNT) + (layer * 256 + vcu) * 16;
        if (tid < 64) { const int my = esm[tid]; int rk = 0;
            for (int j = 0; j < 64; ++j) rk += (j < tid && esm[j] == my) ? 1 : 0;
            tokS[(size_t)(vcu * 32) * 2 + tid] = rk; }
        else if (tid < 80) { const int e = tid - 64; int c = 0;
            for (int j = 0; j < 64; ++j) c += (esm[j] == e) ? 1 : 0;
            bcnt[e] = c; }
    }
    __syncthreads();
}

__device__ __forceinline__ void phase_lnt2(const In& I, unsigned char* ws, LAS unsigned char* lds, LAS int* esm  , int layer, const bf16* Y, int gw, int lane, int tid, int wave, int vcu) {
    typedef float f32x16r __attribute__((ext_vector_type(16)));
    const float* mod = (const float*)(ws + WS_MOD); bf16* XA = (bf16*)(ws + WS_XA); bf16* H = (bf16*)(ws + WS_H);
    const float* lng = I.ln_t_g + layer * DM; const float* lnb = I.ln_t_b + layer * DM;
    const float* wg = I.moe_w_group + (size_t)layer * DM * 4; const float* wr = I.moe_w_router + (size_t)layer * DM * 16;
    int* tokE = (int*)(ws + WS_TOKE); float* tokW = (float*)(ws + WS_TOKW);
    constexpr int APITCH = 129, ABYTES = 16640  , RBUF = ABYTES + 128 * 32 * 4;
    const int r0 = gw * 4, b = r0 >> 12;
    const float* shc = mod + (size_t)(layer * 2 + b) * 12288 + 6144; const float* scc = shc + 2048;
    for (int i = tid; i < 2 * 128 * 12; i += NWAVES * 64) { const int bf = i / (128 * 12), rem = i % (128 * 12); ((LAS float*)(lds + bf * RBUF + ABYTES))[(rem / 12) * 32 + 20 + rem % 12] = 0.f; }
    f32x4 v[4][8]; float rstd[4];
#pragma unroll
    for (int r = 0; r < 4; ++r) {
        const GAS u32x2g* yr = (const GAS u32x2g*)(Y + (size_t)(r0 + r) * DM) + lane; float s = 0.f;
#pragma unroll
        for (int j = 0; j < 8; ++j) { const u32x2g w = yr[64 * j]; v[r][j] = (f32x4){fa::bflo(w.x), fa::bfhi(w.x), fa::bflo(w.y), fa::bfhi(w.y)}; s += (v[r][j].x + v[r][j].y) + (v[r][j].z + v[r][j].w); }
        const float mean = wave_sum(s) * (1.f / DM); float s2 = 0.f;
#pragma unroll
        for (int j = 0; j < 8; ++j) { v[r][j] = v[r][j] - mean; s2 += (v[r][j].x * v[r][j].x + v[r][j].y * v[r][j].y) + (v[r][j].z * v[r][j].z + v[r][j].w * v[r][j].w); }
        rstd[r] = 1.f / sqrtf(wave_sum(s2) * (1.f / DM) + LN_EPS);
    }
    const int wk = tid >> 2, wq = tid & 3;
    f32x4 swr = *(const f32x4*)(wr + (size_t)wk * 16 + 4 * wq), swg = {0.f, 0.f, 0.f, 0.f};
    if (tid < 128) swg = *(const f32x4*)(wg + (size_t)tid * 4);
    f32x16r acc = f32x16r{};
    f32x4 h[4];
#pragma unroll
    for (int st = 0; st < 16; ++st) { const int j = st >> 1, hf = st & 1; LAS float* Ab = (LAS float*)(lds + (st & 1) * RBUF); LAS float* Wb = (LAS float*)(lds + (st & 1) * RBUF + ABYTES);
        if (hf == 0) { const int col = 256 * j + 4 * lane;
            const f32x4 gg = *(const f32x4*)(lng + col), bb = *(const f32x4*)(lnb + col), sc = *(const f32x4*)(scc + col), sh = *(const f32x4*)(shc + col);
#pragma unroll
            for (int r = 0; r < 4; ++r) { const f32x4 x1 = v[r][j] * rstd[r] * gg + bb;
                ((GAS unsigned long long*)(XA + (size_t)(r0 + r) * DM) + lane)[64 * j] = (unsigned long long)pk2(x1.x, x1.y) | ((unsigned long long)pk2(x1.z, x1.w) << 32);
                h[r] = x1 * (sc + 1.0f) + sh;
                ((GAS unsigned long long*)(H + (size_t)(r0 + r) * DM) + lane)[64 * j] = (unsigned long long)pk2(h[r].x, h[r].y) | ((unsigned long long)pk2(h[r].z, h[r].w) << 32); } }
        if ((lane >> 5) == hf) {
#pragma unroll
            for (int r = 0; r < 4; ++r) { LAS float* ap = Ab + (wave * 4 + r) * APITCH + 4 * (lane & 31); ap[0] = h[r].x; ap[1] = h[r].y; ap[2] = h[r].z; ap[3] = h[r].w; } }
        *(LAS f32x4*)(Wb + wk * 32 + 4 * wq) = swr; if (tid < 128) *(LAS f32x4*)(Wb + tid * 32 + 16) = swg;
        LDS_WAIT(); __syncthreads();
        if (st < 15) { swr = *(const f32x4*)(wr + (size_t)(128 * (st + 1) + wk) * 16 + 4 * wq); if (tid < 128) swg = *(const f32x4*)(wg + (size_t)(128 * (st + 1) + tid) * 4); }
#pragma unroll
        for (int m = 0; m < 8; ++m) { const int kk = 16 * wave + 2 * m + (lane >> 5);
            acc = __builtin_amdgcn_mfma_f32_32x32x2f32(Ab[(lane & 31) * APITCH + kk], Wb[kk * 32 + (lane & 31)], acc, 0, 0, 0); }
        __builtin_amdgcn_sched_barrier(0);
    }
    __syncthreads();
    { LAS float* red = (LAS float*)lds;
#pragma unroll
      for (int r = 0; r < 16; ++r) red[(wave * 16 + r) * 64 + lane] = acc[r]; }
    LDS_WAIT(); __syncthreads();
    LAS float* lg = (LAS float*)(lds + 40960);
    for (int i = tid; i < 32 * 20; i += NWAVES * 64) { const int row = i / 20, col = i % 20, ln = col + 32 * ((row >> 2) & 1), rg = (row & 3) + 4 * (row >> 3); float s = 0.f;
#pragma unroll
        for (int w = 0; w < 8; ++w) s += ((LAS float*)lds)[(w * 16 + rg) * 64 + ln];
        lg[i] = s; }
    LDS_WAIT(); __syncthreads();
    if (tid < 32) {
        float l2e = 1.4426950408889634f; asm volatile("" : "+v"(l2e));
        float a[20];
#pragma unroll
        for (int e = 0; e < 20; ++e) a[e] = lg[tid * 20 + e];
        const int row = vcu * 32 + tid;
        float gl[4];
#pragma unroll
        for (int e = 0; e < 4; ++e) gl[e] = a[16 + e] + I.moe_b_group[layer * 4 + e];
        int gi = 0; float gm = gl[0];
#pragma unroll
        for (int e = 1; e < 4; ++e) if (gl[e] > gm) { gm = gl[e]; gi = e; }
        float gs = 0.f;
#pragma unroll
        for (int e = 0; e < 4; ++e) gs += __builtin_amdgcn_exp2f((gl[e] - gm) * l2e);
        const float gprob = __builtin_amdgcn_rcpf(gs);
        float le[4];
#pragma unroll
        for (int e = 0; e < 4; ++e) le[e] = (gi == 0 ? a[e] : gi == 1 ? a[4 + e] : gi == 2 ? a[8 + e] : a[12 + e]) + I.moe_b_router[layer * 16 + gi * 4 + e];
        int i1 = 0; float m1 = le[0];
#pragma unroll
        for (int e = 1; e < 4; ++e) if (le[e] > m1) { m1 = le[e]; i1 = e; }
        int i2 = -1; float m2 = -INFINITY;
#pragma unroll
        for (int e = 0; e < 4; ++e) if (e != i1 && le[e] > m2) { m2 = le[e]; i2 = e; }
        const float p2 = __builtin_amdgcn_exp2f((m2 - m1) * l2e), den = __builtin_amdgcn_rcpf(1.0f + p2);
        const int e1 = gi * 4 + i1, e2 = gi * 4 + i2; const float w1 = gprob * den, w2 = gprob * p2 * den;
        tokE[row * 2] = e1; tokE[row * 2 + 1] = e2; tokW[row * 2] = w1; tokW[row * 2 + 1] = w2;
        esm[tid * 2] = e1; esm[tid * 2 + 1] = e2;
    }
    LDS_WAIT(); __syncthreads();
    {
        int* tokS = (int*)(ws + WS_TOKS); int* bcnt = (int*)(ws + WS_BCNT) + (layer * 256 + vcu) * 16;
        if (tid < 64) { const int my = esm[tid]; int rk = 0;
            for (int jj = 0; jj < 64; ++jj) rk += (jj < tid && esm[jj] == my) ? 1 : 0;
            tokS[(size_t)(vcu * 32) * 2 + tid] = rk; }
        else if (tid < 80) { const int e = tid - 64; int c = 0;
            for (int jj = 0; jj < 64; ++jj) c += (esm[jj] == e) ? 1 : 0;
            bcnt[e] = c; }
    }
    __syncthreads();
}

struct Seg { unsigned cnt[16]; };
__device__ __forceinline__ void seg_load(Seg& s, const unsigned* cnt) {
#pragma unroll
    for (int e = 0; e < 16; ++e) s.cnt[e] = ld_u32_agent(cnt + e);
}
__device__ __forceinline__ int seg_row_base(const Seg& s, int e) {
    int run = 0, base = 0;
#pragma unroll
    for (int k = 0; k < 16; ++k) { if (k == e) base = run; run += (int)((s.cnt[k] + 255u) >> 8); }
    return base * 256;
}
__device__ __forceinline__ void phase_permute(unsigned char* ws, LAS int* psm  , int layer, int gw, int lane, int tid, int vcu) {
    const int* bc = (const int*)(ws + WS_BCNT) + layer * 256 * 16;
    { const int e = tid & 15, part = tid >> 4; int s = 0, pre = 0;
#pragma unroll
      for (int i = 0; i < 8; ++i) { const int v = part * 8 + i; const int c = bc[v * 16 + e]; s += c; pre += (v < vcu) ? c : 0; }
      psm[part * 16 + e] = s; if (part == (vcu >> 3)) psm[512 + 16 + e] = pre; }
    LDS_WAIT(); __syncthreads();
    if (tid < 16) { int tot = 0, bef = 0;
        for (int p = 0; p < 32; ++p) { const int c = psm[p * 16 + tid]; tot += c; bef += (p < (vcu >> 3)) ? c : 0; }
        psm[512 + tid] = tot; psm[512 + 16 + tid] += bef;
        if (vcu == 0) ((unsigned*)(ws + WS_CTL))[CW_CNT + layer * 16 + tid] = (unsigned)tot; }
    LDS_WAIT(); __syncthreads();
    Seg sg;
#pragma unroll
    for (int e = 0; e < 16; ++e) sg.cnt[e] = (unsigned)psm[512 + e];
    const int* tokE = (const int*)(ws + WS_TOKE); const float* tokW = (const float*)(ws + WS_TOKW); const int* tokS = (const int*)(ws + WS_TOKS);
    int* rowtok = (int*)(ws + WS_ROWTOK); float* roww = (float*)(ws + WS_ROWW); int* rowsrc = (int*)(ws + WS_ROWSRC);
    if (tid < 64) { const int row = vcu * 32 + (tid >> 1), k = tid & 1; const int e = tokE[row * 2 + k], dst = seg_row_base(sg, e) + psm[512 + 16 + e] + tokS[row * 2 + k];
        rowtok[dst] = row * 2 + k; roww[dst] = tokW[row * 2 + k]; rowsrc[dst] = row; }
    if (vcu < 16) { const int e = vcu, c = psm[512 + e], b0 = seg_row_base(sg, e) + c, npad = ((c + 255) & ~255) - c;
        if (tid < npad) rowsrc[b0 + tid] = 0; }
    __syncthreads();
}
__device__ __forceinline__ void build_units(pg8::GroupOrder& S, const Seg& sg, int nN, int G, int c) {
    int nT = 0;
#pragma unroll
    for (int e = 0; e < 16; ++e) { S.cnt[e] = (unsigned)__builtin_amdgcn_readfirstlane((int)sg.cnt[e]); nT += (int)((S.cnt[e] + 255u) >> 8); }
    S.nT = nT; S.nN = nN; S.G = G; S.c = c;
}

__device__ __forceinline__ void phase_lnc(const In& I, unsigned char* ws, int layer, float* xout32  , bf16* xout16  , bool write_h, int gw, int lane) {
    const float* mod = (const float*)(ws + WS_MOD); const bf16* XA = (const bf16*)(ws + WS_XA); const bf16* YS = (const bf16*)(ws + WS_YS); bf16* H = (bf16*)(ws + WS_H);
    const float* lng = I.ln_c_g + layer * DM; const float* lnb = I.ln_c_b + layer * DM;
    const int row0 = gw * 4, b = row0 >> 12;
    const float* gc = mod + (size_t)(layer * 2 + b) * 12288 + 10240;
    const float* shn = mod + (size_t)(2 + b) * 12288; const float* scn = shn + 2048;
    u32x2g rx[2][8], ra[2][8], rc[2][8];
#define LNC_LOAD(pp) do { _Pragma("unroll") for (int r = 0; r < 2; ++r) { const int row = row0 + 2 * (pp) + r; \
        const GAS u32x2g* xr = (const GAS u32x2g*)(XA + (size_t)row * DM) + lane; const GAS u32x2g* s0 = (const GAS u32x2g*)(YS + (size_t)(row * 2) * DM) + lane; const GAS u32x2g* s1 = (const GAS u32x2g*)(YS + (size_t)(row * 2 + 1) * DM) + lane; \
        _Pragma("unroll") for (int j = 0; j < 8; ++j) { rx[r][j] = xr[64 * j]; ra[r][j] = s0[64 * j]; rc[r][j] = s1[64 * j]; } } } while (0)
#pragma unroll 1
    for (int pp = 0; pp < 2; ++pp) {
        LNC_LOAD(pp);
        f32x4 v[2][8]; float s[2] = {0.f, 0.f};
#pragma unroll
        for (int r = 0; r < 2; ++r)
#pragma unroll
            for (int j = 0; j < 8; ++j) { const u32x2g xw = rx[r][j], a = ra[r][j], c = rc[r][j]; const f32x4 g = *(const f32x4*)(gc + 256 * j + 4 * lane);
                const f32x4 x1 = {fa::bflo(xw.x), fa::bfhi(xw.x), fa::bflo(xw.y), fa::bfhi(xw.y)};
                f32x4 m; m.x = fa::bflo(a.x) + fa::bflo(c.x); m.y = fa::bfhi(a.x) + fa::bfhi(c.x); m.z = fa::bflo(a.y) + fa::bflo(c.y); m.w = fa::bfhi(a.y) + fa::bfhi(c.y);
                v[r][j] = x1 * ALPHA_RES + g * m; s[r] += (v[r][j].x + v[r][j].y) + (v[r][j].z + v[r][j].w); }
#pragma unroll
        for (int r = 0; r < 2; ++r) { const int row = row0 + 2 * pp + r;
            const float mean = wave_sum(s[r]) * (1.f / DM); float s2 = 0.f;
#pragma unroll
            for (int j = 0; j < 8; ++j) { v[r][j] = v[r][j] - mean; s2 += (v[r][j].x * v[r][j].x + v[r][j].y * v[r][j].y) + (v[r][j].z * v[r][j].z + v[r][j].w * v[r][j].w); }
            const float rstd = 1.f / sqrtf(wave_sum(s2) * (1.f / DM) + LN_EPS);
            GAS f32x4* xo = (GAS f32x4*)(xout32 + (size_t)row * DM) + lane; GAS unsigned long long* xo16 = (GAS unsigned long long*)(xout16 + (size_t)row * DM) + lane; GAS unsigned long long* ho = (GAS unsigned long long*)(H + (size_t)row * DM) + lane;
#pragma unroll
            for (int j = 0; j < 8; ++j) { const int col = 256 * j + 4 * lane; const f32x4 gg = *(const f32x4*)(lng + col), bb = *(const f32x4*)(lnb + col);
                const f32x4 x2 = v[r][j] * rstd * gg + bb; if (write_h) xo16[64 * j] = (unsigned long long)pk2(x2.x, x2.y) | ((unsigned long long)pk2(x2.z, x2.w) << 32); else xo[64 * j] = x2;
                if (write_h) { const f32x4 sc = *(const f32x4*)(scn + col), sh = *(const f32x4*)(shn + col); const f32x4 h = x2 * (sc + 1.0f) + sh;
                    ho[64 * j] = (unsigned long long)pk2(h.x, h.y) | ((unsigned long long)pk2(h.z, h.w) << 32); } } }
    }
#undef LNC_LOAD
}

__device__ __forceinline__ void phase_cmp2(const In& I, unsigned char* ws, LAS unsigned char* lds, int gw, int NGW, int lane, int tid, int wave) {
    LAS float* hid = (LAS float*)(lds + wave * 1024);
    LAS float* phl = (LAS float*)(lds + 16384);
    for (int which = 0; which < 2; ++which) {
        const float* phi2 = which ? I.nsa_phi_v2 : I.nsa_phi_k2;
        __syncthreads();
        for (int i = tid; i < 256 * 16; i += NWAVES * 64) *(LAS f32x4*)(phl + 4 * i) = *(const f32x4*)(phi2 + 4 * i);
        LDS_WAIT(); __syncthreads();
        for (int task = which * 2048 + gw; task < (which + 1) * 2048; task += NGW) { const int bh = (task >> 8) & 7, n = task & 255;
            bf16* kc = (bf16*)(ws + WS_KCMP); bf16* vct = (bf16*)(ws + WS_VCMPT); float o = 0.f;
            if (n < 255) { const float* UL = (const float*)(ws + (which ? WS_ULV : WS_ULK)); const float* cb = (const float*)(ws + WS_CMPB) + which * 256;
                const f32x4 u = *(const f32x4*)(UL + (size_t)(bh * 256 + n) * 512 + 4 * lane), l = *(const f32x4*)(UL + (size_t)(bh * 256 + n + 1) * 512 + 256 + 4 * lane), bb = *(const f32x4*)(cb + 4 * lane);
                f32x4 h = u + l + bb;
#pragma unroll
                for (int i = 0; i < 4; ++i) h[i] = h[i] / (1.0f + __expf(-h[i]));
                *(LAS f32x4*)(hid + 4 * lane) = h; LDS_WAIT(); asm volatile("" ::: "memory");
                float o0 = 0.f, o1 = 0.f, o2 = 0.f, o3 = 0.f;
#pragma unroll 4
                for (int cidx = 0; cidx < 256; cidx += 4) { const f32x4 hv = *(const LAS f32x4*)(hid + cidx);
                    o0 += hv.x * phl[cidx * 64 + lane]; o1 += hv.y * phl[(cidx + 1) * 64 + lane]; o2 += hv.z * phl[(cidx + 2) * 64 + lane]; o3 += hv.w * phl[(cidx + 3) * 64 + lane]; }
                o = (o0 + o1) + (o2 + o3);
                LDS_WAIT(); asm volatile("" ::: "memory"); }
            if (which == 0) kc[(size_t)(bh * 256 + n) * 64 + lane] = (bf16)f2bf(o); else vct[(size_t)(bh * 64 + lane) * 256 + n] = (bf16)f2bf(o);
        }
    }
    __syncthreads();
}

constexpr int CMP_XS = 0, CMP_TOT = 34816, CMP_K = 45056, CMP_V = 81920, CMP_VP = 528;
__device__ __forceinline__ fa::bf16x8 ov_frag(int d, bool spill_only) {
    fa::u32x4 w = {0u, 0u, 0u, 0u};
    if (!spill_only) {
        if (d == 0) { w.x = 0x3F803F80u; w.y = 0x3F003F80u; }
        else if (d == 1) { w.y = 0x3F000000u; w.z = 0x3F803F80u; w.w = 0x3F003F80u; }
        else if (d == 2) { w.w = 0x3F000000u; } }
    else if (d == 2) w.w = 0x3F000000u;
    return __builtin_bit_cast(fa::bf16x8, w);
}
__device__ __forceinline__ void cmp_unit(unsigned char* ws, LAS unsigned char* lds, int b, int hkv, int tb, int tid, int wave, int lane) {
    const int r32 = lane & 31, hi = lane >> 5, head = hkv * 8 + wave, q0 = tb * 32, t = q0 + r32; const size_t row = (size_t)b * SEQ + t;
    const bf16* Q = (const bf16*)(ws + WS_Q); bf16* OUT = (bf16*)(ws + WS_OCMP);
    LAS float* tot = (LAS float*)(lds + CMP_TOT);
    fa::bf16x8 qr[4]; fa::load_q(qr, Q + row * DM + head * 64, hi);
    {
        const fa::u32x4 mine = __builtin_bit_cast(fa::u32x4, qr[0]); fa::u32x4 oth;
#pragma unroll
        for (int i = 0; i < 4; ++i) { const auto rr = __builtin_amdgcn_permlane32_swap(mine[i], mine[i], false, false); oth[i] = hi ? rr[0] : rr[1]; }
        const float* rp = (const float*)(ws + WS_ROPE) + row * 16; const f32x4 c0 = *(const f32x4*)rp, c1 = *(const f32x4*)(rp + 4), s0 = *(const f32x4*)(rp + 8), s1 = *(const f32x4*)(rp + 12);
        const float sg = hi ? -1.f : 1.f; fa::u32x4 o;
        o.x = fa::cvtpk(fa::bflo(mine.x) * c0.x + sg * fa::bflo(oth.x) * s0.x, fa::bfhi(mine.x) * c0.y + sg * fa::bfhi(oth.x) * s0.y);
        o.y = fa::cvtpk(fa::bflo(mine.y) * c0.z + sg * fa::bflo(oth.y) * s0.z, fa::bfhi(mine.y) * c0.w + sg * fa::bfhi(oth.y) * s0.w);
        o.z = fa::cvtpk(fa::bflo(mine.z) * c1.x + sg * fa::bflo(oth.z) * s1.x, fa::bfhi(mine.z) * c1.y + sg * fa::bfhi(oth.z) * s1.y);
        o.w = fa::cvtpk(fa::bflo(mine.w) * c1.z + sg * fa::bflo(oth.w) * s1.z, fa::bfhi(mine.w) * c1.w + sg * fa::bfhi(oth.w) * s1.w);
        qr[0] = __builtin_bit_cast(fa::bf16x8, o); }
    fa::State st; st.o0 = fa::f32x16{}; st.o1 = fa::f32x16{}; st.m = fa::NEGBIG; st.l = 0.f;
    fa::f32x16 impA = fa::f32x16{}, impB = fa::f32x16{};
    const int nhi = (t - 31) >> 4;
    const int nhi_min = (q0 - 31) >> 4;
    const int ntile = ((2 * tb) >> 5) + 1;
    const LAS unsigned char* kl = lds + CMP_K + fa::kap(r32) * 144 + hi * 16;
    const LAS unsigned char* vl = lds + CMP_V + r32 * CMP_VP + hi * 16;
    for (int kt = 0; kt < ntile; ++kt) {
        fa::Frag f;
#pragma unroll
        for (int d0 = 0; d0 < 4; ++d0) f.k[d0] = *(const LAS fa::bf16x8*)(kl + kt * 32 * 144 + d0 * 32);
#pragma unroll
        for (int db = 0; db < 2; ++db)
#pragma unroll
            for (int sx = 0; sx < 2; ++sx) f.v[db * 2 + sx] = *(const LAS fa::bf16x8*)(vl + db * 32 * CMP_VP + kt * 64 + sx * 32);
        fa::f32x16 p; fa::scores(p, f, qr);
        if (kt * 32 + 31 > nhi_min) fa::mask_range(p, kt * 32, hi, 0, nhi);
        float tm = fmaxf(p[0], p[1]);
#pragma unroll
        for (int r = 2; r < 16; ++r) tm = fmaxf(tm, p[r]);
        tm = fa::xmax(tm);
        const float mn = fmaxf(st.m, tm); const float alpha = __builtin_amdgcn_exp2f(st.m - mn); st.m = mn;
        float rs = 0.f;
#pragma unroll
        for (int r = 0; r < 16; ++r) { p[r] = __builtin_amdgcn_exp2f(p[r] - mn); rs += p[r]; }
        st.l = st.l * alpha + rs;
        if (!__all(alpha == 1.0f)) { st.o0 = st.o0 * alpha; st.o1 = st.o1 * alpha; impA = impA * alpha; impB = impB * alpha; }
        fa::u32x4 w0, w1;
        w0.x = fa::cvtpk(p[0], p[1]); w0.y = fa::cvtpk(p[2], p[3]); w0.z = fa::cvtpk(p[4], p[5]); w0.w = fa::cvtpk(p[6], p[7]);
        w1.x = fa::cvtpk(p[8], p[9]); w1.y = fa::cvtpk(p[10], p[11]); w1.z = fa::cvtpk(p[12], p[13]); w1.w = fa::cvtpk(p[14], p[15]);
        const fa::bf16x8 pb0 = __builtin_bit_cast(fa::bf16x8, w0), pb1 = __builtin_bit_cast(fa::bf16x8, w1);
        st.o0 = __builtin_amdgcn_mfma_f32_32x32x16_bf16(f.v[0], pb0, st.o0, 0, 0, 0);
        st.o0 = __builtin_amdgcn_mfma_f32_32x32x16_bf16(f.v[1], pb1, st.o0, 0, 0, 0);
        st.o1 = __builtin_amdgcn_mfma_f32_32x32x16_bf16(f.v[2], pb0, st.o1, 0, 0, 0);
        st.o1 = __builtin_amdgcn_mfma_f32_32x32x16_bf16(f.v[3], pb1, st.o1, 0, 0, 0);
        { const int T = kt >> 2, S = 32 * T + r32;
          const fa::bf16x8 o0f = ov_frag(S - (8 * kt + 2 * hi), false), o1f = ov_frag(S - (8 * kt + 4 + 2 * hi), false);
          if (T == 0) { impA = __builtin_amdgcn_mfma_f32_32x32x16_bf16(o0f, pb0, impA, 0, 0, 0); impA = __builtin_amdgcn_mfma_f32_32x32x16_bf16(o1f, pb1, impA, 0, 0, 0); }
          else        { impB = __builtin_amdgcn_mfma_f32_32x32x16_bf16(o0f, pb0, impB, 0, 0, 0); impB = __builtin_amdgcn_mfma_f32_32x32x16_bf16(o1f, pb1, impB, 0, 0, 0); }
          if (kt == 3) {
              const fa::bf16x8 sp = ov_frag((r32 == 0 && hi == 1) ? 2 : 9, true);
              impB = __builtin_amdgcn_mfma_f32_32x32x16_bf16(sp, pb1, impB, 0, 0, 0); } }
    }
    const float inv = fa::finish(st);
    fa::store_o(st, inv, OUT + row * DM + head * 64, hi);
    LAS float* xs = (LAS float*)(lds + CMP_XS) + (wave & 3) * (32 * 66) + r32 * 66 + 4 * hi;
#define CMP_XW(EXPR_A, EXPR_B) do { _Pragma("unroll") for (int r = 0; r < 16; ++r) { const int sl = (r & 3) + 8 * (r >> 2); xs[sl] = (EXPR_A); xs[32 + sl] = (EXPR_B); } } while (0)
    if (wave >= 4) CMP_XW(impA[r] * inv, impB[r] * inv);
    LDS_WAIT(); __syncthreads();
    if (wave < 4) CMP_XW(impA[r] * inv + xs[sl], impB[r] * inv + xs[32 + sl]);
#undef CMP_XW
    LDS_WAIT(); __syncthreads();
    for (int i = tid; i < 32 * 64; i += NWAVES * 64) { const int q = i >> 6, j = i & 63; float s = 0.f;
#pragma unroll
        for (int w = 0; w < 4; ++w) s += ((LAS float*)(lds + CMP_XS))[w * (32 * 66) + q * 66 + j];
        const int tq = q0 + q, cur = tq >> 6; const bool causal = j * 64 <= tq, forced = (j == 0) || (j == cur) || (j == cur - 1);
        tot[q * 68 + j] = causal ? s + (forced ? 1e4f : 0.f) : -1e30f; }
    LDS_WAIT(); __syncthreads();
    {
        const int q = tid >> 4, part = tid & 15, tq = q0 + q;
        float sc[4];
#pragma unroll
        for (int i = 0; i < 4; ++i) sc[i] = tot[q * 68 + 4 * part + i];
        int rk[4] = {0, 0, 0, 0};
#pragma unroll 8
        for (int jp = 0; jp < 64; ++jp) { const float sp = tot[q * 68 + jp];
#pragma unroll
            for (int i = 0; i < 4; ++i) { const int j = 4 * part + i; rk[i] += (sp > sc[i] || (sp == sc[i] && jp < j)) ? 1 : 0; } }
        unsigned lo = 0u, hi32 = 0u;
#pragma unroll
        for (int i = 0; i < 4; ++i) { const int j = 4 * part + i; if (rk[i] < 16) { if (j < 32) lo |= 1u << j; else hi32 |= 1u << (j - 32); } }
#pragma unroll
        for (int o = 1; o < 16; o <<= 1) { lo |= __shfl_xor(lo, o); hi32 |= __shfl_xor(hi32, o); }
        if (part == 0) ((unsigned long long*)(ws + WS_SELM))[(size_t)(b * 4 + hkv) * SEQ + tq] = ((unsigned long long)hi32 << 32) | lo;
    }
    __syncthreads();
}

__device__ __forceinline__ void sel_unit(unsigned char* ws, int b, int hkv, int tb, int wave, int lane) {
    const int r32 = lane & 31, hi = lane >> 5, head = hkv * 8 + wave, q0 = tb * 32, t = q0 + r32; const size_t row = (size_t)b * SEQ + t;
    const bf16* Q = (const bf16*)(ws + WS_Q); bf16* OUT = (bf16*)(ws + WS_ATT);
    const bf16* Kbh = (const bf16*)(ws + WS_KS) + (size_t)(b * 4 + hkv) * SEQ * 64; const bf16* Vbh = (const bf16*)(ws + WS_VST) + (size_t)(b * 4 + hkv) * 64 * SEQ;
    const unsigned long long selm = ((const unsigned long long*)(ws + WS_SELM))[(size_t)(b * 4 + hkv) * SEQ + t];
    unsigned ulo = (unsigned)selm, uhi = (unsigned)(selm >> 32);
#pragma unroll
    for (int o = 1; o < 64; o <<= 1) { ulo |= __shfl_xor(ulo, o); uhi |= __shfl_xor(uhi, o); }
    const unsigned long long U = ((unsigned long long)(unsigned)__builtin_amdgcn_readfirstlane((int)uhi) << 32) | (unsigned)__builtin_amdgcn_readfirstlane((int)ulo);
    fa::bf16x8 qr[4]; fa::load_q(qr, Q + row * DM + head * 64, hi);
    fa::State st; st.o0 = fa::f32x16{}; st.o1 = fa::f32x16{}; st.m = fa::NEGBIG; st.l = 0.f;
    int kt = 0; while (kt <= tb && !((U >> (kt >> 1)) & 1ull)) ++kt;
    fa::Frag fc, fn; if (kt <= tb) fa::load_tile(fc, Kbh, Vbh, SEQ, kt * 32, r32, hi);
    while (kt <= tb) {
        int kn = kt + 1; while (kn <= tb && !((U >> (kn >> 1)) & 1ull)) ++kn;
        if (kn <= tb) fa::load_tile(fn, Kbh, Vbh, SEQ, kn * 32, r32, hi);
        const bool mine = (selm >> (kt >> 1)) & 1ull;
        const bool nm = (kt == tb) || !__all(mine);
        fa::step(st, fc, qr, kt * 32, hi, nm, 0, mine ? t : -1);
        fc = fn; kt = kn;
    }
    const float inv = fa::finish(st);
    const float* gates = (const float*)(ws + WS_GATES) + row * 96 + head * 3; const float g0 = gates[0], g1 = gates[1] * inv, g2 = gates[2];
    const bf16* oc = (const bf16*)(ws + WS_OCMP) + row * DM + head * 64; const bf16* ow = (const bf16*)(ws + WS_OWIN) + row * DM + head * 64; bf16* od = OUT + row * DM + head * 64;
#pragma unroll
    for (int g = 0; g < 4; ++g)
#pragma unroll
        for (int db = 0; db < 2; ++db) { const int d = 32 * db + 8 * g + 4 * hi; const u32x2g c = *(const u32x2g*)(oc + d), w = *(const u32x2g*)(ow + d);
            const fa::f32x16& oo = db ? st.o1 : st.o0;
            const float v0 = g0 * fa::bflo(c.x) + g1 * oo[4 * g] + g2 * fa::bflo(w.x), v1 = g0 * fa::bfhi(c.x) + g1 * oo[4 * g + 1] + g2 * fa::bfhi(w.x);
            const float v2 = g0 * fa::bflo(c.y) + g1 * oo[4 * g + 2] + g2 * fa::bflo(w.y), v3 = g0 * fa::bfhi(c.y) + g1 * oo[4 * g + 3] + g2 * fa::bfhi(w.y);
            u32x2g o; o.x = fa::cvtpk(v0, v1); o.y = fa::cvtpk(v2, v3); *(u32x2g*)(od + d) = o; }
}
namespace fb {
using fa::bf16x8; using fa::f32x16; using fa::u32x4;
constexpr int PITCH = 144, TILE = 64 * PITCH, BUF = 2 * TILE;
struct Stage { v4u k, v; };
__device__ __forceinline__ void stage_load(Stage& s, const bf16* Kbh, const bf16* Vbh, int VP, int key0, int tid) {
    const int row = tid >> 3, ch = tid & 7;
    s.k = *(const GAS v4u*)(Kbh + (size_t)(key0 + row) * 64 + ch * 8);
    s.v = *(const GAS v4u*)(Vbh + (size_t)row * VP + key0 + ch * 8);
}
__device__ __forceinline__ void stage_store(const Stage& s, LAS unsigned char* lds, int buf, int tid) {
    const int row = tid >> 3, ch = tid & 7; LAS unsigned char* p = lds + buf * BUF + row * PITCH + ch * 16;
    *(LAS v4u*)p = s.k; *(LAS v4u*)(p + TILE) = s.v;
}
__device__ __forceinline__ void frag_load_k(bf16x8 (&k)[8], const LAS unsigned char* lds, int buf, int r32, int hi) {
    const LAS unsigned char* kb = lds + buf * BUF + fa::kap(r32) * PITCH + hi * 16;
#pragma unroll
    for (int h = 0; h < 2; ++h)
#pragma unroll
        for (int d0 = 0; d0 < 4; ++d0) k[h * 4 + d0] = *(const LAS bf16x8*)(kb + h * 32 * PITCH + d0 * 32);
}
__device__ __forceinline__ void frag_load_v(bf16x8 (&v)[8], const LAS unsigned char* lds, int buf, int r32, int hi) {
    const LAS unsigned char* vb = lds + buf * BUF + TILE + r32 * PITCH + hi * 16;
#pragma unroll
    for (int db = 0; db < 2; ++db)
#pragma unroll
        for (int h = 0; h < 2; ++h)
#pragma unroll
            for (int s = 0; s < 2; ++s) v[(db * 2 + h) * 2 + s] = *(const LAS bf16x8*)(vb + db * 32 * PITCH + h * 64 + s * 32);
}
struct QState { f32x16 o0, o1; float m, l; };
__device__ __forceinline__ void block_step(QState& st, const LAS unsigned char* lds, int buf, int r32, const LAS unsigned char* qlds  , int key0, int hi, bool sel, bool emask, int lo, int hi_) {
    f32x16 p0 = f32x16{}, p1 = f32x16{};
    { bf16x8 fk[8], qr[4]; frag_load_k(fk, lds, buf, r32, hi);
#pragma unroll
      for (int d0 = 0; d0 < 4; ++d0) qr[d0] = *(const LAS bf16x8*)(qlds + d0 * 1024);
#pragma unroll
    for (int d0 = 0; d0 < 4; ++d0) { p0 = __builtin_amdgcn_mfma_f32_32x32x16_bf16(fk[d0], qr[d0], p0, 0, 0, 0); p1 = __builtin_amdgcn_mfma_f32_32x32x16_bf16(fk[4 + d0], qr[d0], p1, 0, 0, 0); } }
    if (emask) { fa::mask_range(p0, key0, hi, lo, hi_); fa::mask_range(p1, key0 + 32, hi, lo, hi_); }
    float ta = fmaxf(p0[0], p0[1]), tb = fmaxf(p1[0], p1[1]);
#pragma unroll
    for (int r = 2; r < 16; ++r) { ta = fmaxf(ta, p0[r]); tb = fmaxf(tb, p1[r]); }
    const float tm = fa::xmax(fmaxf(ta, tb));
    const float mn = sel ? fmaxf(st.m, tm) : st.m; const float alpha = __builtin_amdgcn_exp2f(st.m - mn); st.m = mn;
    const float me = sel ? mn : INFINITY;
    float rs0 = 0.f, rs1 = 0.f;
#pragma unroll
    for (int r = 0; r < 16; ++r) { p0[r] = __builtin_amdgcn_exp2f(p0[r] - me); p1[r] = __builtin_amdgcn_exp2f(p1[r] - me); rs0 += p0[r]; rs1 += p1[r]; }
#if defined(ATT_PROBE) && ATT_PROBE == 1
    {
#pragma unroll
      for (int r = 0; r < 32; ++r) { float d_; asm volatile("v_exp_f32 %0, %1" : "=v"(d_) : "v"(p0[r & 15])); } }
#endif
    st.l = st.l * alpha + (rs0 + rs1);
    if (!__all(alpha == 1.0f)) { st.o0 = st.o0 * alpha; st.o1 = st.o1 * alpha; }
    u32x4 w;
    w.x = fa::cvtpk(p0[0], p0[1]); w.y = fa::cvtpk(p0[2], p0[3]); w.z = fa::cvtpk(p0[4], p0[5]); w.w = fa::cvtpk(p0[6], p0[7]); const bf16x8 a0 = __builtin_bit_cast(bf16x8, w);
    w.x = fa::cvtpk(p0[8], p0[9]); w.y = fa::cvtpk(p0[10], p0[11]); w.z = fa::cvtpk(p0[12], p0[13]); w.w = fa::cvtpk(p0[14], p0[15]); const bf16x8 a1 = __builtin_bit_cast(bf16x8, w);
    w.x = fa::cvtpk(p1[0], p1[1]); w.y = fa::cvtpk(p1[2], p1[3]); w.z = fa::cvtpk(p1[4], p1[5]); w.w = fa::cvtpk(p1[6], p1[7]); const bf16x8 b0 = __builtin_bit_cast(bf16x8, w);
    w.x = fa::cvtpk(p1[8], p1[9]); w.y = fa::cvtpk(p1[10], p1[11]); w.z = fa::cvtpk(p1[12], p1[13]); w.w = fa::cvtpk(p1[14], p1[15]); const bf16x8 b1 = __builtin_bit_cast(bf16x8, w);
    bf16x8 fv[8]; frag_load_v(fv, lds, buf, r32, hi);
#if defined(ATT_PROBE) && ATT_PROBE == 2
    { f32x16 dm = f32x16{};
#pragma unroll
      for (int r = 0; r < 8; ++r) dm = __builtin_amdgcn_mfma_f32_32x32x16_bf16(fv[r], a0, dm, 0, 0, 0);
      asm volatile("" :: "v"(dm)); }
#endif
#if defined(ATT_PROBE) && ATT_PROBE == 3
    { bf16x8 fx[8]; frag_load_k(fx, lds, buf, r32 ^ 1, hi);
#pragma unroll
      for (int r = 0; r < 8; ++r) asm volatile("" :: "v"(fx[r])); }
#endif
    st.o0 = __builtin_amdgcn_mfma_f32_32x32x16_bf16(fv[0], a0, st.o0, 0, 0, 0); st.o1 = __builtin_amdgcn_mfma_f32_32x32x16_bf16(fv[4], a0, st.o1, 0, 0, 0);
    st.o0 = __builtin_amdgcn_mfma_f32_32x32x16_bf16(fv[1], a1, st.o0, 0, 0, 0); st.o1 = __builtin_amdgcn_mfma_f32_32x32x16_bf16(fv[5], a1, st.o1, 0, 0, 0);
    st.o0 = __builtin_amdgcn_mfma_f32_32x32x16_bf16(fv[2], b0, st.o0, 0, 0, 0); st.o1 = __builtin_amdgcn_mfma_f32_32x32x16_bf16(fv[6], b0, st.o1, 0, 0, 0);
    st.o0 = __builtin_amdgcn_mfma_f32_32x32x16_bf16(fv[3], b1, st.o0, 0, 0, 0); st.o1 = __builtin_amdgcn_mfma_f32_32x32x16_bf16(fv[7], b1, st.o1, 0, 0, 0);
}
__device__ __forceinline__ void qk2(f32x16& pa0, f32x16& pa1, f32x16& pb0, f32x16& pb1, const LAS unsigned char* lds, int buf, int r32, const LAS unsigned char* qpark, int hi) {
    pa0 = f32x16{}; pa1 = f32x16{}; pb0 = f32x16{}; pb1 = f32x16{};
    { bf16x8 fk[8]; frag_load_k(fk, lds, buf, r32, hi);
#pragma unroll
      for (int d0 = 0; d0 < 4; ++d0) { const bf16x8 qa = *(const LAS bf16x8*)(qpark + d0 * 1024);
          pa0 = __builtin_amdgcn_mfma_f32_32x32x16_bf16(fk[d0], qa, pa0, 0, 0, 0); pa1 = __builtin_amdgcn_mfma_f32_32x32x16_bf16(fk[4 + d0], qa, pa1, 0, 0, 0); }
#pragma unroll
      for (int d0 = 0; d0 < 4; ++d0) { const bf16x8 qb = *(const LAS bf16x8*)(qpark + 4096 + d0 * 1024);
          pb0 = __builtin_amdgcn_mfma_f32_32x32x16_bf16(fk[d0], qb, pb0, 0, 0, 0); pb1 = __builtin_amdgcn_mfma_f32_32x32x16_bf16(fk[4 + d0], qb, pb1, 0, 0, 0); } }
}
__device__ __forceinline__ void sp2(QState& s0, QState& s1, f32x16& pa0, f32x16& pa1, f32x16& pb0, f32x16& pb1, const LAS unsigned char* lds, int buf, int r32, int key0, int hi,
                                    bool sel0, bool sel1, bool emask, int lo0, int hi0, int lo1, int hi1) {
    bf16x8 fv[8];
#define SP_(st, p0, p1, sel, lo, hi_, LOADV) do { \
    if (emask) { fa::mask_range(p0, key0, hi, lo, hi_); fa::mask_range(p1, key0 + 32, hi, lo, hi_); } \
    float ta = fmaxf(p0[0], p0[1]), tb = fmaxf(p1[0], p1[1]); \
    _Pragma("unroll") for (int r = 2; r < 16; ++r) { ta = fmaxf(ta, p0[r]); tb = fmaxf(tb, p1[r]); } \
    const float tm = fa::xmax(fmaxf(ta, tb)); \
    const float mn = sel ? fmaxf(st.m, tm) : st.m; const float alpha = __builtin_amdgcn_exp2f(st.m - mn); st.m = mn; \
    const float me = sel ? mn : INFINITY; \
    float rs0 = 0.f, rs1 = 0.f; \
    _Pragma("unroll") for (int r = 0; r < 16; ++r) { p0[r] = __builtin_amdgcn_exp2f(p0[r] - me); p1[r] = __builtin_amdgcn_exp2f(p1[r] - me); rs0 += p0[r]; rs1 += p1[r]; } \
    st.l = st.l * alpha + (rs0 + rs1); \
    if (!__all(alpha == 1.0f)) { st.o0 = st.o0 * alpha; st.o1 = st.o1 * alpha; } \
    u32x4 w; \
    w.x = fa::cvtpk(p0[0], p0[1]); w.y = fa::cvtpk(p0[2], p0[3]); w.z = fa::cvtpk(p0[4], p0[5]); w.w = fa::cvtpk(p0[6], p0[7]); const bf16x8 a0 = __builtin_bit_cast(bf16x8, w); \
    w.x = fa::cvtpk(p0[8], p0[9]); w.y = fa::cvtpk(p0[10], p0[11]); w.z = fa::cvtpk(p0[12], p0[13]); w.w = fa::cvtpk(p0[14], p0[15]); const bf16x8 a1 = __builtin_bit_cast(bf16x8, w); \
    w.x = fa::cvtpk(p1[0], p1[1]); w.y = fa::cvtpk(p1[2], p1[3]); w.z = fa::cvtpk(p1[4], p1[5]); w.w = fa::cvtpk(p1[6], p1[7]); const bf16x8 b0 = __builtin_bit_cast(bf16x8, w); \
    w.x = fa::cvtpk(p1[8], p1[9]); w.y = fa::cvtpk(p1[10], p1[11]); w.z = fa::cvtpk(p1[12], p1[13]); w.w = fa::cvtpk(p1[14], p1[15]); const bf16x8 b1 = __builtin_bit_cast(bf16x8, w); \
    if (LOADV) { __builtin_amdgcn_sched_barrier(0); frag_load_v(fv, lds, buf, r32, hi); } \
    st.o0 = __builtin_amdgcn_mfma_f32_32x32x16_bf16(fv[0], a0, st.o0, 0, 0, 0); st.o1 = __builtin_amdgcn_mfma_f32_32x32x16_bf16(fv[4], a0, st.o1, 0, 0, 0); \
    st.o0 = __builtin_amdgcn_mfma_f32_32x32x16_bf16(fv[1], a1, st.o0, 0, 0, 0); st.o1 = __builtin_amdgcn_mfma_f32_32x32x16_bf16(fv[5], a1, st.o1, 0, 0, 0); \
    st.o0 = __builtin_amdgcn_mfma_f32_32x32x16_bf16(fv[2], b0, st.o0, 0, 0, 0); st.o1 = __builtin_amdgcn_mfma_f32_32x32x16_bf16(fv[6], b0, st.o1, 0, 0, 0); \
    st.o0 = __builtin_amdgcn_mfma_f32_32x32x16_bf16(fv[3], b1, st.o0, 0, 0, 0); st.o1 = __builtin_amdgcn_mfma_f32_32x32x16_bf16(fv[7], b1, st.o1, 0, 0, 0); } while (0)
    SP_(s0, pa0, pa1, sel0, lo0, hi0, true);
    __builtin_amdgcn_sched_barrier(0);
    SP_(s1, pb0, pb1, sel1, lo1, hi1, false);
#undef SP_
}
__device__ __forceinline__ float finish(QState& st) { const float lt = fa::xsum(st.l); return lt > 0.f ? 1.0f / lt : 0.f; }
}

template <int MODE, int W>
__device__ __forceinline__ void attn64_unit(unsigned char* ws, LAS unsigned char* lds, int b, int hkv, int c, int tid, int wave, int lane, const bf16* Q, const bf16* K, const bf16* VT, bf16* OUT, const float* sinks) {
    const int r32 = lane & 31, hi = lane >> 5, head = hkv * 8 + wave, q0 = c * 64;
    const bf16* Kbh = K + (size_t)(b * 4 + hkv) * SEQ * 64; const bf16* Vbh = VT + (size_t)(b * 4 + hkv) * 64 * SEQ;
    fb::QState st[2]; unsigned long long selm[2] = {~0ull, ~0ull};
    LAS unsigned char* qpark = lds + 2 * fb::BUF + wave * 8192 + lane * 16;
#pragma unroll
    for (int g = 0; g < 2; ++g) { const size_t row = (size_t)b * SEQ + q0 + 32 * g + r32;
        { fa::bf16x8 qr[4]; fa::load_q(qr, Q + row * DM + head * 64, hi);
#pragma unroll
          for (int d0 = 0; d0 < 4; ++d0) *(LAS fa::bf16x8*)(qpark + (g * 4 + d0) * 1024) = qr[d0]; }
        st[g].o0 = fa::f32x16{}; st[g].o1 = fa::f32x16{};
        if (MODE == 0) { st[g].m = sinks[head] * LOG2E; st[g].l = hi == 0 ? 1.0f : 0.0f; } else { st[g].m = fa::NEGBIG; st[g].l = 0.f; }
        if (MODE == 2) { const unsigned long long sm = ((const unsigned long long*)(ws + WS_SELM))[(size_t)(b * 4 + hkv) * SEQ + q0 + 32 * g + r32];
            unsigned lo_ = (unsigned)sm, hi_ = (unsigned)(sm >> 32), lo2, hi2;
            asm volatile("v_mov_b32 %0, %2\n\tv_mov_b32 %1, %3" : "=&v"(lo2), "=&v"(hi2) : "v"(lo_), "v"(hi_));
            selm[g] = ((unsigned long long)hi2 << 32) | lo2; } }
    const int jlo = (MODE == 2) ? 0 : (c - W / 64 > 0 ? c - W / 64 : 0);
    fb::Stage sg; fb::stage_load(sg, Kbh, Vbh, SEQ, jlo * 64, tid); fb::stage_store(sg, lds, 0, tid);
    LDS_WAIT(); __syncthreads();
    for (int j = jlo; j <= c; ++j) {
        const int buf = (j - jlo) & 1;
        const bool em = (j == c) || (MODE != 2 && j == c - W / 64);
        if (MODE == 0) {
          if (j < c) fb::stage_load(sg, Kbh, Vbh, SEQ, (j + 1) * 64, tid);
#pragma unroll
          for (int g = 0; g < 2; ++g) { const int t = q0 + 32 * g + r32;
              fb::block_step(st[g], lds, buf, r32, qpark + g * 4096, j * 64, hi, true, em, t - W + 1, t);
              __builtin_amdgcn_sched_barrier(0); }
        } else { const int t0 = q0 + r32, t1 = t0 + 32;
          const bool sel0 = (MODE == 2) ? (bool)((selm[0] >> j) & 1ull) : true, sel1 = (MODE == 2) ? (bool)((selm[1] >> j) & 1ull) : true;
          fa::f32x16 pa0, pa1, pb0, pb1;
          fb::qk2(pa0, pa1, pb0, pb1, lds, buf, r32, qpark, hi);
          __builtin_amdgcn_sched_barrier(0);
          if (j < c) fb::stage_load(sg, Kbh, Vbh, SEQ, (j + 1) * 64, tid);
          fb::sp2(st[0], st[1], pa0, pa1, pb0, pb1, lds, buf, r32, j * 64, hi, sel0, sel1, em, (MODE == 2) ? 0 : t0 - W + 1, t0, (MODE == 2) ? 0 : t1 - W + 1, t1);
          __builtin_amdgcn_sched_barrier(0); }
        if (j < c) fb::stage_store(sg, lds, buf ^ 1, tid);
        LDS_WAIT(); __syncthreads();
    }
#pragma unroll
    for (int g = 0; g < 2; ++g) { const size_t row = (size_t)b * SEQ + q0 + 32 * g + r32; const float inv = fb::finish(st[g]);
        if (MODE != 2) { fa::State so; so.o0 = st[g].o0; so.o1 = st[g].o1; fa::store_o(so, inv, OUT + row * DM + head * 64, hi); }
        else {
            const float* gates = (const float*)(ws + WS_GATES) + row * 96 + head * 3; const float g0 = gates[0], g1 = gates[1] * inv, g2 = gates[2];
            const bf16* oc = (const bf16*)(ws + WS_OCMP) + row * DM + head * 64; const bf16* ow = (const bf16*)(ws + WS_OWIN) + row * DM + head * 64; bf16* od = OUT + row * DM + head * 64;
#pragma unroll
            for (int gg = 0; gg < 4; ++gg)
#pragma unroll
                for (int db = 0; db < 2; ++db) { const int d = 32 * db + 8 * gg + 4 * hi; const u32x2g cc = *(const u32x2g*)(oc + d), w = *(const u32x2g*)(ow + d);
                    const fa::f32x16& oo = db ? st[g].o1 : st[g].o0;
                    const float v0 = g0 * fa::bflo(cc.x) + g1 * oo[4 * gg] + g2 * fa::bflo(w.x), v1 = g0 * fa::bfhi(cc.x) + g1 * oo[4 * gg + 1] + g2 * fa::bfhi(w.x);
                    const float v2 = g0 * fa::bflo(cc.y) + g1 * oo[4 * gg + 2] + g2 * fa::bflo(w.y), v3 = g0 * fa::bfhi(cc.y) + g1 * oo[4 * gg + 3] + g2 * fa::bfhi(w.y);
                    u32x2g o; o.x = fa::cvtpk(v0, v1); o.y = fa::cvtpk(v2, v3); *(u32x2g*)(od + d) = o; }
        }
    }
}
template <int MODE, int W>
__device__ __forceinline__ void phase_attn64(unsigned char* ws, LAS unsigned char* lds, int vcu, int tid, int wave, int lane, const bf16* Q, const bf16* K, const bf16* VT, bf16* OUT, const float* sinks) {
    const int bh = (vcu >> 5) & 7, x = vcu & 31;
#pragma unroll 1
    for (int i = 0; i < 2; ++i) attn64_unit<MODE, W>(ws, lds, bh >> 2, bh & 3, i ? 63 - x : x, tid, wave, lane, Q, K, VT, OUT, sinks);
}
__device__ __forceinline__ int mk_lane() { int l; asm volatile("v_mbcnt_lo_u32_b32 %0, -1, 0\n\tv_mbcnt_hi_u32_b32 %0, -1, %0" : "=v"(l)); return l; }
typedef const void* const __attribute__((address_space(4))) * karg_ptr_t;
__device__ __forceinline__ void load_in(In& I) {
    karg_ptr_t ap = (karg_ptr_t)__builtin_amdgcn_kernarg_segment_ptr(); asm volatile("" : "+s"(ap));
#define GP(T, k) ((const T*)(const GAS T*)(unsigned long long)ap[k])
    I.x = GP(float, 0); I.c = GP(float, 1); I.positions = GP(int, 2); I.w_ada = GP(float, 3); I.b_ada = GP(float, 4);
    I.swa_w_qkv = GP(float, 5); I.swa_b_qkv = GP(float, 6); I.swa_sinks = GP(float, 7); I.swa_w_o = GP(float, 8);
    I.nsa_w_in = GP(float, 9); I.nsa_pe_k = GP(float, 10); I.nsa_pe_v = GP(float, 11); I.nsa_phi_k1 = GP(float, 12); I.nsa_phi_k2 = GP(float, 13);
    I.nsa_phi_v1 = GP(float, 14); I.nsa_phi_v2 = GP(float, 15); I.nsa_w_o = GP(float, 16);
    I.moe_w_group = GP(float, 17); I.moe_b_group = GP(float, 18); I.moe_w_router = GP(float, 19); I.moe_b_router = GP(float, 20);
    I.moe_w1 = GP(float, 21); I.moe_w3 = GP(float, 22); I.moe_w2 = GP(float, 23);
    I.ln_t_g = GP(float, 24); I.ln_t_b = GP(float, 25); I.ln_c_g = GP(float, 26); I.ln_c_b = GP(float, 27);
#undef GP
}
struct Args { const void* in[28]; float* out; unsigned char* ws; int ph_lo, ph_hi, li, pad; };
__global__ void __launch_bounds__(NWAVES * 64, 2) hyb_fwd(Args args) {
    extern __shared__ __attribute__((aligned(16))) unsigned char lds_raw[];
    LAS unsigned char* lds = (LAS unsigned char*)lds_raw;
    volatile LAS unsigned* MISC = (volatile LAS unsigned*)(lds + MISC_OFF);
    const int wave_s = __builtin_amdgcn_readfirstlane((int)threadIdx.x >> 6);
#define MK_TID() (wave_s * 64 + mk_lane())
    const int G0 = gridDim.x, bx0 = blockIdx.x; const int vcu0 = (G0 % 8 == 0) ? (bx0 % 8) * (G0 / 8) + bx0 / 8 : bx0;
    unsigned char* const ws0 = args.ws; gu32* ctl = (gu32*)(ws0 + WS_CTL);
    for (int u = MK_TID(); u < (LDS_BYTES - LDSCTL_OFF) / 4; u += NWAVES * 64) ((LAS unsigned*)(lds + LDSCTL_OFF))[u] = 0u;
    __syncthreads();
    XcdBarrier bar; bar.bar = (unsigned*)(ctl + CW_BAR); bar.x = 0; bar.st = nullptr;
    if (N_LAUNCHES == 1) bar = xcd_barrier_post((unsigned*)(ctl + CW_BAR), MISC + 8, MK_TID());
#if MK_N_LAUNCHES == 1
    constexpr int lo = 0, hi = NPHASE;
#else
    const int lo = args.ph_lo, hi = args.ph_hi;
#endif
    float* const out0 = args.out;
    if (lo == 0) { In I; load_in(I); rope_table(I.positions, (float*)(ws0 + WS_ROPE), vcu0 * (NWAVES * 64) + MK_TID(), G0 * NWAVES * 64); }
#ifdef FULL_TWICE
#pragma unroll 1
    for (int pass_ = 0; pass_ < 2; ++pass_) {
    if (pass_) { XcdBarrier b3 = bar; asm volatile("" : "+s"(b3.bar)); xcd_barrier(b3, MK_TID()); }
#endif
#pragma unroll 1
    for (int ph = lo; ph < hi; ++ph) {
#ifdef DOUBLE_MASK
        const int nrep = ((DOUBLE_MASK >> ph) & 1) ? 2 : 1;
#else
        const int nrep = 1;
#endif
#pragma unroll 1
        for (int rep = 0; rep < nrep; ++rep) {
        if (rep) __syncthreads();
        unsigned long long wsi = (unsigned long long)ws0, outi = (unsigned long long)out0; int G = G0, bx = bx0, vcu = vcu0; int phx = ph;
        int tid = MK_TID();
        asm volatile("" : "+s"(wsi), "+s"(G), "+s"(bx), "+s"(vcu), "+s"(outi), "+s"(phx), "+v"(tid));
        unsigned char* ws = (unsigned char*)(GAS unsigned char*)wsi; float* outp = (float*)(GAS float*)outi;
#ifdef ONLYP
        phx = ONLYP;
#endif
        const int lane = tid & 63, wave = __builtin_amdgcn_readfirstlane(tid >> 6);
#if defined(FULL_TWICE) && defined(SKIP2_MASK)
        if (pass_ == 1 && ((SKIP2_MASK >> ph) & 1)) phx = 99;
#endif
#if defined(FULL_TWICE) && defined(ABLATE)
        const int ablate_ = pass_ == 1 ? ABLATE : 0;
#else
        const int ablate_ = 0;
#endif
        const int gw = vcu * NWAVES + wave, NGW = G * NWAVES;
        const int layer = phx >= 10 ? 1 : 0, cp = phx - (layer ? 15 : 4);
        switch (phx) {
        case 0: {
            In I; load_in(I); phase_mod_partial(I.c, I.w_ada, (float*)(ws + WS_MODP), (LAS float*)(lds + wave * 16384), gw, NGW, lane);
        } break;
        case 1: {
            In I; load_in(I); phase_prologue(I, ws, lds, tid, lane, wave, vcu, G);
        } break;
        case 2: {
            In I; load_in(I); pg8::Gemm g{(const bf16*)(ws + WS_H), (const bf16*)(ws + WS_WQKV), NTOK, 2560, DM}; pg8::StaticOrder S; S.init(NTOK, 2560, G, bx);
            pg8::EpiQKV E{(bf16*)(ws + WS_Q), (bf16*)(ws + WS_K0), (bf16*)(ws + WS_VT0), I.swa_b_qkv, (const float*)(ws + WS_ROPE), QSCALE};
            pg8::gemm_phase<pg8::EpiQKV, pg8::StaticOrder, true, true>(lds + RING_OFF, g, S, E, tid);
            conv_fill(I, ws, lds, 0, G, tid, wave, lane);
        } break;
        case 3: {
            In I; load_in(I); conv_drain(I, ws, lds, CV_B, tid, wave, lane); phase_attn64<0, 128>(ws, lds, vcu, tid, wave, lane, (const bf16*)(ws + WS_Q), (const bf16*)(ws + WS_K0), (const bf16*)(ws + WS_VT0), (bf16*)(ws + WS_ATT), I.swa_sinks);
        } break;
        case 10: {
            In I; load_in(I); pg8::Gemm g{(const bf16*)(ws + WS_H), (const bf16*)(ws + WS_WIN), NTOK, 3840, DM}; pg8::StaticOrder S; S.init(NTOK, 3840, G, bx);
            pg8::EpiNSA E{(bf16*)(ws + WS_QRAW), (bf16*)(ws + WS_Q), (bf16*)(ws + WS_KC), (bf16*)(ws + WS_VC), (bf16*)(ws + WS_KS), (bf16*)(ws + WS_VST), (bf16*)(ws + WS_KW), (bf16*)(ws + WS_VWT), (float*)(ws + WS_GATES), (const float*)(ws + WS_ROPE), QSCALE, ablate_};
            pg8::gemm_phase<pg8::EpiNSA, pg8::StaticOrder, true, true>(lds + RING_OFF, g, S, E, tid);
            conv_fill(I, ws, lds, 3, G, tid, wave, lane);
        } break;
        case 11: {
            int bxv = ((vcu & 31) < 4) ? ((vcu >> 5) & 7) * 4 + (vcu & 31) : 128;
            asm volatile("" : "+s"(bxv));
#pragma unroll 1
            for (int which = 0; which < 2; ++which) {
                pg8::Gemm g{(const bf16*)(ws + (which ? WS_VC : WS_KC)), (const bf16*)(ws + (which ? WS_PHIV : WS_PHIK)), 2048, 512, 1024}; pg8::StaticOrder S; S.init(2048, 512, G, which ? (bxv + G - 16) % G : bxv);
                pg8::EpiF32 E{(float*)(ws + (which ? WS_ULV : WS_ULK)), 512};
                pg8::gemm_phase<pg8::EpiF32, pg8::StaticOrder, false, true>(lds + RING_OFF, g, S, E, tid); }
            phase_attn64<1, 512>(ws, lds, vcu, tid, wave, lane, (const bf16*)(ws + WS_Q), (const bf16*)(ws + WS_KW), (const bf16*)(ws + WS_VWT), (bf16*)(ws + WS_OWIN), nullptr);
        } break;
        case 12: {
            In I; load_in(I); conv_drain(I, ws, lds, CV_D - 16 * 512, tid, wave, lane); phase_cmp2(I, ws, lds, gw, NGW, lane, tid, wave);
        } break;
        case 13: {
            { const int bh = (vcu >> 5) & 7;
              const bf16* kc = (const bf16*)(ws + WS_KCMP) + (size_t)bh * 256 * 64;
              for (int i = tid; i < 256 * 8; i += NWAVES * 64) { const int r = i >> 3, ch = i & 7; *(LAS v4u*)(lds + CMP_K + r * 144 + ch * 16) = *(const GAS v4u*)(kc + (size_t)r * 64 + ch * 8); }
              const bf16* vc = (const bf16*)(ws + WS_VCMPT) + (size_t)bh * 64 * 256;
              for (int i = tid; i < 64 * 32; i += NWAVES * 64) { const int r = i >> 5, ch = i & 31; *(LAS v4u*)(lds + CMP_V + r * CMP_VP + ch * 16) = *(const GAS v4u*)(vc + (size_t)r * 256 + ch * 8); }
              LDS_WAIT(); __syncthreads(); }
            for (int u = vcu; u < 1024; u += G) { const int k_ = u >> 8, x_ = u & 31;
                cmp_unit(ws, lds, (u >> 7) & 1, (u >> 5) & 3, (k_ >> 1) * 64 + ((k_ & 1) ? 63 - x_ : x_), tid, wave, lane); }
        } break;
        case 14: {
            phase_attn64<2, 0>(ws, lds, vcu, tid, wave, lane, (const bf16*)(ws + WS_Q), (const bf16*)(ws + WS_KS), (const bf16*)(ws + WS_VST), (bf16*)(ws + WS_ATT), nullptr);
        } break;
        default: switch (cp) {
        case 0: {
            In I; load_in(I); pg8::Gemm g{(const bf16*)(ws + WS_ATT), (const bf16*)(ws + (layer ? WS_WO1 : WS_WO0)), NTOK, DM, DM}; pg8::StaticOrder S; S.init(NTOK, DM, G, bx);
            pg8::EpiWoRes E{layer ? nullptr : I.x, (const bf16*)(ws + WS_XB), (const float*)(ws + WS_MOD) + (size_t)layer * 2 * 12288 + 4096, 12288, (bf16*)(ws + WS_Y), ALPHA_RES};
            pg8::gemm_phase<pg8::EpiWoRes, pg8::StaticOrder, true, true>(lds + RING_OFF, g, S, E, tid);
        } break;
        case 1: {
            In I; load_in(I); phase_lnt2(I, ws, lds, (LAS int*)(lds + 131072 + 1024), layer, (const bf16*)(ws + WS_Y), gw, lane, tid, wave, vcu);
        } break;
        case 2: {
            phase_permute(ws, (LAS int*)(lds + 131072 + 1024), layer, gw, lane, tid, vcu);
        } break;
        case 3: {
            Seg sg; seg_load(sg, (const unsigned*)(ws + WS_CTL) + CW_CNT + layer * 16); pg8::GroupOrder S; build_units(S, sg, 4, G, bx);
            pg8::Gemm g{(const bf16*)(ws + WS_H), (const bf16*)(ws + WS_W13) + (size_t)layer * 16 * 1024 * 2048, 0, 0, DM, (const int*)(ws + WS_ROWSRC)}; pg8::EpiUp E{(bf16*)(ws + WS_HE)};
            pg8::gemm_phase<pg8::EpiUp, pg8::GroupOrder, true, true, true>(lds + RING_OFF, g, S, E, tid);
            { In I; load_in(I); conv_fill(I, ws, lds, 1 + 3 * layer, G, tid, wave, lane); if (layer) conv_drain(I, ws, lds, CV_D, tid, wave, lane); }
        } break;
        case 4: {
            Seg sg; seg_load(sg, (const unsigned*)(ws + WS_CTL) + CW_CNT + layer * 16); pg8::GroupOrder S; build_units(S, sg, 8, G, bx);
            pg8::Gemm g{(const bf16*)(ws + WS_HE), (const bf16*)(ws + WS_W2) + (size_t)layer * 16 * 2048 * 512, 0, 0, DEXP}; pg8::EpiDown E{(bf16*)(ws + WS_YS), (const int*)(ws + WS_ROWTOK), (const float*)(ws + WS_ROWW)};
            pg8::gemm_phase<pg8::EpiDown, pg8::GroupOrder, true, true>(lds + RING_OFF, g, S, E, tid);
            { In I; load_in(I); conv_fill(I, ws, lds, 2 + 3 * layer, G, tid, wave, lane); }
        } break;
        case 5: {
            In I; load_in(I); if (layer == 0) conv_drain(I, ws, lds, CV_C, tid, wave, lane);
            for (int rb = gw; rb < NTOK / 4; rb += NGW) phase_lnc(I, ws, layer, outp, (bf16*)(ws + WS_XB), layer == 0, rb, lane);
        } break;
        default: break; }
        break; }
        }
        if (ph + 1 < hi) { XcdBarrier b2 = bar; asm volatile("" : "+s"(b2.bar)); xcd_barrier(b2, MK_TID()); }
    }
#ifdef FULL_TWICE
    }
#endif
}

extern "C" void kernel_launch(void* const* d_in, const int* in_sizes, int n_in, void* d_out, int out_size, void* d_ws, size_t ws_size, hipStream_t stream) {
    static int grid = 0;
    if (grid == 0) {
        if (n_in != 28 || in_sizes[0] != NTOK * DM || out_size != NTOK * DM || ws_size < WS_END) { fprintf(stderr, "kernel_launch: built for 28 inputs, x/out of %d floats, >= %zu bytes of workspace; got n_in %d, in0 %d, out %d, ws %zu; nothing launched\n", NTOK * DM, (size_t)WS_END, n_in, n_in > 0 ? in_sizes[0] : -1, out_size, ws_size); grid = -1; return; }
        int dev = 0, cus = 0, per_cu = 0;
        if (hipGetDevice(&dev) != hipSuccess || hipDeviceGetAttribute(&cus, hipDeviceAttributeMultiprocessorCount, dev) != hipSuccess) { fprintf(stderr, "kernel_launch: device query failed\n"); grid = -1; return; }
        if (hipFuncSetAttribute((const void*)hyb_fwd, hipFuncAttributeMaxDynamicSharedMemorySize, LDS_BYTES) != hipSuccess) { fprintf(stderr, "kernel_launch: hipFuncSetAttribute failed\n"); grid = -1; return; }
        if (hipOccupancyMaxActiveBlocksPerMultiprocessor(&per_cu, (const void*)hyb_fwd, NWAVES * 64, LDS_BYTES) != hipSuccess || per_cu < 1) { fprintf(stderr, "kernel_launch: occupancy query reports %d workgroups per CU\n", per_cu); }
        (void)hipGetLastError();
        grid = cus;
        if (grid != 256) { fprintf(stderr, "kernel_launch: %d CUs; this kernel is built for exactly 256 workgroups; nothing launched\n", grid); grid = -1; return; }
    }
    if (grid < 0) return;
    if (hipMemsetAsync((char*)d_ws + WS_CTL, 0, CTL_ZERO_BYTES, stream) != hipSuccess) { fprintf(stderr, "kernel_launch: memset failed\n"); return; }
    Args a{};
    for (int i = 0; i < 28; ++i) a.in[i] = d_in[i];
    a.out = (float*)d_out; a.ws = (unsigned char*)d_ws;
    for (int li = 0; li < N_LAUNCHES; ++li) {
        if (N_LAUNCHES == 1) { a.ph_lo = 0; a.ph_hi = NPHASE; } else { a.ph_lo = li; a.ph_hi = li + 1; }
        a.li = li;
        hipLaunchKernelGGL(hyb_fwd, dim3(grid), dim3(NWAVES * 64), LDS_BYTES, stream, a);
        const hipError_t le = hipPeekAtLastError();
        if (le != hipSuccess) { fprintf(stderr, "kernel_launch: launch %d failed: %s\n", li, hipGetErrorName(le)); break; }
    }
}
```

```cpp
#include <hip/hip_runtime.h>
#include <hip/hip_bf16.h>
#include <cstdio>
#include <cstdint>
#include <cmath>
namespace pg8 {
#define PG8_LAS __attribute__((address_space(3)))
typedef unsigned short bf16_t;
typedef short bf16x8 __attribute__((ext_vector_type(8)));
typedef float f32x4 __attribute__((ext_vector_type(4)));
typedef unsigned u32x4 __attribute__((ext_vector_type(4)));
constexpr int BM = 256, BK = 64, HALF = 128, HTB = HALF * BK * 2  , STAGE_BYTES = 8 * HTB, NXCD = 8, WGM = 8;

__host__ __device__ __forceinline__ int lds_byte(int r, int c) { const int st = (r >> 4) * 2 + (c >> 5), rr = r & 15, cc = c & 31, ob = rr * 64 + cc * 2; return st * 1024 + (ob ^ (((ob >> 9) & 1) << 5)); }
__host__ __device__ __forceinline__ void stage_rc(int b, int& R, int& C) { const int st = b / 1024, sb = b % 1024, swz = sb ^ (((sb >> 9) & 1) << 5); R = (st >> 1) * 16 + swz / 64; C = (st & 1) * 32 + (swz % 64) / 2; }
__host__ __device__ __forceinline__ int perm32(int rho) { const int n = rho >> 4, i = rho & 15; return 8 * (i >> 2) + 4 * n + (i & 3); }

struct Unit { int pm, pn, pnl, nvalid; };
struct Gemm { const bf16_t* A; const bf16_t* Bt; int M, N, K; const int* rowmap; };

struct StaticOrder {
    int nM, nN, nwg, G, c;
    __host__ __device__ void init(int M, int N, int G_, int c_) { nM = M / BM; nN = N / BM; nwg = nM * nN; G = G_; c = c_; }
    __host__ __device__ bool next(int i, Unit& u) const {
        const long L = (long)i * G + c; if (L >= nwg) return false;
        int wgid = (int)L; { const int q = nwg / NXCD, r = nwg % NXCD, xcd = wgid % NXCD, off = wgid / NXCD; wgid = (xcd < r ? xcd * (q + 1) : r * (q + 1) + (xcd - r) * q) + off; }
        const int nig = WGM * nN, gid = wgid / nig, fm = gid * WGM, gsz = (nM - fm) < WGM ? (nM - fm) : WGM;
        u.pm = fm + ((wgid % nig) % gsz); u.pn = (wgid % nig) / gsz; return true;
    }
    __device__ __forceinline__ void a_ready(const Unit&) const {}
    __device__ __forceinline__ void done(const Unit&) const {}
};
__device__ __forceinline__ unsigned cvt_pk_bf16(float lo, float hi) { unsigned r; asm volatile("v_cvt_pk_bf16_f32 %0, %1, %2" : "=v"(r) : "v"(lo), "v"(hi)); return r; }
typedef float f32x2 __attribute__((ext_vector_type(2)));
typedef unsigned u32x2 __attribute__((ext_vector_type(2)));
__device__ __forceinline__ float silu_f(float a) { return a * __builtin_amdgcn_rcpf(1.0f + __builtin_amdgcn_exp2f(-1.4426950408889634f * a)); }
__device__ __forceinline__ float sigmoid_f(float a) { return __builtin_amdgcn_rcpf(1.0f + __builtin_amdgcn_exp2f(-1.4426950408889634f * a)); }
__device__ __forceinline__ u32x4 pack8(const f32x4& a, const f32x4& b) { u32x4 w; w.x = cvt_pk_bf16(a[0], a[1]); w.y = cvt_pk_bf16(a[2], a[3]); w.z = cvt_pk_bf16(b[0], b[1]); w.w = cvt_pk_bf16(b[2], b[3]); return w; }
__device__ __forceinline__ unsigned short bf1(float v) { return (unsigned short)(cvt_pk_bf16(v, 0.f) & 0xffffu); }

__device__ __forceinline__ void rope8(f32x4& v0, f32x4& v1, const f32x4 (&cs)[4], int fq) {
    f32x4 p0, p1;
#pragma unroll
    for (int i = 0; i < 4; ++i) { p0[i] = __shfl_xor(v0[i], 16); p1[i] = __shfl_xor(v1[i], 16); }
    if (fq < 2) { const float sg = fq == 0 ? -1.f : 1.f; v0 = v0 * cs[0] + (p0 * cs[2]) * sg; v1 = v1 * cs[1] + (p1 * cs[3]) * sg; }
}
__device__ __forceinline__ void rope_ld(f32x4 (&cs)[4], const float* ropeRow, bool want) {
    if (want) { cs[0] = *(const f32x4*)(ropeRow); cs[1] = *(const f32x4*)(ropeRow + 4); cs[2] = *(const f32x4*)(ropeRow + 8); cs[3] = *(const f32x4*)(ropeRow + 12); }
}
__device__ __forceinline__ void store_vt8(bf16_t* VT, int b, int hk, int d0, int s, const f32x4& v0, const f32x4& v1) {
    bf16_t* p = VT + ((size_t)((b * 4 + hk) * 64 + d0)) * 4096 + s;
#pragma unroll
    for (int i = 0; i < 4; ++i) { p[(size_t)i * 4096] = bf1(v0[i]); p[(size_t)(i + 4) * 4096] = bf1(v1[i]); }
}

struct EpiQKV {
    static constexpr bool PERM = true, AFTER_DRAIN = false;
    bf16_t* Q; bf16_t* K; bf16_t* VT; const float* bias; const float* rope; float qscale;
    __device__ __forceinline__ void operator()(const f32x4 (&acc)[2][2][4][2], const Unit& u, int wr, int wc, int fr, int fq) const {
        const int pn = u.pn; const bool rot = (pn <= 8) && ((wc & 1) == 0);
        f32x4 bv[2][2];
#pragma unroll
        for (int bj = 0; bj < 2; ++bj)
#pragma unroll
            for (int n = 0; n < 2; ++n) bv[bj][n] = *(const f32x4*)(bias + pn * BM + bj * HALF + wc * 32 + 8 * fq + 4 * n);
        const bool wantr = rot && fq < 2; const int rowb = u.pm * BM + wr * 64 + fr;
        f32x4 cs[4] = {}; rope_ld(cs, rope + (size_t)rowb * 16, wantr);
#pragma unroll
        for (int ai = 0; ai < 2; ++ai)
#pragma unroll
            for (int m = 0; m < 4; ++m) {
                const int row = rowb + ai * HALF + m * 16, b = row >> 12, s = row & 4095;
                f32x4 w0[2], w1[2];
#pragma unroll
                for (int bj = 0; bj < 2; ++bj) { w0[bj] = acc[ai][bj][m][0] + bv[bj][0]; w1[bj] = acc[ai][bj][m][1] + bv[bj][1]; if (rot) rope8(w0[bj], w1[bj], cs, fq); }
                if (ai * 4 + m < 7) { const int nx = ai * 4 + m + 1; rope_ld(cs, rope + (size_t)(rowb + (nx >> 2) * HALF + (nx & 3) * 16) * 16, wantr); }
#pragma unroll
                for (int bj = 0; bj < 2; ++bj) {
                    const int col = bj * HALF + wc * 32 + 8 * fq;
                    f32x4 v0 = w0[bj], v1 = w1[bj];
                    if (pn < 8) { v0 = v0 * qscale; v1 = v1 * qscale; *(u32x4*)(Q + (size_t)row * 2048 + pn * BM + col) = pack8(v0, v1); }
                    else if (pn == 8) { *(u32x4*)(K + ((size_t)((b * 4 + (col >> 6)) * 4096 + s)) * 64 + (col & 63)) = pack8(v0, v1); }
                    else store_vt8(VT, b, col >> 6, col & 63, s, v0, v1);
                }
            }
    }
};
struct EpiNSA {
    static constexpr bool PERM = true, AFTER_DRAIN = false;
    bf16_t *QRAW, *QROT, *KC, *VC, *KS, *VST, *KW, *VWT; float* GATES; const float* rope; float qscale; int ablate;
    __device__ __forceinline__ void operator()(const f32x4 (&acc)[2][2][4][2], const Unit& u, int wr, int wc, int fr, int fq) const {
        if (ablate & 2) return;
        const int pn = u.pn; const bool rot = (pn < 8 || pn == 10 || pn == 12) && ((wc & 1) == 0);
        const bool wantr = rot && fq < 2; const int rowb = u.pm * BM + wr * 64 + fr;
        f32x4 cs[4] = {}; rope_ld(cs, rope + (size_t)rowb * 16, wantr);
#pragma unroll
        for (int ai = 0; ai < 2; ++ai)
#pragma unroll
            for (int m = 0; m < 4; ++m) {
                const int row = rowb + ai * HALF + m * 16, b = row >> 12, s = row & 4095;
                f32x4 w0[2], w1[2];
#pragma unroll
                for (int bj = 0; bj < 2; ++bj) { w0[bj] = acc[ai][bj][m][0]; w1[bj] = acc[ai][bj][m][1]; if (rot) rope8(w0[bj], w1[bj], cs, fq); }
                if (ai * 4 + m < 7) { const int nx = ai * 4 + m + 1; rope_ld(cs, rope + (size_t)(rowb + (nx >> 2) * HALF + (nx & 3) * 16) * 16, wantr); }
#pragma unroll
                for (int bj = 0; bj < 2; ++bj) {
                    const int col = bj * HALF + wc * 32 + 8 * fq;
                    f32x4 v0 = w0[bj], v1 = w1[bj];
                    if (pn < 8) { *(u32x4*)(QROT + (size_t)row * 2048 + pn * BM + col) = pack8(v0 * qscale, v1 * qscale); }
                    else if (pn == 8 || pn == 9 || pn == 10 || pn == 12) {
                        bf16_t* dst = pn == 8 ? KC : pn == 9 ? VC : pn == 10 ? KS : KW;
                        *(u32x4*)(dst + ((size_t)((b * 4 + (col >> 6)) * 4096 + s)) * 64 + (col & 63)) = pack8(v0, v1); }
                    else if ((pn == 11 || pn == 13) && (ablate & 1)) {}
                    else if (pn == 11 || pn == 13) store_vt8(pn == 11 ? VST : VWT, b, col >> 6, col & 63, s, v0, v1);
                    else if (col < 96) {
                        f32x4 g0, g1;
#pragma unroll
                        for (int i = 0; i < 4; ++i) { g0[i] = sigmoid_f(v0[i]); g1[i] = sigmoid_f(v1[i]); }
                        *(f32x4*)(GATES + (size_t)row * 96 + col) = g0; *(f32x4*)(GATES + (size_t)row * 96 + col + 4) = g1; }
                }
            }
    }
};
__device__ __forceinline__ float bf_lo(unsigned w) { return __uint_as_float(w << 16); }
__device__ __forceinline__ float bf_hi(unsigned w) { return __uint_as_float(w & 0xffff0000u); }
struct EpiWoRes {
    static constexpr bool PERM = true, AFTER_DRAIN = false;
    const float* x32; const bf16_t* x16; const float* gate; int gstride; bf16_t* Y; float alpha;
    __device__ __forceinline__ void operator()(const f32x4 (&acc)[2][2][4][2], const Unit& u, int wr, int wc, int fr, int fq) const {
        const int b = (u.pm * BM) >> 12; const int col0 = u.pn * BM + wc * 32 + 8 * fq;
        f32x4 gv[2][2];
#pragma unroll
        for (int bj = 0; bj < 2; ++bj)
#pragma unroll
            for (int n = 0; n < 2; ++n) gv[bj][n] = *(const f32x4*)(gate + (size_t)b * gstride + col0 + bj * HALF + n * 4);
#pragma unroll
        for (int ai = 0; ai < 2; ++ai)
#pragma unroll
            for (int m = 0; m < 4; ++m) { const size_t off = (size_t)(u.pm * BM + ai * HALF + wr * 64 + m * 16 + fr) * 2048 + col0;
#pragma unroll
                for (int bj = 0; bj < 2; ++bj) { f32x4 x0, x1;
                    if (x32) { x0 = *(const f32x4*)(x32 + off + bj * HALF); x1 = *(const f32x4*)(x32 + off + bj * HALF + 4); }
                    else { const u32x4 w = *(const u32x4*)(x16 + off + bj * HALF); x0 = (f32x4){bf_lo(w.x), bf_hi(w.x), bf_lo(w.y), bf_hi(w.y)}; x1 = (f32x4){bf_lo(w.z), bf_hi(w.z), bf_lo(w.w), bf_hi(w.w)}; }
                    *(u32x4*)(Y + off + bj * HALF) = pack8(x0 * alpha + gv[bj][0] * acc[ai][bj][m][0], x1 * alpha + gv[bj][1] * acc[ai][bj][m][1]); }
                if (m & 1) asm volatile("" ::: "memory"); }
    }
};
struct EpiF32 {
    static constexpr bool PERM = false, AFTER_DRAIN = false;
    float* O; int ldc;
    __device__ __forceinline__ void operator()(const f32x4 (&acc)[2][2][4][2], const Unit& u, int wr, int wc, int fr, int fq) const {
        const int col0 = u.pn * BM + wc * 32 + 4 * fq;
#pragma unroll
        for (int ai = 0; ai < 2; ++ai)
#pragma unroll
            for (int m = 0; m < 4; ++m) { const size_t off = (size_t)(u.pm * BM + ai * HALF + wr * 64 + m * 16 + fr) * ldc + col0;
#pragma unroll
                for (int bj = 0; bj < 2; ++bj)
#pragma unroll
                    for (int n = 0; n < 2; ++n) *(f32x4*)(O + off + bj * HALF + n * 16) = acc[ai][bj][m][n]; }
    }
};
struct EpiUp {
    static constexpr bool PERM = true, AFTER_DRAIN = false;
    bf16_t* HE;
    __device__ __forceinline__ void operator()(const f32x4 (&acc)[2][2][4][2], const Unit& u, int wr, int wc, int fr, int fq) const {
#pragma unroll
        for (int ai = 0; ai < 2; ++ai)
#pragma unroll
            for (int m = 0; m < 4; ++m) { const int row = u.pm * BM + ai * HALF + wr * 64 + m * 16 + fr; f32x4 h[2];
#pragma unroll
                for (int n = 0; n < 2; ++n)
#pragma unroll
                    for (int i = 0; i < 4; ++i) h[n][i] = silu_f(acc[ai][0][m][n][i]) * acc[ai][1][m][n][i];
                *(u32x4*)(HE + (size_t)row * 512 + u.pnl * HALF + wc * 32 + 8 * fq) = pack8(h[0], h[1]); }
    }
};
struct EpiDown {
    static constexpr bool PERM = true, AFTER_DRAIN = false;
    bf16_t* YS; const int* rowtok; const float* roww;
    __device__ __forceinline__ void operator()(const f32x4 (&acc)[2][2][4][2], const Unit& u, int wr, int wc, int fr, int fq) const {
#pragma unroll
        for (int ai = 0; ai < 2; ++ai)
#pragma unroll
            for (int m = 0; m < 4; ++m) { const int lrow = ai * HALF + wr * 64 + m * 16 + fr;
                if (lrow < u.nvalid) { const int grow = u.pm * BM + lrow; const int tk = rowtok[grow]; const float w = roww[grow];
#pragma unroll
                    for (int bj = 0; bj < 2; ++bj)
                        *(u32x4*)(YS + (size_t)tk * 2048 + u.pnl * BM + bj * HALF + wc * 32 + 8 * fq) = pack8(acc[ai][bj][m][0] * w, acc[ai][bj][m][1] * w); } }
    }
};
constexpr int SEG_TILES = 32;
struct GroupOrder {
    unsigned cnt[16]; int nT, nN, G, c;
    __device__ __forceinline__ bool next(int i, Unit& u) const {
        const int nwg = nT * nN, L = i * G + c; if (L >= nwg) return false;
        const int q = nwg / 8, r = nwg % 8, xcd = L % 8, off = L / 8; const int wgid = (xcd < r ? xcd * (q + 1) : r * (q + 1) + (xcd - r) * q) + off;
        const int pm = wgid / nN, pnl = wgid % nN; int run = 0, ee = 0, nv = 0;
        int loc = 0;
#pragma unroll
        for (int e = 0; e < 16; ++e) { const int te = (int)((cnt[e] + 255u) >> 8); if (pm >= run && pm < run + te) { ee = e; loc = pm - run; const int left = (int)cnt[e] - (pm - run) * 256; nv = left < 256 ? left : 256; } run += te; }
        u.pm = ee * SEG_TILES + loc; u.pn = ee * nN + pnl; u.pnl = pnl; u.nvalid = nv; return true;
    }
    __device__ __forceinline__ void a_ready(const Unit&) const {}
    __device__ __forceinline__ void done(const Unit&) const {}
};
template <class Epi, class Sched, bool ALIGN_EPI = false, bool SP2 = false, bool GATHER = false>
__device__ __forceinline__ void gemm_phase(PG8_LAS unsigned char* lds, const Gemm g, const Sched& S, const Epi& E, int tid_in) {
    int tid_ = tid_in; asm volatile("" : "+v"(tid_)); const int tid = tid_, wid = __builtin_amdgcn_readfirstlane(tid >> 6), lane = tid & 63, wr = wid >> 2, wc = wid & 3, fr = lane & 15, fq = lane >> 4;
    const int K = g.K, nt = K / BK;
    unsigned voffA[2], voffB[2];
#pragma unroll
    for (int i = 0; i < 2; ++i) { int R, C; stage_rc(tid * 16 + i * 8192, R, C); const int Rb = Epi::PERM ? ((R & ~31) + perm32(R & 31)) : R;
        voffA[i] = (unsigned)(R * K + C) * 2u; voffB[i] = (unsigned)(Rb * K + C) * 2u; }
    static_assert(!GATHER || SP2, "GATHER is wired into the SP2 loop only");
    unsigned gc0[2] = {0u, 0u}, gc1[2] = {0u, 0u}, gn0[2] = {0u, 0u}, gn1[2] = {0u, 0u};
#define PG8_GOFF(pm_, o0, o1) do { _Pragma("unroll") for (int _i = 0; _i < 2; ++_i) { int R_, C_; stage_rc(tid * 16 + _i * 8192, R_, C_); \
        int r0_ = g.rowmap[(pm_) * BM + R_], r1_ = g.rowmap[(pm_) * BM + HALF + R_]; r0_ = (unsigned)r0_ < (unsigned)g.M ? r0_ : 0; r1_ = (unsigned)r1_ < (unsigned)g.M ? r1_ : 0;     \
        o0[_i] = (unsigned)(r0_ * K + C_) * 2u; o1[_i] = (unsigned)(r1_ * K + C_) * 2u; } } while (0)
#define PG8_STAGE_A(bufoff, base, half, nx) do { if constexpr (GATHER) { unsigned vo_[2]; \
        vo_[0] = (nx) ? ((half) ? gn1[0] : gn0[0]) : ((half) ? gc1[0] : gc0[0]); vo_[1] = (nx) ? ((half) ? gn1[1] : gn0[1]) : ((half) ? gc1[1] : gc0[1]); PG8_STAGE(bufoff, base, vo_); } \
        else { PG8_STAGE(bufoff, (base) + ((half) ? hstep : (size_t)0), voffA); } } while (0)
    const size_t kstep = (size_t)(BK * 2);
    const size_t hstep = (size_t)HALF * K * 2;
    const size_t tstep = 2 * hstep;
    const unsigned ldsw = (unsigned)wid * 1024u;
    const int aoff = lds_byte(wr * 64 + fr, fq * 8), boff = lds_byte(wc * 32 + fr, fq * 8);
#define PG8_SA(b, h) (((b) * 2 + (h)) * HTB)
#define PG8_SB(b, h) ((4 + (b) * 2 + (h)) * HTB)
#define PG8_STAGE(bufoff, gbase, voff) do { _Pragma("unroll") for (int _i = 0; _i < 2; ++_i) \
        __builtin_amdgcn_global_load_lds((const unsigned*)((const char*)(gbase) + (voff)[_i]), (PG8_LAS unsigned*)(lds + (bufoff) + ldsw + _i * 8192), 16, 0, 0); } while (0)
#define PG8_LDA(dst, b, h) do { _Pragma("unroll") for (int m = 0; m < 4; ++m) _Pragma("unroll") for (int k = 0; k < 2; ++k) dst[m][k] = *(const PG8_LAS bf16x8*)(lds + PG8_SA(b, h) + aoff + m * 2048 + k * 1024); } while (0)
#define PG8_LDB(dst, b, h) do { _Pragma("unroll") for (int n = 0; n < 2; ++n) _Pragma("unroll") for (int k = 0; k < 2; ++k) dst[n][k] = *(const PG8_LAS bf16x8*)(lds + PG8_SB(b, h) + boff + n * 2048 + k * 1024); } while (0)
#define PG8_MMA(ai, bj, At, Bt) do { __builtin_amdgcn_s_setprio(1); _Pragma("unroll") for (int m = 0; m < 4; ++m) _Pragma("unroll") for (int n = 0; n < 2; ++n) _Pragma("unroll") for (int k = 0; k < 2; ++k) \
        acc[ai][bj][m][n] = __builtin_amdgcn_mfma_f32_16x16x32_bf16(Bt[n][k], At[m][k], acc[ai][bj][m][n], 0, 0, 0); __builtin_amdgcn_s_setprio(0); } while (0)
#define PG8_WAIT_V(n) asm volatile("s_waitcnt vmcnt(" #n ")" ::: "memory")
#define PG8_WAIT_L(n) asm volatile("s_waitcnt lgkmcnt(" #n ")" ::: "memory")
#define PG8_BAR __builtin_amdgcn_s_barrier()
#define PG8_SCHED __builtin_amdgcn_sched_barrier(0)
    Unit cur, nxt; int ui = 0;
    if (!S.next(0, cur)) return;
    f32x4 acc[2][2][4][2];
#pragma unroll
    for (int a = 0; a < 2; ++a)
#pragma unroll
        for (int b = 0; b < 2; ++b)
#pragma unroll
            for (int m = 0; m < 4; ++m)
#pragma unroll
                for (int n = 0; n < 2; ++n) acc[a][b][m][n] = (f32x4){0.f, 0.f, 0.f, 0.f};
    bf16x8 At[4][2], B0[2][2], B1[2][2];
    const char* cA = (const char*)g.A + (GATHER ? (size_t)0 : (size_t)cur.pm * tstep); const char* cB = (const char*)g.Bt + (size_t)cur.pn * tstep;
    S.a_ready(cur);
    if constexpr (SP2) {
        if constexpr (GATHER) PG8_GOFF(cur.pm, gc0, gc1);
        PG8_STAGE(PG8_SB(0, 0), cB, voffB); PG8_STAGE(PG8_SB(0, 1), cB + hstep, voffB); PG8_STAGE_A(PG8_SA(0, 0), cA, 0, false); PG8_STAGE_A(PG8_SA(0, 1), cA, 1, false);
        if (wr == 1) PG8_BAR;
        PG8_WAIT_V(2); PG8_BAR;
        PG8_STAGE(PG8_SB(1, 0), cB + kstep, voffB); PG8_STAGE_A(PG8_SA(1, 0), cA + kstep, 0, false); PG8_STAGE(PG8_SB(1, 1), cB + hstep + kstep, voffB);
        PG8_WAIT_V(6); PG8_BAR;
    } else {
        PG8_STAGE(PG8_SB(0, 0), cB, voffB); PG8_STAGE(PG8_SA(0, 0), cA, voffA); PG8_STAGE(PG8_SB(0, 1), cB + hstep, voffB); PG8_STAGE(PG8_SA(0, 1), cA + hstep, voffA);
        if (wr == 1) PG8_BAR;
        PG8_WAIT_V(4); PG8_BAR;
        PG8_STAGE(PG8_SB(1, 0), cB + kstep, voffB); PG8_STAGE(PG8_SA(1, 0), cA + kstep, voffA); PG8_STAGE(PG8_SB(1, 1), cB + hstep + kstep, voffB);
        PG8_WAIT_V(6); PG8_BAR;
    }
    for (;;) {
        const bool has_next = S.next(ui + 1, nxt);
        if constexpr (GATHER) { if (has_next) PG8_GOFF(nxt.pm, gn0, gn1); else { gn0[0] = gc0[0]; gn0[1] = gc0[1]; gn1[0] = gc1[0]; gn1[1] = gc1[1]; } }
        const char* nA = GATHER ? (const char*)g.A : (has_next ? (const char*)g.A + (size_t)nxt.pm * tstep : cA); const char* nB = has_next ? (const char*)g.Bt + (size_t)nxt.pn * tstep : cB;
        for (int t = 0; t < nt; t += 2) {
            const bool last = (t == nt - 2);
            const char* a1 = cA + (size_t)(t + 1) * kstep;
            const char* a2 = last ? nA : cA + (size_t)(t + 2) * kstep; const char* b2 = last ? nB : cB + (size_t)(t + 2) * kstep;
            const char* a3 = a2 + kstep; const char* b3 = b2 + kstep;
            if (last && has_next) S.a_ready(nxt);
            if constexpr (SP2) {
            PG8_LDB(B0, 0, 0); PG8_LDB(B1, 0, 1); PG8_SCHED; PG8_LDA(At, 0, 0); PG8_STAGE_A(PG8_SA(1, 1), a1, 1, false);
            PG8_WAIT_V(8); PG8_WAIT_L(0); PG8_BAR; PG8_MMA(0, 0, At, B0); PG8_MMA(0, 1, At, B1); PG8_BAR; PG8_SCHED;
            PG8_LDA(At, 0, 1); PG8_STAGE(PG8_SB(0, 0), b2, voffB); PG8_STAGE(PG8_SB(0, 1), b2 + hstep, voffB); PG8_STAGE_A(PG8_SA(0, 0), a2, 0, last);
            PG8_WAIT_V(8); PG8_WAIT_L(0); PG8_BAR; PG8_MMA(1, 0, At, B0); PG8_MMA(1, 1, At, B1); PG8_BAR; PG8_SCHED;
            PG8_LDB(B0, 1, 0); PG8_LDB(B1, 1, 1); PG8_SCHED; PG8_LDA(At, 1, 0); PG8_STAGE_A(PG8_SA(0, 1), a2, 1, last);
            PG8_WAIT_V(8); PG8_WAIT_L(0); PG8_BAR; PG8_MMA(0, 0, At, B0); PG8_MMA(0, 1, At, B1); PG8_BAR; PG8_SCHED;
            PG8_LDA(At, 1, 1); PG8_STAGE(PG8_SB(1, 0), b3, voffB); PG8_STAGE(PG8_SB(1, 1), b3 + hstep, voffB); PG8_STAGE_A(PG8_SA(1, 0), a3, 0, last);
            PG8_WAIT_V(8); PG8_WAIT_L(0); PG8_BAR; PG8_MMA(1, 0, At, B0); PG8_MMA(1, 1, At, B1); PG8_BAR; PG8_SCHED;
            } else {
            PG8_LDB(B0, 0, 0); PG8_SCHED; PG8_LDA(At, 0, 0); PG8_STAGE(PG8_SA(1, 1), a1 + hstep, voffA);
            PG8_WAIT_L(8); PG8_BAR; PG8_WAIT_L(0); PG8_MMA(0, 0, At, B0); PG8_BAR; PG8_SCHED;
            PG8_LDB(B1, 0, 1); PG8_STAGE(PG8_SB(0, 0), b2, voffB);
            PG8_BAR; PG8_WAIT_L(0); PG8_MMA(0, 1, At, B1); PG8_BAR;
            PG8_LDA(At, 0, 1); PG8_STAGE(PG8_SA(0, 0), a2, voffA);
            PG8_BAR; PG8_WAIT_L(0); PG8_MMA(1, 0, At, B0); PG8_BAR; PG8_SCHED;
            PG8_STAGE(PG8_SB(0, 1), b2 + hstep, voffB);
            PG8_WAIT_V(6); PG8_BAR; PG8_MMA(1, 1, At, B1); PG8_BAR;
            PG8_LDB(B0, 1, 0); PG8_SCHED; PG8_LDA(At, 1, 0); PG8_STAGE(PG8_SA(0, 1), a2 + hstep, voffA);
            PG8_WAIT_L(8); PG8_BAR; PG8_WAIT_L(0); PG8_MMA(0, 0, At, B0); PG8_BAR; PG8_SCHED;
            PG8_LDB(B1, 1, 1); PG8_STAGE(PG8_SB(1, 0), b3, voffB);
            PG8_BAR; PG8_WAIT_L(0); PG8_MMA(0, 1, At, B1); PG8_BAR;
            PG8_LDA(At, 1, 1); PG8_STAGE(PG8_SA(1, 0), a3, voffA);
            PG8_BAR; PG8_WAIT_L(0); PG8_MMA(1, 0, At, B0); PG8_BAR; PG8_SCHED;
            PG8_STAGE(PG8_SB(1, 1), b3 + hstep, voffB);
            PG8_WAIT_V(6); PG8_BAR; PG8_MMA(1, 1, At, B1); PG8_BAR;
            }
        }
        if constexpr (ALIGN_EPI) { if (wr == 0) PG8_BAR; }
        if constexpr (!Epi::AFTER_DRAIN) { E(acc, cur, wr, wc, fr, fq); S.done(cur); }
        if (!has_next) break;
#pragma unroll
        for (int a = 0; a < 2; ++a)
#pragma unroll
            for (int b = 0; b < 2; ++b)
#pragma unroll
                for (int m = 0; m < 4; ++m)
#pragma unroll
                    for (int n = 0; n < 2; ++n) acc[a][b][m][n] = (f32x4){0.f, 0.f, 0.f, 0.f};
        cur = nxt; cA = nA; cB = nB; ++ui;
        if constexpr (GATHER) { gc0[0] = gn0[0]; gc0[1] = gn0[1]; gc1[0] = gn1[0]; gc1[1] = gn1[1]; }
        if constexpr (ALIGN_EPI) { if (wr == 1) PG8_BAR; }
    }
    PG8_WAIT_V(0);
    if constexpr (!ALIGN_EPI) { if (wr == 0) PG8_BAR; }
    PG8_BAR;
    if constexpr (Epi::AFTER_DRAIN) { E.fused(acc, cur, wr, wc, fr, fq, lds, wid, lane); S.done(cur); }
#undef PG8_SA
#undef PG8_SB
#undef PG8_STAGE
#undef PG8_STAGE_A
#undef PG8_GOFF
#undef PG8_LDA
#undef PG8_LDB
#undef PG8_MMA
#undef PG8_WAIT_V
#undef PG8_WAIT_L
#undef PG8_BAR
#undef PG8_SCHED
}
}
#define GAS __attribute__((address_space(1)))
#define LAS __attribute__((address_space(3)))
typedef unsigned short bf16;
typedef unsigned v4u __attribute__((ext_vector_type(4)));
typedef float f32x4 __attribute__((ext_vector_type(4)));
typedef short bf16x8 __attribute__((ext_vector_type(8)));
typedef GAS unsigned gu32;
typedef GAS unsigned long long gu64;
#define RLX_AGENT __ATOMIC_RELAXED, __HIP_MEMORY_SCOPE_AGENT
#define LDS_WAIT() asm volatile("s_waitcnt lgkmcnt(0)" ::: "memory")
#define VM_WAIT() asm volatile("s_waitcnt vmcnt(0)" ::: "memory")
__device__ __forceinline__ unsigned long long rt() { return __builtin_amdgcn_s_memrealtime(); }
__device__ __forceinline__ unsigned f2bf(float f) { unsigned u = __builtin_bit_cast(unsigned, f); return (u + 0x7fffu + ((u >> 16) & 1u)) >> 16; }
__device__ __forceinline__ unsigned pk2(float lo, float hi) { return f2bf(lo) | (f2bf(hi) << 16); }
#define XB_TMO      128
#define XB_XCNT(j)  (256  + 64 * (j))
#define XB_XSUB(j)  (1280 + 64 * (j))
#define XB_XGEN(j)  (2304 + 64 * (j))
#define XB_TOP      3328
#define XB_TOPGEN   3392
#define XCD_BAR_WORDS 3456
#define XB_SPIN_CAP (1u << 18)

__device__ __forceinline__ unsigned xb_ld(unsigned* p)              { return __hip_atomic_load(p, __ATOMIC_RELAXED, __HIP_MEMORY_SCOPE_AGENT); }
__device__ __forceinline__ unsigned xb_add(unsigned* p, unsigned v) { return __hip_atomic_fetch_add(p, v, __ATOMIC_RELAXED, __HIP_MEMORY_SCOPE_AGENT); }
__device__ __forceinline__ unsigned xb_xcc_id() { return (unsigned)__builtin_amdgcn_s_getreg((3 << 11) | 20) & 0xFu; }
#define XB_SPIN(cond, bar) do { unsigned _sp = 0; while (cond) { __builtin_amdgcn_s_sleep(1); \
    if ((++_sp & 255u) == 0u) { if (xb_ld(&(bar)[XB_TMO])) break; if (_sp > XB_SPIN_CAP) { atomicAdd(&(bar)[XB_TMO], 1u); break; } } } } while (0)

struct XcdBarrier {
    unsigned* bar; unsigned x;
    volatile LAS unsigned* st;
};

__device__ __forceinline__ XcdBarrier xcd_barrier_post(unsigned* bar, volatile LAS unsigned* st, int tid) {
    XcdBarrier b; b.bar = bar; b.x = xb_xcc_id(); b.st = st;
    if (tid == 0) (void)xb_add(&bar[XB_XCNT(b.x)], 1u);
    return b;
}
__device__ __forceinline__ void xcd_barrier_complete(unsigned* bar, unsigned x, unsigned& nloc, unsigned& nx) {
    const unsigned G = gridDim.x * gridDim.y * gridDim.z;
    unsigned sum, cnt, mine, sp = 0u;
    for (;;) {
        sum = 0u; cnt = 0u; mine = 0u;
#pragma unroll
        for (unsigned j = 0; j < 16; ++j) { const unsigned c = xb_ld(&bar[XB_XCNT(j)]); sum += c; cnt += (c > 0u) ? 1u : 0u; mine = (j == x) ? c : mine; }
        if (sum == G) break;
        __builtin_amdgcn_s_sleep(1);
        if ((++sp & 255u) == 0u) { if (xb_ld(&bar[XB_TMO])) break; if (sp > XB_SPIN_CAP) { atomicAdd(&bar[XB_TMO], 1u); break; } }
    }
    nloc = mine > 0u ? mine : 1u; nx = cnt > 0u ? cnt : 1u;
}

__device__ __forceinline__ void xcd_barrier(const XcdBarrier& b, int tid) {
    asm volatile("s_waitcnt vmcnt(0)" ::: "memory");
    __syncthreads();
    if (tid == 0) {
        unsigned* bar = b.bar;
        __builtin_amdgcn_s_waitcnt(0);
        unsigned nloc = b.st[0], nx = b.st[1];
        if (nloc == 0u) { xcd_barrier_complete(bar, b.x, nloc, nx); b.st[0] = nloc; b.st[1] = nx; }
        const unsigned old = xb_add(&bar[XB_XSUB(b.x)], 1u);
        const unsigned gen = old / nloc;
        if (old + 1u == (gen + 1u) * nloc) {
            __builtin_amdgcn_fence(__ATOMIC_RELEASE, "agent");
            asm volatile("s_waitcnt vmcnt(0)" ::: "memory");
            const unsigned og = xb_add(&bar[XB_TOP], 1u);
            const unsigned tg = og / nx;
            if (og + 1u == (tg + 1u) * nx) xb_add(&bar[XB_TOPGEN], 1u);
            else XB_SPIN(xb_ld(&bar[XB_TOPGEN]) == tg, bar);
            __builtin_amdgcn_fence(__ATOMIC_ACQUIRE, "agent");
            xb_add(&bar[XB_XGEN(b.x)], 1u);
            asm volatile("s_waitcnt vmcnt(0)" ::: "memory");
        } else {
            XB_SPIN(xb_ld(&bar[XB_XGEN(b.x)]) == gen, bar);
            __builtin_amdgcn_fence(__ATOMIC_ACQUIRE, "agent");
            asm volatile("s_waitcnt vmcnt(0)" ::: "memory");
        }
    }
    __syncthreads();
}
namespace fa {
typedef short bf16x8 __attribute__((ext_vector_type(8)));
typedef float f32x16 __attribute__((ext_vector_type(16)));
typedef float f32x2_t __attribute__((ext_vector_type(2))); typedef __bf16 bf16x2_t __attribute__((ext_vector_type(2)));
typedef unsigned u32x4 __attribute__((ext_vector_type(4)));
typedef unsigned u32x2 __attribute__((ext_vector_type(2)));
__device__ __forceinline__ unsigned cvtpk(float lo, float hi) { f32x2_t v = {lo, hi}; bf16x2_t b = __builtin_convertvector(v, bf16x2_t); return __builtin_bit_cast(unsigned, b); }
__device__ __forceinline__ int kap(int r32) { return (r32 & ~12) | ((r32 & 4) << 1) | ((r32 & 8) >> 1); }
__device__ __forceinline__ float xmax(float v) { auto rr = __builtin_amdgcn_permlane32_swap(__float_as_uint(v), __float_as_uint(v), false, false); return fmaxf(__uint_as_float(rr[0]), __uint_as_float(rr[1])); }
__device__ __forceinline__ float xsum(float v) { auto rr = __builtin_amdgcn_permlane32_swap(__float_as_uint(v), __float_as_uint(v), false, false); return __uint_as_float(rr[0]) + __uint_as_float(rr[1]); }
constexpr float NEGBIG = -1e30f;

struct Frag { bf16x8 k[4]; bf16x8 v[4]; };
struct State { f32x16 o0, o1; float m, l; };

__device__ __forceinline__ void load_tile(Frag& f, const bf16* Kbh, const bf16* Vbh, int VP, int key0, int r32, int hi) {
    const bf16* kp = Kbh + (size_t)(key0 + kap(r32)) * 64 + hi * 8;
#pragma unroll
    for (int d0 = 0; d0 < 4; ++d0) f.k[d0] = *(const bf16x8*)(kp + d0 * 16);
    const bf16* vp = Vbh + (size_t)r32 * VP + key0 + hi * 8;
#pragma unroll
    for (int db = 0; db < 2; ++db)
#pragma unroll
        for (int s = 0; s < 2; ++s) f.v[db * 2 + s] = *(const bf16x8*)(vp + (size_t)db * 32 * VP + s * 16);
}
__device__ __forceinline__ void load_v(Frag& f, const bf16* Vbh, int VP, int key0, int r32, int hi) {
    const bf16* vp = Vbh + (size_t)r32 * VP + key0 + hi * 8;
#pragma unroll
    for (int db = 0; db < 2; ++db)
#pragma unroll
        for (int s = 0; s < 2; ++s) f.v[db * 2 + s] = *(const bf16x8*)(vp + (size_t)db * 32 * VP + s * 16);
}
__device__ __forceinline__ void load_k(Frag& f, const bf16* Kbh, int key0, int r32, int hi) {
    const bf16* kp = Kbh + (size_t)(key0 + kap(r32)) * 64 + hi * 8;
#pragma unroll
    for (int d0 = 0; d0 < 4; ++d0) f.k[d0] = *(const bf16x8*)(kp + d0 * 16);
}
__device__ __forceinline__ void scores(f32x16& p, const Frag& f, const bf16x8 (&qr)[4]) {
    p = f32x16{};
#pragma unroll
    for (int d0 = 0; d0 < 4; ++d0) p = __builtin_amdgcn_mfma_f32_32x32x16_bf16(f.k[d0], qr[d0], p, 0, 0, 0);
}
__device__ __forceinline__ void mask_range(f32x16& p, int key0, int hi, int lo, int hi_) {
#pragma unroll
    for (int r = 0; r < 16; ++r) { const int kpos = key0 + 16 * (r >> 3) + 8 * hi + (r & 7); p[r] = (kpos >= lo && kpos <= hi_) ? p[r] : -INFINITY; }
}
__device__ __forceinline__ void step(State& st, const Frag& f, const bf16x8 (&qr)[4], int key0, int hi, bool need_mask, int lo, int hi_) {
    f32x16 p; scores(p, f, qr);
    if (need_mask) mask_range(p, key0, hi, lo, hi_);
    float tm = fmaxf(p[0], p[1]);
#pragma unroll
    for (int r = 2; r < 16; ++r) tm = fmaxf(tm, p[r]);
    tm = xmax(tm);
    const float mn = fmaxf(st.m, tm); const float alpha = __builtin_amdgcn_exp2f(st.m - mn); st.m = mn;
    float rs = 0.f;
#pragma unroll
    for (int r = 0; r < 16; ++r) { p[r] = __builtin_amdgcn_exp2f(p[r] - mn); rs += p[r]; }
    st.l = st.l * alpha + rs;
    if (!__all(alpha == 1.0f)) { st.o0 = st.o0 * alpha; st.o1 = st.o1 * alpha; }
    u32x4 w0, w1;
    w0.x = cvtpk(p[0], p[1]); w0.y = cvtpk(p[2], p[3]); w0.z = cvtpk(p[4], p[5]); w0.w = cvtpk(p[6], p[7]);
    w1.x = cvtpk(p[8], p[9]); w1.y = cvtpk(p[10], p[11]); w1.z = cvtpk(p[12], p[13]); w1.w = cvtpk(p[14], p[15]);
    const bf16x8 pb0 = __builtin_bit_cast(bf16x8, w0), pb1 = __builtin_bit_cast(bf16x8, w1);
    st.o0 = __builtin_amdgcn_mfma_f32_32x32x16_bf16(f.v[0], pb0, st.o0, 0, 0, 0);
    st.o0 = __builtin_amdgcn_mfma_f32_32x32x16_bf16(f.v[1], pb1, st.o0, 0, 0, 0);
    st.o1 = __builtin_amdgcn_mfma_f32_32x32x16_bf16(f.v[2], pb0, st.o1, 0, 0, 0);
    st.o1 = __builtin_amdgcn_mfma_f32_32x32x16_bf16(f.v[3], pb1, st.o1, 0, 0, 0);
}
__device__ __forceinline__ void load_q(bf16x8 (&qr)[4], const bf16* Qrow  , int hi) {
#pragma unroll
    for (int d0 = 0; d0 < 4; ++d0) qr[d0] = *(const bf16x8*)(Qrow + d0 * 16 + hi * 8);
}
__device__ __forceinline__ float finish(State& st) { const float lt = xsum(st.l); return lt > 0.f ? 1.0f / lt : 0.f; }
__device__ __forceinline__ void store_o(const State& st, float inv, bf16* Orow  , int hi) {
#pragma unroll
    for (int g = 0; g < 4; ++g) {
        u32x2 a, b; a.x = cvtpk(st.o0[4 * g] * inv, st.o0[4 * g + 1] * inv); a.y = cvtpk(st.o0[4 * g + 2] * inv, st.o0[4 * g + 3] * inv);
        b.x = cvtpk(st.o1[4 * g] * inv, st.o1[4 * g + 1] * inv); b.y = cvtpk(st.o1[4 * g + 2] * inv, st.o1[4 * g + 3] * inv);
        *(u32x2*)(Orow + 8 * g + 4 * hi) = a; *(u32x2*)(Orow + 32 + 8 * g + 4 * hi) = b; }
}
__device__ __forceinline__ float bflo(unsigned w) { return __uint_as_float(w << 16); }
__device__ __forceinline__ float bfhi(unsigned w) { return __uint_as_float(w & 0xffff0000u); }
}
constexpr int NWAVES = 8;
constexpr int NB = 2, SEQ = 4096, DM = 2048, NTOK = NB * SEQ, NEXP = 16, DEXP = 512;
constexpr float ALPHA_RES = 1.4142135623730951f;
constexpr float LN_EPS = 1e-5f;
constexpr float QSCALE = 0.125f * 1.4426950408889634f;
constexpr float LOG2E = 1.4426950408889634f;
constexpr int NPHASE = 21;
#ifndef MK_N_LAUNCHES
#define MK_N_LAUNCHES 1
#endif
constexpr int N_LAUNCHES = MK_N_LAUNCHES;

constexpr size_t MiB = 1u << 20, KiB = 1u << 10;
constexpr size_t WS_CTL = 0, CTL_ZERO_BYTES = 32 * KiB;
constexpr size_t WS_MODP = 1 * MiB;
constexpr size_t WS_MOD = 4 * MiB;
constexpr size_t WS_ROPE = 4 * MiB + 512 * KiB;
constexpr size_t WS_CMPB = 5 * MiB;
constexpr size_t WS_TOKE = 5 * MiB + 256 * KiB;
constexpr size_t WS_TOKW = WS_TOKE + 64 * KiB;
constexpr size_t WS_TOKS = WS_TOKW + 64 * KiB;
constexpr int SEG_CAP = 8192;
constexpr size_t WS_ROWTOK = 10 * MiB;
constexpr size_t WS_ROWW = WS_ROWTOK + 512 * KiB;
constexpr size_t WS_BCNT = 5 * MiB + 768 * KiB;
constexpr size_t WS_ROWSRC = WS_ROWW + 512 * KiB;
constexpr size_t WS_SELM = 6 * MiB;
constexpr size_t WS_KCMP = 6 * MiB + 256 * KiB;
constexpr size_t WS_VCMPT = 6 * MiB + 512 * KiB;
constexpr size_t WS_GATES = 7 * MiB;
constexpr size_t WS_ULK = 10 * MiB, WS_ULV = 14 * MiB;
constexpr size_t WS_WQKV = 18 * MiB, WS_WO0 = 28 * MiB, WS_WIN = 36 * MiB, WS_WO1 = 51 * MiB, WS_PHIK = 59 * MiB, WS_PHIV = 60 * MiB;
constexpr size_t WS_W13 = 64 * MiB;
constexpr size_t WS_W2 = 192 * MiB;
constexpr size_t WS_H = 256 * MiB;
constexpr size_t WS_XA = 288 * MiB, WS_Y = 320 * MiB, WS_XB = 352 * MiB;
constexpr size_t WS_Q = 416 * MiB, WS_QRAW = 448 * MiB, WS_ATT = 480 * MiB;
constexpr size_t WS_HPERM = 416 * MiB;
constexpr size_t WS_OCMP = 512 * MiB, WS_OWIN = 544 * MiB;
constexpr size_t WS_K0 = 576 * MiB, WS_VT0 = 580 * MiB, WS_KC = 584 * MiB, WS_VC = 588 * MiB, WS_KS = 592 * MiB, WS_VST = 596 * MiB, WS_KW = 600 * MiB, WS_VWT = 604 * MiB;
constexpr size_t WS_HE = 416 * MiB;
constexpr size_t WS_YS = 628 * MiB;
constexpr size_t WS_END = 692 * MiB;
constexpr int CW_TMO = 0, CW_CODE = 1;
constexpr int CW_DONE = 512;
constexpr int CW_FQ = 128;
constexpr int CW_CNT = 1024, CW_CNT_STRIDE = 64;
constexpr int CW_BAR = 4096;

constexpr int RING_OFF = 0, RING_BYTES = 131072;
constexpr int LDSCTL_OFF = RING_BYTES, MISC_OFF = LDSCTL_OFF + 320;
constexpr int LDS_BYTES = 147456;
typedef float f32x16g __attribute__((ext_vector_type(16)));
typedef unsigned u32x2g __attribute__((ext_vector_type(2)));
__device__ __forceinline__ float wave_sum(float v) {
#pragma unroll
    for (int o = 1; o < 64; o <<= 1) v += __shfl_xor(v, o);
    return v;
}
__device__ __forceinline__ unsigned ld_u32_agent(const unsigned* p) { return __hip_atomic_load(p, __ATOMIC_RELAXED, __HIP_MEMORY_SCOPE_AGENT); }

__device__ __forceinline__ void transpose_item(const float* W, int ldw, bf16* WT, int ldt, int k0, int n0, int drow0, LAS float* scr, int lane) {
    float t[32]; const float* wp = W + (size_t)(k0 + (lane >> 5)) * ldw + n0 + (lane & 31);
#pragma unroll
    for (int i = 0; i < 32; ++i) t[i] = __builtin_nontemporal_load(wp + (size_t)(2 * i) * ldw);
#pragma unroll
    for (int i = 0; i < 32; ++i) scr[(2 * i + (lane >> 5)) * 33 + (lane & 31)] = t[i];
    LDS_WAIT(); asm volatile("" ::: "memory");
    const int c = lane & 7;
#pragma unroll
    for (int j = 0; j < 4; ++j) { const int n = (lane >> 3) + 8 * j; const LAS float* s = scr + (8 * c) * 33 + n;
        v4u o; o.x = pk2(s[0 * 33], s[1 * 33]); o.y = pk2(s[2 * 33], s[3 * 33]); o.z = pk2(s[4 * 33], s[5 * 33]); o.w = pk2(s[6 * 33], s[7 * 33]);
        *(GAS v4u*)(WT + (size_t)(drow0 + n) * ldt + k0 + 8 * c) = o; }
    LDS_WAIT(); asm volatile("" ::: "memory");
}

__device__ __forceinline__ void phase_mod_partial(const float* c, const float* w_ada, float* modp, LAS float* scr, int gw, int NGW, int lane) {
    for (int task = gw; task < 1536; task += NGW) {
        const int ks = task & 15, chunk = (task >> 4) % 48, layer = task / 768, k0 = ks * 128;
        for (int i = lane; i < 256; i += 64) { const float v = c[(i >> 7) * DM + k0 + (i & 127)]; scr[i] = v / (1.0f + __expf(-v)); }
        LDS_WAIT(); asm volatile("" ::: "memory");
        const float* wp = w_ada + ((size_t)layer * DM + k0) * 12288 + chunk * 256 + lane * 4;
        f32x4 a0 = {0.f, 0.f, 0.f, 0.f}, a1 = {0.f, 0.f, 0.f, 0.f};
#pragma unroll 8
        for (int k = 0; k < 128; ++k) { const f32x4 w = __builtin_nontemporal_load((const f32x4*)(wp + (size_t)k * 12288)); const float s0 = scr[k], s1 = scr[128 + k]; a0 += w * s0; a1 += w * s1; }
        float* o = modp + ((size_t)((ks * 2 + layer) * 2) * 12288) + chunk * 256 + lane * 4;
        *(f32x4*)o = a0; *(f32x4*)(o + 12288) = a1;
        LDS_WAIT(); asm volatile("" ::: "memory");
    }
}
__device__ __forceinline__ void rope_table(const int* positions, float* rope, int gtid, int nthr) {
    for (int idx = gtid; idx < NTOK * 8; idx += nthr) {
        const int tok = idx >> 3, i = idx & 7;
        const double invf = i == 0 ? 1.0 : i == 1 ? 0.19392274474868576 : i == 2 ? 0.03760603093086393 : i == 3 ? 0.007292664737217109 : i == 4 ? 0.001414213562373095 : i == 5 ? 0.0002742481756762073 : i == 6 ? 5.318295896944988e-05 : 1.031338537721246e-05;
        const double a = (double)positions[tok] * invf;
        const double kq = __builtin_rint(a * 0.6366197723675814);
        double r = __builtin_fma(-kq, 1.5707963267948966, a); r = __builtin_fma(-kq, 6.123233995736766e-17, r);
        const double r2 = r * r;
        double sn = 1.0 / 6227020800.0; sn = sn * r2 - 1.0 / 39916800.0; sn = sn * r2 + 1.0 / 362880.0; sn = sn * r2 - 1.0 / 5040.0; sn = sn * r2 + 1.0 / 120.0; sn = sn * r2 - 1.0 / 6.0; sn = sn * r2 + 1.0; sn *= r;
        double cs = -1.0 / 87178291200.0; cs = cs * r2 + 1.0 / 479001600.0; cs = cs * r2 - 1.0 / 3628800.0; cs = cs * r2 + 1.0 / 40320.0; cs = cs * r2 - 1.0 / 720.0; cs = cs * r2 + 1.0 / 24.0; cs = cs * r2 - 0.5; cs = cs * r2 + 1.0;
        const int q = ((int)(long long)kq) & 3;
        const double co = q == 0 ? cs : q == 1 ? -sn : q == 2 ? -cs : sn, si = q == 0 ? sn : q == 1 ? cs : q == 2 ? -sn : -cs;
        rope[(size_t)tok * 16 + i] = (float)co; rope[(size_t)tok * 16 + 8 + i] = (float)si;
    }
}

__device__ __forceinline__ void modulate_row_lds(const float* xrow, const LAS float* sh, const LAS float* sc, bf16* orow, int lane) {
    const GAS f32x4* xr = (const GAS f32x4*)xrow + lane; GAS unsigned long long* o8 = (GAS unsigned long long*)orow + lane;
#pragma unroll
    for (int j = 0; j < 8; ++j) { const f32x4 v = xr[64 * j]; const f32x4 s = *(const LAS f32x4*)(sc + 256 * j + 4 * lane), h = *(const LAS f32x4*)(sh + 256 * j + 4 * lane);
        const f32x4 o = v * (s + 1.0f) + h; o8[64 * j] = (unsigned long long)pk2(o.x, o.y) | ((unsigned long long)pk2(o.z, o.w) << 32); }
}

struct In {
    const float *x, *c; const int* positions; const float *w_ada, *b_ada, *swa_w_qkv, *swa_b_qkv, *swa_sinks, *swa_w_o, *nsa_w_in, *nsa_pe_k, *nsa_pe_v, *nsa_phi_k1, *nsa_phi_k2, *nsa_phi_v1, *nsa_phi_v2, *nsa_w_o,
        *moe_w_group, *moe_b_group, *moe_w_router, *moe_b_router, *moe_w1, *moe_w3, *moe_w2, *ln_t_g, *ln_t_b, *ln_c_g, *ln_c_b;
};

constexpr int CV_QKV = 32 * 80, CV_WO = 32 * 64, CV_WIN = 32 * 115, CV_PHI = 16 * 8, CV_MOE = 16 * 3 * 512;
constexpr int CV_A = CV_QKV + CV_WO;
constexpr int CV_B = CV_A + CV_MOE;
constexpr int CV_C = CV_B + CV_WIN + CV_WO + 4 * CV_PHI;
constexpr int CV_D = CV_C + CV_MOE;
__device__ __forceinline__ void conv_moe_item(const In& I, unsigned char* ws, int layer, int r, LAS float* scr, int lane) {
    if (r < 16 * 2 * 512) { const int mat = r / 512, q = r % 512, le = layer * 16 + (mat >> 1), which = mat & 1;
        const int n0 = 32 * (q % 16);
        transpose_item((which ? I.moe_w3 : I.moe_w1) + (size_t)le * 2048 * 512, 512, (bf16*)(ws + WS_W13) + (size_t)le * 1024 * 2048, 2048, 64 * (q / 16), n0, (n0 >> 7) * 256 + which * 128 + (n0 & 127), scr, lane); return; }
    r -= 16 * 2 * 512;
    { const int le = layer * 16 + r / 512, q = r % 512;
      transpose_item(I.moe_w2 + (size_t)le * 512 * 2048, 2048, (bf16*)(ws + WS_W2) + (size_t)le * 2048 * 512, 512, 64 * (q / 64), 32 * (q % 64), 32 * (q % 64), scr, lane); }
}
__device__ __forceinline__ void conv_item(const In& I, unsigned char* ws, int it, LAS float* scr, int lane) {
    int r = it;
    if (r < CV_QKV) { transpose_item(I.swa_w_qkv, 2560, (bf16*)(ws + WS_WQKV), 2048, 64 * (r / 80), 32 * (r % 80), 32 * (r % 80), scr, lane); return; } r -= CV_QKV;
    if (r < CV_WO) { transpose_item(I.swa_w_o, 2048, (bf16*)(ws + WS_WO0), 2048, 64 * (r / 64), 32 * (r % 64), 32 * (r % 64), scr, lane); return; } r -= CV_WO;
    if (r < CV_MOE) { conv_moe_item(I, ws, 0, r, scr, lane); return; } r -= CV_MOE;
    if (r < CV_WIN) { transpose_item(I.nsa_w_in, 3680, (bf16*)(ws + WS_WIN), 2048, 64 * (r / 115), 32 * (r % 115), 32 * (r % 115), scr, lane); return; } r -= CV_WIN;
    if (r < CV_WO) { transpose_item(I.nsa_w_o, 2048, (bf16*)(ws + WS_WO1), 2048, 64 * (r / 64), 32 * (r % 64), 32 * (r % 64), scr, lane); return; } r -= CV_WO;
    if (r < 4 * CV_PHI) { const int j = r / CV_PHI, q = r % CV_PHI, which = j >> 1, half = j & 1;
        transpose_item((which ? I.nsa_phi_v1 : I.nsa_phi_k1) + (size_t)half * 1024 * 256, 256, (bf16*)(ws + (which ? WS_PHIV : WS_PHIK)), 1024, 64 * (q / 8), 32 * (q % 8), half * 256 + 32 * (q % 8), scr, lane); return; }
    r -= 4 * CV_PHI;
    if (r < CV_MOE) conv_moe_item(I, ws, 1, r, scr, lane);
}
__device__ __forceinline__ bool conv_batch(const In& I, unsigned char* ws, LAS unsigned char* lds, int limit, const unsigned* donew, unsigned done_target, int tid, int wave, int lane) {
    volatile LAS int* sb = (volatile LAS int*)(lds + 131072 + 2048);
    if (tid == 0) { const bool stop = donew && ld_u32_agent(donew) >= done_target;
        sb[0] = stop ? 0x7fffffff : (int)atomicAdd((unsigned*)(ws + WS_CTL) + CW_FQ, 8u); }
    LDS_WAIT(); __syncthreads();
    const int sv = sb[0];
    __syncthreads();
    if (sv == 0x7fffffff) return false;
    const int base = CV_A + sv, it = base + wave;
    if (it < CV_D) conv_item(I, ws, it, (LAS float*)(lds + wave * 16384), lane);
    return base < limit;
}
__device__ __forceinline__ void conv_fill(const In& I, unsigned char* ws, LAS unsigned char* lds, int slot, int G, int tid, int wave, int lane) {
    unsigned* donew = (unsigned*)(ws + WS_CTL) + CW_DONE + 64 * slot;
    if (tid == 0) atomicAdd(donew, 1u);
    for (int n = 0; n < 64; ++n) if (!conv_batch(I, ws, lds, CV_D, donew, (unsigned)G, tid, wave, lane)) break;
    __syncthreads();
}
__device__ __forceinline__ void conv_drain(const In& I, unsigned char* ws, LAS unsigned char* lds, int limit, int tid, int wave, int lane) {
    while (conv_batch(I, ws, lds, limit, nullptr, 0u, tid, wave, lane)) {}
    __syncthreads();
}

__device__ __forceinline__ void phase_prologue(const In& I, unsigned char* ws, LAS unsigned char* lds, int tid, int lane, int wave, int vcu, int G) {
    const float* modp = (const float*)(ws + WS_MODP); float* mod = (float*)(ws + WS_MOD);
    LAS float* msm = (LAS float*)(lds + 65536);
#pragma unroll 1
    for (int it = 0; it < 2; ++it) {
        f32x4 pv[2][16];
#pragma unroll
        for (int u = 0; u < 2; ++u) { const int i4 = tid + (NWAVES * 64) * (2 * it + u), b = i4 >> 10, col = (i4 & 1023) * 4;
#pragma unroll
            for (int ks = 0; ks < 16; ++ks) pv[u][ks] = *(const f32x4*)(modp + (size_t)((ks * 2 + 0) * 2 + b) * 12288 + col); }
#pragma unroll
        for (int u = 0; u < 2; ++u) { const int i4 = tid + (NWAVES * 64) * (2 * it + u), col = (i4 & 1023) * 4; f32x4 sacc = *(const f32x4*)(I.b_ada + col);
#pragma unroll
            for (int ks = 0; ks < 16; ++ks) sacc += pv[u][ks];
            *(LAS f32x4*)(msm + 4 * i4) = sacc; } }
    { const int gidx = vcu * 192 + tid;
      if (tid < 192 && gidx < 2 * 2 * 12288) { const int layer = gidx / 24576, rem = gidx % 24576, b = rem / 12288, col = rem % 12288; float s = I.b_ada[layer * 12288 + col];
#pragma unroll
          for (int ks = 0; ks < 16; ++ks) s += modp[(size_t)((ks * 2 + layer) * 2 + b) * 12288 + col];
          mod[gidx] = s; } }
    __syncthreads();
    const int gw = vcu * NWAVES + wave, NGW = G * NWAVES;
    bf16* H = (bf16*)(ws + WS_H);
    for (int m0 = gw; m0 < NTOK; m0 += 4 * NGW) {
        f32x4 xv[4][8];
#pragma unroll
        for (int r = 0; r < 4; ++r) { const int m = m0 + r * NGW; if (m < NTOK) { const GAS f32x4* xr = (const GAS f32x4*)(I.x + (size_t)m * DM) + lane;
#pragma unroll
            for (int j = 0; j < 8; ++j) xv[r][j] = __builtin_nontemporal_load(xr + 64 * j); } }
#pragma unroll
        for (int r = 0; r < 4; ++r) { const int m = m0 + r * NGW; if (m < NTOK) { const int b = m >> 12; const LAS float* sh = msm + b * 4096; const LAS float* sc = sh + 2048;
            GAS unsigned long long* o8 = (GAS unsigned long long*)(H + (size_t)m * DM) + lane;
#pragma unroll
            for (int j = 0; j < 8; ++j) { const f32x4 sv = *(const LAS f32x4*)(sc + 256 * j + 4 * lane), hv = *(const LAS f32x4*)(sh + 256 * j + 4 * lane);
                const f32x4 o = xv[r][j] * (sv + 1.0f) + hv; o8[64 * j] = (unsigned long long)pk2(o.x, o.y) | ((unsigned long long)pk2(o.z, o.w) << 32); } } }
    }
    if (gw < 512) { const int which = gw >> 8, cc = gw & 255; const float* pe = which ? I.nsa_pe_v : I.nsa_pe_k; const float* phi = which ? I.nsa_phi_v1 : I.nsa_phi_k1; float s = 0.f;
#pragma unroll 4
        for (int i = 0; i < 32; ++i) { const int k = lane + 64 * i; s += pe[k] * phi[(size_t)k * 256 + cc]; }
        s = wave_sum(s); if (lane == 0) ((float*)(ws + WS_CMPB))[which * 256 + cc] = s; }
    __syncthreads();
    LAS float* scr = (LAS float*)(lds + wave * 16384);
    for (int it = gw; it < CV_A; it += NGW) conv_item(I, ws, it, scr, lane);
}

template <int W, bool SINK>
__device__ __forceinline__ void banded_unit(int b, int hkv, int tb, int g, int lane, const bf16* Q, const bf16* K, const bf16* VT, bf16* OUT, const float* sinks) {
    const int r32 = lane & 31, hi = lane >> 5, head = hkv * 8 + g, q0 = tb * 32, t = q0 + r32;
    const size_t row = (size_t)b * SEQ + t;
    fa::bf16x8 qr[4]; fa::load_q(qr, Q + row * DM + head * 64, hi);
    const bf16* Kbh = K + (size_t)(b * 4 + hkv) * SEQ * 64; const bf16* Vbh = VT + (size_t)(b * 4 + hkv) * 64 * SEQ;
    fa::State st; st.o0 = fa::f32x16{}; st.o1 = fa::f32x16{};
    if (SINK) { st.m = sinks[head] * LOG2E; st.l = hi == 0 ? 1.0f : 0.0f; } else { st.m = fa::NEGBIG; st.l = 0.f; }
    const int ktA = tb - W / 32 > 0 ? tb - W / 32 : 0;
    fa::Frag fc, fn; fa::load_tile(fc, Kbh, Vbh, SEQ, ktA * 32, r32, hi);
    for (int kt = ktA; kt <= tb; ++kt) {
        if (kt < tb) fa::load_tile(fn, Kbh, Vbh, SEQ, (kt + 1) * 32, r32, hi);
        const bool nm = (kt == tb) || (kt == tb - W / 32);
        fa::step(st, fc, qr, kt * 32, hi, nm, t - W + 1, t);
        fc = fn;
    }
    const float inv = fa::finish(st);
    fa::store_o(st, inv, OUT + row * DM + head * 64, hi);
}
template <int W, bool SINK>
__device__ __forceinline__ void phase_banded(int vcu, int G, int wave, int lane, const bf16* Q, const bf16* K, const bf16* VT, bf16* OUT, const float* sinks) {
    for (int u = vcu; u < 1024; u += G) { const int bh = (u >> 5) & 7, tb = ((u >> 8) << 5) | (u & 31); banded_unit<W, SINK>(bh >> 2, bh & 3, tb, wave, lane, Q, K, VT, OUT, sinks); }
}

__device__ __forceinline__ void phase_lnt(const In& I, unsigned char* ws, LAS unsigned char* wsm  , LAS int* esm  , int layer, const bf16* Y, int gw, int lane_in, int tid, int vcu) {
    const float* mod = (const float*)(ws + WS_MOD); bf16* XA = (bf16*)(ws + WS_XA); bf16* H = (bf16*)(ws + WS_H);
    const float* lng = I.ln_t_g + layer * DM; const float* lnb = I.ln_t_b + layer * DM;
    const float* wg = I.moe_w_group + (size_t)layer * DM * 4; const float* wr = I.moe_w_router + (size_t)layer * DM * 16;
    int* tokE = (int*)(ws + WS_TOKE); float* tokW = (float*)(ws + WS_TOKW); int* tokS = (int*)(ws + WS_TOKS);
    constexpr int WCH = 64 * 272 + 64 * 80;
    f32x4 sr0, sr1, sgp = {0.f, 0.f, 0.f, 0.f};
    const int sk0 = tid >> 2, sk1 = (tid + 512) >> 2, sq = tid & 3;
    const float* srp0 = wr + (size_t)sk0 * 16 + 4 * sq; const float* srp1 = wr + (size_t)sk1 * 16 + 4 * sq; const float* sgpp = wg + (size_t)tid * 4;
    const int so0 = (sk0 >> 2) * 272 + (sk0 & 3) * 64 + sq * 16, so1 = (sk1 >> 2) * 272 + (sk1 & 3) * 64 + sq * 16, sog = 64 * 272 + (tid >> 2) * 80 + (tid & 3) * 16;
#define STAGE_LD(ch) do { sr0 = *(const f32x4*)(srp0 + (size_t)(ch) * 4096); sr1 = *(const f32x4*)(srp1 + (size_t)(ch) * 4096); if (tid < 256) sgp = *(const f32x4*)(sgpp + (size_t)(ch) * 1024); } while (0)
#define STAGE_ST(buf) do { LAS unsigned char* base_ = wsm + (buf) * WCH; *(LAS f32x4*)(base_ + so0) = sr0; *(LAS f32x4*)(base_ + so1) = sr1; if (tid < 256) *(LAS f32x4*)(base_ + sog) = sgp; } while (0)
    STAGE_LD(0); STAGE_ST(0); LDS_WAIT(); __syncthreads();
#pragma unroll 1
    for (int it = 0; it < 2; ++it) {
        int lane_o = lane_in; asm volatile("" : "+v"(lane_o)); const int lane = lane_o;
        const int rA = gw * 4 + it * 2, b = rA >> 12;
        const float* shc = mod + (size_t)(layer * 2 + b) * 12288 + 6144; const float* scc = shc + 2048;
        f32x4 v[2][8]; float rstd[2];
#pragma unroll
        for (int r = 0; r < 2; ++r) {
            const GAS u32x2g* yr = (const GAS u32x2g*)(Y + (size_t)(rA + r) * DM) + lane; float s = 0.f;
#pragma unroll
            for (int j = 0; j < 8; ++j) { const u32x2g w = yr[64 * j]; v[r][j] = (f32x4){fa::bflo(w.x), fa::bfhi(w.x), fa::bflo(w.y), fa::bfhi(w.y)}; s += (v[r][j].x + v[r][j].y) + (v[r][j].z + v[r][j].w); }
            const float mean = wave_sum(s) * (1.f / DM); float s2 = 0.f;
#pragma unroll
            for (int j = 0; j < 8; ++j) { v[r][j] = v[r][j] - mean; s2 += (v[r][j].x * v[r][j].x + v[r][j].y * v[r][j].y) + (v[r][j].z * v[r][j].z + v[r][j].w * v[r][j].w); }
            rstd[r] = 1.f / sqrtf(wave_sum(s2) * (1.f / DM) + LN_EPS);
        }
        float acc[2][20];
#pragma unroll
        for (int r = 0; r < 2; ++r)
#pragma unroll
            for (int e = 0; e < 20; ++e) acc[r][e] = 0.f;
#pragma unroll
        for (int j = 0; j < 8; ++j) { const int col = 256 * j + 4 * lane; const int step = it * 8 + j;
            const f32x4 gg = *(const f32x4*)(lng + col), bb = *(const f32x4*)(lnb + col), sc = *(const f32x4*)(scc + col), sh = *(const f32x4*)(shc + col);
            f32x4 h[2];
#pragma unroll
            for (int r = 0; r < 2; ++r) { const f32x4 x1 = v[r][j] * rstd[r] * gg + bb; ((GAS unsigned long long*)(XA + (size_t)(rA + r) * DM) + lane)[64 * j] = (unsigned long long)pk2(x1.x, x1.y) | ((unsigned long long)pk2(x1.z, x1.w) << 32);
                h[r] = x1 * (sc + 1.0f) + sh;
                ((GAS unsigned long long*)(H + (size_t)(rA + r) * DM) + lane)[64 * j] = (unsigned long long)pk2(h[r].x, h[r].y) | ((unsigned long long)pk2(h[r].z, h[r].w) << 32); }
            if (step < 15) STAGE_LD((j + 1) & 7);
            const LAS unsigned char* cb = wsm + (step & 1) * WCH;
#pragma unroll 1
            for (int i = 0; i < 4; ++i) {
                const float hA = i == 0 ? h[0][0] : i == 1 ? h[0][1] : i == 2 ? h[0][2] : h[0][3], hB = i == 0 ? h[1][0] : i == 1 ? h[1][1] : i == 2 ? h[1][2] : h[1][3];
#pragma unroll
                for (int q = 0; q < 4; ++q) { const f32x4 w = *(const LAS f32x4*)(cb + lane * 272 + i * 64 + q * 16);
#pragma unroll
                    for (int e = 0; e < 4; ++e) { acc[0][4 * q + e] += hA * w[e]; acc[1][4 * q + e] += hB * w[e]; } }
                const f32x4 w = *(const LAS f32x4*)(cb + 64 * 272 + lane * 80 + i * 16);
#pragma unroll
                for (int e = 0; e < 4; ++e) { acc[0][16 + e] += hA * w[e]; acc[1][16 + e] += hB * w[e]; }
            }
            if (step < 15) STAGE_ST((step + 1) & 1);
            LDS_WAIT(); __syncthreads(); __builtin_amdgcn_sched_barrier(0);
        }
#pragma unroll
        for (int r = 0; r < 2; ++r)
#pragma unroll
            for (int e = 0; e < 20; ++e) acc[r][e] = wave_sum(acc[r][e]);
        if (lane < 2) {
            float a[20];
#pragma unroll
            for (int e = 0; e < 20; ++e) a[e] = lane == 0 ? acc[0][e] : acc[1][e];
            const int row = rA + lane;
            float gl[4];
#pragma unroll
            for (int e = 0; e < 4; ++e) gl[e] = a[16 + e] + I.moe_b_group[layer * 4 + e];
            int gi = 0; float gm = gl[0];
#pragma unroll
            for (int e = 1; e < 4; ++e) if (gl[e] > gm) { gm = gl[e]; gi = e; }
            float gs = 0.f;
#pragma unroll
            for (int e = 0; e < 4; ++e) gs += __expf(gl[e] - gm);
            const float gprob = 1.0f / gs;
            float le[4];
#pragma unroll
            for (int e = 0; e < 4; ++e) le[e] = (gi == 0 ? a[e] : gi == 1 ? a[4 + e] : gi == 2 ? a[8 + e] : a[12 + e]) + I.moe_b_router[layer * 16 + gi * 4 + e];
            int i1 = 0; float m1 = le[0];
#pragma unroll
            for (int e = 1; e < 4; ++e) if (le[e] > m1) { m1 = le[e]; i1 = e; }
            int i2 = -1; float m2 = -INFINITY;
#pragma unroll
            for (int e = 0; e < 4; ++e) if (e != i1 && le[e] > m2) { m2 = le[e]; i2 = e; }
            const float p2 = __expf(m2 - m1), den = 1.0f / (1.0f + p2);
            const int e1 = gi * 4 + i1, e2 = gi * 4 + i2; const float w1 = gprob * den, w2 = gprob * p2 * den;
            tokE[row * 2] = e1; tokE[row * 2 + 1] = e2; tokW[row * 2] = w1; tokW[row * 2 + 1] = w2;
            esm[(row & 31) * 2] = e1; esm[(row & 31) * 2 + 1] = e2;
        }
    }
    LDS_WAIT(); __syncthreads();
    {
        int* tokS = (int*)(ws + WS_TOKS); int* bcnt = (int*)(ws + WS_BCNT) + (layer * 256 + vcu) * 16;
        if (tid < 64) { const int my = esm[tid]; int rk = 0;
            for (int j = 0; j < 64; ++j) rk += (j < tid && esm[j] == my) ? 1 : 0;
            tokS[(size_t)(vcu * 32) * 2 + tid] = rk; }
        else if (tid < 80) { const int e = tid - 64; int c = 0;
            for (int j = 0; j < 64; ++j) c += (esm[j] == e) ? 1 : 0;
            bcnt[e] = c; }
    }
    __syncthreads();
}

__device__ __forceinline__ void phase_lnt2(const In& I, unsigned char* ws, LAS unsigned char* lds, LAS int* esm  , int layer, const bf16* Y, int gw, int lane, int tid, int wave, int vcu) {
    typedef float f32x16r __attribute__((ext_vector_type(16)));
    const float* mod = (const float*)(ws + WS_MOD); bf16* XA = (bf16*)(ws + WS_XA); bf16* H = (bf16*)(ws + WS_H);
    const float* lng = I.ln_t_g + layer * DM; const float* lnb = I.ln_t_b + layer * DM;
    const float* wg = I.moe_w_group + (size_t)layer * DM * 4; const float* wr = I.moe_w_router + (size_t)layer * DM * 16;
    constexpr int APITCH = 129, ABYTES = 16640  , RBUF = ABYTES + 128 * 32 * 4;
    const int r0 = gw * 4, b = r0 >> 12;
    const float* shc = mod + (size_t)(layer * 2 + b) * 12288 + 6144; const float* scc = shc + 2048;
    for (int i = tid; i < 2 * 128 * 12; i += NWAVES * 64) { const int bf = i / (128 * 12), rem = i % (128 * 12); ((LAS float*)(lds + bf * RBUF + ABYTES))[(rem / 12) * 32 + 20 + rem % 12] = 0.f; }
    f32x4 v[4][8]; float rstd[4];
#pragma unroll
    for (int r = 0; r < 4; ++r) {
        const GAS u32x2g* yr = (const GAS u32x2g*)(Y + (size_t)(r0 + r) * DM) + lane; float s = 0.f;
#pragma unroll
        for (int j = 0; j < 8; ++j) { const u32x2g w = yr[64 * j]; v[r][j] = (f32x4){fa::bflo(w.x), fa::bfhi(w.x), fa::bflo(w.y), fa::bfhi(w.y)}; s += (v[r][j].x + v[r][j].y) + (v[r][j].z + v[r][j].w); }
        const float mean = wave_sum(s) * (1.f / DM); float s2 = 0.f;
#pragma unroll
        for (int j = 0; j < 8; ++j) { v[r][j] = v[r][j] - mean; s2 += (v[r][j].x * v[r][j].x + v[r][j].y * v[r][j].y) + (v[r][j].z * v[r][j].z + v[r][j].w * v[r][j].w); }
        rstd[r] = 1.f / sqrtf(wave_sum(s2) * (1.f / DM) + LN_EPS);
    }
    const int wk = tid >> 2, wq = tid & 3;
    f32x4 swr = *(const f32x4*)(wr + (size_t)wk * 16 + 4 * wq), swg = {0.f, 0.f, 0.f, 0.f};
    if (tid < 128) swg = *(const f32x4*)(wg + (size_t)tid * 4);
    f32x16r acc = f32x16r{};
    f32x4 h[4];
#pragma unroll
    for (int st = 0; st < 16; ++st) { const int j = st >> 1, hf = st & 1; LAS float* Ab = (LAS float*)(lds + (st & 1) * RBUF); LAS float* Wb = (LAS float*)(lds + (st & 1) * RBUF + ABYTES);
        if (hf == 0) { const int col = 256 * j + 4 * lane;
            const f32x4 gg = *(const f32x4*)(lng + col), bb = *(const f32x4*)(lnb + col), sc = *(const f32x4*)(scc + col), sh = *(const f32x4*)(shc + col);
#pragma unroll
            for (int r = 0; r < 4; ++r) { const f32x4 x1 = v[r][j] * rstd[r] * gg + bb;
                ((GAS unsigned long long*)(XA + (size_t)(r0 + r) * DM) + lane)[64 * j] = (unsigned long long)pk2(x1.x, x1.y) | ((unsigned long long)pk2(x1.z, x1.w) << 32);
                h[r] = x1 * (sc + 1.0f) + sh;
                ((GAS unsigned long long*)(H + (size_t)(r0 + r) * DM) + lane)[64 * j] = (unsigned long long)pk2(h[r].x, h[r].y) | ((unsigned long long)pk2(h[r].z, h[r].w) << 32); } }
        if ((lane >> 5) == hf) {
#pragma unroll
            for (int r = 0; r < 4; ++r) { LAS float* ap = Ab + (wave * 4 + r) * APITCH + 4 * (lane & 31); ap[0] = h[r].x; ap[1] = h[r].y; ap[2] = h[r].z; ap[3] = h[r].w; } }
        *(LAS f32x4*)(Wb + wk * 32 + 4 * wq) = swr; if (tid < 128) *(LAS f32x4*)(Wb + tid * 32 + 16) = swg;
        LDS_WAIT(); __syncthreads();
        if (st < 15) { swr = *(const f32x4*)(wr + (size_t)(128 * (st + 1) + wk) * 16 + 4 * wq); if (tid < 128) swg = *(const f32x4*)(wg + (size_t)(128 * (st + 1) + tid) * 4); }
#pragma unroll
        for (int m = 0; m < 8; ++m) { const int kk = 16 * wave + 2 * m + (lane >> 5);
            acc = __builtin_amdgcn_mfma_f32_32x32x2f32(Ab[(lane & 31) * APITCH + kk], Wb[kk * 32 + (lane & 31)], acc, 0, 0, 0); }
        __builtin_amdgcn_sched_barrier(0);
    }
    __syncthreads();
    { LAS float* red = (LAS float*)lds;
#pragma unroll
      for (int r = 0; r < 16; ++r) red[(wave * 16 + r) * 64 + lane] = acc[r]; }
    LDS_WAIT(); __syncthreads();
    LAS float* lg = (LAS float*)(lds + 40960);
    for (int i = tid; i < 32 * 20; i += NWAVES * 64) { const int row = i / 20, col = i % 20, ln = col + 32 * ((row >> 2) & 1), rg = (row & 3) + 4 * (row >> 3); float s = 0.f;
#pragma unroll
        for (int w = 0; w < 8; ++w) s += ((LAS float*)lds)[(w * 16 + rg) * 64 + ln];
        lg[i] = s; }
    LDS_WAIT(); __syncthreads();
    if (tid < 32) {
        float l2e = 1.4426950408889634f; asm volatile("" : "+v"(l2e));
        float a[20];
#pragma unroll
        for (int e = 0; e < 20; ++e) a[e] = lg[tid * 20 + e];
        const int row = vcu * 32 + tid;
        float gl[4];
#pragma unroll
        for (int e = 0; e < 4; ++e) gl[e] = a[16 + e] + I.moe_b_group[layer * 4 + e];
        int gi = 0; float gm = gl[0];
#pragma unroll
        for (int e = 1; e < 4; ++e) if (gl[e] > gm) { gm = gl[e]; gi = e; }
        float gs = 0.f;
#pragma unroll
        for (int e = 0; e < 4; ++e) gs += __builtin_amdgcn_exp2f((gl[e] - gm) * l2e);
        const float gprob = __builtin_amdgcn_rcpf(gs);
        float le[4];
#pragma unroll
        for (int e = 0; e < 4; ++e) le[e] = (gi == 0 ? a[e] : gi == 1 ? a[4 + e] : gi == 2 ? a[8 + e] : a[12 + e]) + I.moe_b_router[layer * 16 + gi * 4 + e];
        int i1 = 0; float m1 = le[0];
#pragma unroll
        for (int e = 1; e < 4; ++e) if (le[e] > m1) { m1 = le[e]; i1 = e; }
        int i2 = -1; float m2 = -INFINITY;
#pragma unroll
        for (int e = 0; e < 4; ++e) if (e != i1 && le[e] > m2) { m2 = le[e]; i2 = e; }
        const float p2 = __builtin_amdgcn_exp2f((m2 - m1) * l2e), den = __builtin_amdgcn_rcpf(1.0f + p2);
        const int e1 = gi * 4 + i1, e2 = gi * 4 + i2; const float w1 = gprob * den, w2 = gprob * p2 * den;
        esm[tid * 2] = e1; esm[tid * 2 + 1] = e2; ((LAS float*)esm)[64 + tid * 2] = w1; ((LAS float*)esm)[64 + tid * 2 + 1] = w2;
    }
    LDS_WAIT(); __syncthreads();
    {
        int rk = 0, my = 0;
        if (tid < 64) { my = esm[tid];
            for (int jj = 0; jj < 64; ++jj) rk += (jj < tid && esm[jj] == my) ? 1 : 0; }
        else if (tid < 80) { const int e = tid - 64; int c = 0;
            for (int jj = 0; jj < 64; ++jj) c += (esm[jj] == e) ? 1 : 0;
            esm[128 + e] = c ? (int)atomicAdd((unsigned*)(ws + WS_CTL) + CW_CNT + (layer * 16 + e) * CW_CNT_STRIDE, (unsigned)c) : 0; }
        LDS_WAIT(); __syncthreads();
        if (tid < 64) { const int row = vcu * 32 + (tid >> 1), dst = my * SEG_CAP + esm[128 + my] + rk;
            ((int*)(ws + WS_ROWTOK))[dst] = row * 2 + (tid & 1); ((float*)(ws + WS_ROWW))[dst] = ((LAS float*)esm)[64 + tid]; ((int*)(ws + WS_ROWSRC))[dst] = row; }
    }
    __syncthreads();
}

struct Seg { unsigned cnt[16]; };
__device__ __forceinline__ void seg_load(Seg& s, const unsigned* cnt) {
#pragma unroll
    for (int e = 0; e < 16; ++e) s.cnt[e] = ld_u32_agent(cnt + e * CW_CNT_STRIDE);
}
__device__ __forceinline__ int seg_row_base(const Seg& s, int e) {
    int run = 0, base = 0;
#pragma unroll
    for (int k = 0; k < 16; ++k) { if (k == e) base = run; run += (int)((s.cnt[k] + 255u) >> 8); }
    return base * 256;
}
__device__ __forceinline__ void phase_permute(unsigned char* ws, LAS int* psm  , int layer, int gw, int lane, int tid, int vcu) {
    const int* bc = (const int*)(ws + WS_BCNT) + layer * 256 * 16;
    { const int e = tid & 15, part = tid >> 4; int s = 0, pre = 0;
#pragma unroll
      for (int i = 0; i < 8; ++i) { const int v = part * 8 + i; const int c = bc[v * 16 + e]; s += c; pre += (v < vcu) ? c : 0; }
      psm[part * 16 + e] = s; if (part == (vcu >> 3)) psm[512 + 16 + e] = pre; }
    LDS_WAIT(); __syncthreads();
    if (tid < 16) { int tot = 0, bef = 0;
        for (int p = 0; p < 32; ++p) { const int c = psm[p * 16 + tid]; tot += c; bef += (p < (vcu >> 3)) ? c : 0; }
        psm[512 + tid] = tot; psm[512 + 16 + tid] += bef;
        if (vcu == 0) ((unsigned*)(ws + WS_CTL))[CW_CNT + (layer * 16 + tid) * CW_CNT_STRIDE] = (unsigned)tot; }
    LDS_WAIT(); __syncthreads();
    Seg sg;
#pragma unroll
    for (int e = 0; e < 16; ++e) sg.cnt[e] = (unsigned)psm[512 + e];
    const int* tokE = (const int*)(ws + WS_TOKE); const float* tokW = (const float*)(ws + WS_TOKW); const int* tokS = (const int*)(ws + WS_TOKS);
    int* rowtok = (int*)(ws + WS_ROWTOK); float* roww = (float*)(ws + WS_ROWW); int* rowsrc = (int*)(ws + WS_ROWSRC);
    if (tid < 64) { const int row = vcu * 32 + (tid >> 1), k = tid & 1; const int e = tokE[row * 2 + k], dst = seg_row_base(sg, e) + psm[512 + 16 + e] + tokS[row * 2 + k];
        rowtok[dst] = row * 2 + k; roww[dst] = tokW[row * 2 + k]; rowsrc[dst] = row; }
    if (vcu < 16) { const int e = vcu, c = psm[512 + e], b0 = seg_row_base(sg, e) + c, npad = ((c + 255) & ~255) - c;
        if (tid < npad) rowsrc[b0 + tid] = 0; }
    __syncthreads();
}
__device__ __forceinline__ void build_units(pg8::GroupOrder& S, const Seg& sg, int nN, int G, int c) {
    int nT = 0;
#pragma unroll
    for (int e = 0; e < 16; ++e) { S.cnt[e] = (unsigned)__builtin_amdgcn_readfirstlane((int)sg.cnt[e]); nT += (int)((S.cnt[e] + 255u) >> 8); }
    S.nT = nT; S.nN = nN; S.G = G; S.c = c;
}

__device__ __forceinline__ void phase_lnc(const In& I, unsigned char* ws, int layer, float* xout32  , bf16* xout16  , bool write_h, int gw, int lane) {
    const float* mod = (const float*)(ws + WS_MOD); const bf16* XA = (const bf16*)(ws + WS_XA); const bf16* YS = (const bf16*)(ws + WS_YS); bf16* H = (bf16*)(ws + WS_H);
    const float* lng = I.ln_c_g + layer * DM; const float* lnb = I.ln_c_b + layer * DM;
    const int row0 = gw * 4, b = row0 >> 12;
    const float* gc = mod + (size_t)(layer * 2 + b) * 12288 + 10240;
    const float* shn = mod + (size_t)(2 + b) * 12288; const float* scn = shn + 2048;
    u32x2g rx[2][8], ra[2][8], rc[2][8];
#define LNC_LOAD(pp) do { _Pragma("unroll") for (int r = 0; r < 2; ++r) { const int row = row0 + 2 * (pp) + r; \
        const GAS u32x2g* xr = (const GAS u32x2g*)(XA + (size_t)row * DM) + lane; const GAS u32x2g* s0 = (const GAS u32x2g*)(YS + (size_t)(row * 2) * DM) + lane; const GAS u32x2g* s1 = (const GAS u32x2g*)(YS + (size_t)(row * 2 + 1) * DM) + lane; \
        _Pragma("unroll") for (int j = 0; j < 8; ++j) { rx[r][j] = xr[64 * j]; ra[r][j] = s0[64 * j]; rc[r][j] = s1[64 * j]; } } } while (0)
#pragma unroll 1
    for (int pp = 0; pp < 2; ++pp) {
        LNC_LOAD(pp);
        f32x4 v[2][8]; float s[2] = {0.f, 0.f};
#pragma unroll
        for (int r = 0; r < 2; ++r)
#pragma unroll
            for (int j = 0; j < 8; ++j) { const u32x2g xw = rx[r][j], a = ra[r][j], c = rc[r][j]; const f32x4 g = *(const f32x4*)(gc + 256 * j + 4 * lane);
                const f32x4 x1 = {fa::bflo(xw.x), fa::bfhi(xw.x), fa::bflo(xw.y), fa::bfhi(xw.y)};
                f32x4 m; m.x = fa::bflo(a.x) + fa::bflo(c.x); m.y = fa::bfhi(a.x) + fa::bfhi(c.x); m.z = fa::bflo(a.y) + fa::bflo(c.y); m.w = fa::bfhi(a.y) + fa::bfhi(c.y);
                v[r][j] = x1 * ALPHA_RES + g * m; s[r] += (v[r][j].x + v[r][j].y) + (v[r][j].z + v[r][j].w); }
#pragma unroll
        for (int r = 0; r < 2; ++r) { const int row = row0 + 2 * pp + r;
            const float mean = wave_sum(s[r]) * (1.f / DM); float s2 = 0.f;
#pragma unroll
            for (int j = 0; j < 8; ++j) { v[r][j] = v[r][j] - mean; s2 += (v[r][j].x * v[r][j].x + v[r][j].y * v[r][j].y) + (v[r][j].z * v[r][j].z + v[r][j].w * v[r][j].w); }
            const float rstd = 1.f / sqrtf(wave_sum(s2) * (1.f / DM) + LN_EPS);
            GAS f32x4* xo = (GAS f32x4*)(xout32 + (size_t)row * DM) + lane; GAS unsigned long long* xo16 = (GAS unsigned long long*)(xout16 + (size_t)row * DM) + lane; GAS unsigned long long* ho = (GAS unsigned long long*)(H + (size_t)row * DM) + lane;
#pragma unroll
            for (int j = 0; j < 8; ++j) { const int col = 256 * j + 4 * lane; const f32x4 gg = *(const f32x4*)(lng + col), bb = *(const f32x4*)(lnb + col);
                const f32x4 x2 = v[r][j] * rstd * gg + bb; if (write_h) xo16[64 * j] = (unsigned long long)pk2(x2.x, x2.y) | ((unsigned long long)pk2(x2.z, x2.w) << 32); else xo[64 * j] = x2;
                if (write_h) { const f32x4 sc = *(const f32x4*)(scn + col), sh = *(const f32x4*)(shn + col); const f32x4 h = x2 * (sc + 1.0f) + sh;
                    ho[64 * j] = (unsigned long long)pk2(h.x, h.y) | ((unsigned long long)pk2(h.z, h.w) << 32); } } }
    }
#undef LNC_LOAD
}

__device__ __forceinline__ void phase_cmp2(const In& I, unsigned char* ws, LAS unsigned char* lds, int gw, int NGW, int lane, int tid, int wave) {
    LAS float* hid = (LAS float*)(lds + wave * 1024);
    LAS float* phl = (LAS float*)(lds + 16384);
    for (int which = 0; which < 2; ++which) {
        const float* phi2 = which ? I.nsa_phi_v2 : I.nsa_phi_k2;
        __syncthreads();
        for (int i = tid; i < 256 * 16; i += NWAVES * 64) *(LAS f32x4*)(phl + 4 * i) = *(const f32x4*)(phi2 + 4 * i);
        LDS_WAIT(); __syncthreads();
        for (int task = which * 2048 + gw; task < (which + 1) * 2048; task += NGW) { const int bh = (task >> 8) & 7, n = task & 255;
            bf16* kc = (bf16*)(ws + WS_KCMP); bf16* vct = (bf16*)(ws + WS_VCMPT); float o = 0.f;
            if (n < 255) { const float* UL = (const float*)(ws + (which ? WS_ULV : WS_ULK)); const float* cb = (const float*)(ws + WS_CMPB) + which * 256;
                const f32x4 u = *(const f32x4*)(UL + (size_t)(bh * 256 + n) * 512 + 4 * lane), l = *(const f32x4*)(UL + (size_t)(bh * 256 + n + 1) * 512 + 256 + 4 * lane), bb = *(const f32x4*)(cb + 4 * lane);
                f32x4 h = u + l + bb;
#pragma unroll
                for (int i = 0; i < 4; ++i) h[i] = h[i] / (1.0f + __expf(-h[i]));
                *(LAS f32x4*)(hid + 4 * lane) = h; LDS_WAIT(); asm volatile("" ::: "memory");
                float o0 = 0.f, o1 = 0.f, o2 = 0.f, o3 = 0.f;
#pragma unroll 4
                for (int cidx = 0; cidx < 256; cidx += 4) { const f32x4 hv = *(const LAS f32x4*)(hid + cidx);
                    o0 += hv.x * phl[cidx * 64 + lane]; o1 += hv.y * phl[(cidx + 1) * 64 + lane]; o2 += hv.z * phl[(cidx + 2) * 64 + lane]; o3 += hv.w * phl[(cidx + 3) * 64 + lane]; }
                o = (o0 + o1) + (o2 + o3);
                LDS_WAIT(); asm volatile("" ::: "memory"); }
            if (which == 0) kc[(size_t)(bh * 256 + n) * 64 + lane] = (bf16)f2bf(o); else vct[(size_t)(bh * 64 + lane) * 256 + n] = (bf16)f2bf(o);
        }
    }
    __syncthreads();
}

constexpr int CMP_XS = 0, CMP_TOT = 34816, CMP_K = 45056, CMP_V = 81920, CMP_VP = 528;
__device__ __forceinline__ fa::bf16x8 ov_frag(int d, bool spill_only) {
    fa::u32x4 w = {0u, 0u, 0u, 0u};
    if (!spill_only) {
        if (d == 0) { w.x = 0x3F803F80u; w.y = 0x3F003F80u; }
        else if (d == 1) { w.y = 0x3F000000u; w.z = 0x3F803F80u; w.w = 0x3F003F80u; }
        else if (d == 2) { w.w = 0x3F000000u; } }
    else if (d == 2) w.w = 0x3F000000u;
    return __builtin_bit_cast(fa::bf16x8, w);
}
__device__ __forceinline__ void cmp_unit(unsigned char* ws, LAS unsigned char* lds, int b, int hkv, int tb, int tid, int wave, int lane) {
    const int r32 = lane & 31, hi = lane >> 5, head = hkv * 8 + wave, q0 = tb * 32, t = q0 + r32; const size_t row = (size_t)b * SEQ + t;
    const bf16* Q = (const bf16*)(ws + WS_Q); bf16* OUT = (bf16*)(ws + WS_OCMP);
    LAS float* tot = (LAS float*)(lds + CMP_TOT);
    fa::bf16x8 qr[4]; fa::load_q(qr, Q + row * DM + head * 64, hi);
    {
        const fa::u32x4 mine = __builtin_bit_cast(fa::u32x4, qr[0]); fa::u32x4 oth;
#pragma unroll
        for (int i = 0; i < 4; ++i) { const auto rr = __builtin_amdgcn_permlane32_swap(mine[i], mine[i], false, false); oth[i] = hi ? rr[0] : rr[1]; }
        const float* rp = (const float*)(ws + WS_ROPE) + row * 16; const f32x4 c0 = *(const f32x4*)rp, c1 = *(const f32x4*)(rp + 4), s0 = *(const f32x4*)(rp + 8), s1 = *(const f32x4*)(rp + 12);
        const float sg = hi ? -1.f : 1.f; fa::u32x4 o;
        o.x = fa::cvtpk(fa::bflo(mine.x) * c0.x + sg * fa::bflo(oth.x) * s0.x, fa::bfhi(mine.x) * c0.y + sg * fa::bfhi(oth.x) * s0.y);
        o.y = fa::cvtpk(fa::bflo(mine.y) * c0.z + sg * fa::bflo(oth.y) * s0.z, fa::bfhi(mine.y) * c0.w + sg * fa::bfhi(oth.y) * s0.w);
        o.z = fa::cvtpk(fa::bflo(mine.z) * c1.x + sg * fa::bflo(oth.z) * s1.x, fa::bfhi(mine.z) * c1.y + sg * fa::bfhi(oth.z) * s1.y);
        o.w = fa::cvtpk(fa::bflo(mine.w) * c1.z + sg * fa::bflo(oth.w) * s1.z, fa::bfhi(mine.w) * c1.w + sg * fa::bfhi(oth.w) * s1.w);
        qr[0] = __builtin_bit_cast(fa::bf16x8, o); }
    fa::State st; st.o0 = fa::f32x16{}; st.o1 = fa::f32x16{}; st.m = fa::NEGBIG; st.l = 0.f;
    fa::f32x16 impA = fa::f32x16{}, impB = fa::f32x16{};
    const int nhi = (t - 31) >> 4;
    const int nhi_min = (q0 - 31) >> 4;
    const int ntile = ((2 * tb) >> 5) + 1;
    const LAS unsigned char* kl = lds + CMP_K + fa::kap(r32) * 144 + hi * 16;
    const LAS unsigned char* vl = lds + CMP_V + r32 * CMP_VP + hi * 16;
    for (int kt = 0; kt < ntile; ++kt) {
        fa::Frag f;
#pragma unroll
        for (int d0 = 0; d0 < 4; ++d0) f.k[d0] = *(const LAS fa::bf16x8*)(kl + kt * 32 * 144 + d0 * 32);
#pragma unroll
        for (int db = 0; db < 2; ++db)
#pragma unroll
            for (int sx = 0; sx < 2; ++sx) f.v[db * 2 + sx] = *(const LAS fa::bf16x8*)(vl + db * 32 * CMP_VP + kt * 64 + sx * 32);
        fa::f32x16 p; fa::scores(p, f, qr);
        if (kt * 32 + 31 > nhi_min) fa::mask_range(p, kt * 32, hi, 0, nhi);
        float tm = fmaxf(p[0], p[1]);
#pragma unroll
        for (int r = 2; r < 16; ++r) tm = fmaxf(tm, p[r]);
        tm = fa::xmax(tm);
        const float mn = fmaxf(st.m, tm); const float alpha = __builtin_amdgcn_exp2f(st.m - mn); st.m = mn;
        float rs = 0.f;
#pragma unroll
        for (int r = 0; r < 16; ++r) { p[r] = __builtin_amdgcn_exp2f(p[r] - mn); rs += p[r]; }
        st.l = st.l * alpha + rs;
        if (!__all(alpha == 1.0f)) { st.o0 = st.o0 * alpha; st.o1 = st.o1 * alpha; impA = impA * alpha; impB = impB * alpha; }
        fa::u32x4 w0, w1;
        w0.x = fa::cvtpk(p[0], p[1]); w0.y = fa::cvtpk(p[2], p[3]); w0.z = fa::cvtpk(p[4], p[5]); w0.w = fa::cvtpk(p[6], p[7]);
        w1.x = fa::cvtpk(p[8], p[9]); w1.y = fa::cvtpk(p[10], p[11]); w1.z = fa::cvtpk(p[12], p[13]); w1.w = fa::cvtpk(p[14], p[15]);
        const fa::bf16x8 pb0 = __builtin_bit_cast(fa::bf16x8, w0), pb1 = __builtin_bit_cast(fa::bf16x8, w1);
        st.o0 = __builtin_amdgcn_mfma_f32_32x32x16_bf16(f.v[0], pb0, st.o0, 0, 0, 0);
        st.o0 = __builtin_amdgcn_mfma_f32_32x32x16_bf16(f.v[1], pb1, st.o0, 0, 0, 0);
        st.o1 = __builtin_amdgcn_mfma_f32_32x32x16_bf16(f.v[2], pb0, st.o1, 0, 0, 0);
        st.o1 = __builtin_amdgcn_mfma_f32_32x32x16_bf16(f.v[3], pb1, st.o1, 0, 0, 0);
        { const int T = kt >> 2, S = 32 * T + r32;
          const fa::bf16x8 o0f = ov_frag(S - (8 * kt + 2 * hi), false), o1f = ov_frag(S - (8 * kt + 4 + 2 * hi), false);
          if (T == 0) { impA = __builtin_amdgcn_mfma_f32_32x32x16_bf16(o0f, pb0, impA, 0, 0, 0); impA = __builtin_amdgcn_mfma_f32_32x32x16_bf16(o1f, pb1, impA, 0, 0, 0); }
          else        { impB = __builtin_amdgcn_mfma_f32_32x32x16_bf16(o0f, pb0, impB, 0, 0, 0); impB = __builtin_amdgcn_mfma_f32_32x32x16_bf16(o1f, pb1, impB, 0, 0, 0); }
          if (kt == 3) {
              const fa::bf16x8 sp = ov_frag((r32 == 0 && hi == 1) ? 2 : 9, true);
              impB = __builtin_amdgcn_mfma_f32_32x32x16_bf16(sp, pb1, impB, 0, 0, 0); } }
    }
    const float inv = fa::finish(st);
    fa::store_o(st, inv, OUT + row * DM + head * 64, hi);
    LAS float* xs = (LAS float*)(lds + CMP_XS) + (wave & 3) * (32 * 66) + r32 * 66 + 4 * hi;
#define CMP_XW(EXPR_A, EXPR_B) do { _Pragma("unroll") for (int r = 0; r < 16; ++r) { const int sl = (r & 3) + 8 * (r >> 2); xs[sl] = (EXPR_A); xs[32 + sl] = (EXPR_B); } } while (0)
    if (wave >= 4) CMP_XW(impA[r] * inv, impB[r] * inv);
    LDS_WAIT(); __syncthreads();
    if (wave < 4) CMP_XW(impA[r] * inv + xs[sl], impB[r] * inv + xs[32 + sl]);
#undef CMP_XW
    LDS_WAIT(); __syncthreads();
    for (int i = tid; i < 32 * 64; i += NWAVES * 64) { const int q = i >> 6, j = i & 63; float s = 0.f;
#pragma unroll
        for (int w = 0; w < 4; ++w) s += ((LAS float*)(lds + CMP_XS))[w * (32 * 66) + q * 66 + j];
        const int tq = q0 + q, cur = tq >> 6; const bool causal = j * 64 <= tq, forced = (j == 0) || (j == cur) || (j == cur - 1);
        tot[q * 68 + j] = causal ? s + (forced ? 1e4f : 0.f) : -1e30f; }
    LDS_WAIT(); __syncthreads();
    {
        const int q = tid >> 4, part = tid & 15, tq = q0 + q;
        float sc[4];
#pragma unroll
        for (int i = 0; i < 4; ++i) sc[i] = tot[q * 68 + 4 * part + i];
        int rk[4] = {0, 0, 0, 0};
#pragma unroll 8
        for (int jp = 0; jp < 64; ++jp) { const float sp = tot[q * 68 + jp];
#pragma unroll
            for (int i = 0; i < 4; ++i) { const int j = 4 * part + i; rk[i] += (sp > sc[i] || (sp == sc[i] && jp < j)) ? 1 : 0; } }
        unsigned lo = 0u, hi32 = 0u;
#pragma unroll
        for (int i = 0; i < 4; ++i) { const int j = 4 * part + i; if (rk[i] < 16) { if (j < 32) lo |= 1u << j; else hi32 |= 1u << (j - 32); } }
#pragma unroll
        for (int o = 1; o < 16; o <<= 1) { lo |= __shfl_xor(lo, o); hi32 |= __shfl_xor(hi32, o); }
        if (part == 0) ((unsigned long long*)(ws + WS_SELM))[(size_t)(b * 4 + hkv) * SEQ + tq] = ((unsigned long long)hi32 << 32) | lo;
    }
    __syncthreads();
}

__device__ __forceinline__ void sel_unit(unsigned char* ws, int b, int hkv, int tb, int wave, int lane) {
    const int r32 = lane & 31, hi = lane >> 5, head = hkv * 8 + wave, q0 = tb * 32, t = q0 + r32; const size_t row = (size_t)b * SEQ + t;
    const bf16* Q = (const bf16*)(ws + WS_Q); bf16* OUT = (bf16*)(ws + WS_ATT);
    const bf16* Kbh = (const bf16*)(ws + WS_KS) + (size_t)(b * 4 + hkv) * SEQ * 64; const bf16* Vbh = (const bf16*)(ws + WS_VST) + (size_t)(b * 4 + hkv) * 64 * SEQ;
    const unsigned long long selm = ((const unsigned long long*)(ws + WS_SELM))[(size_t)(b * 4 + hkv) * SEQ + t];
    unsigned ulo = (unsigned)selm, uhi = (unsigned)(selm >> 32);
#pragma unroll
    for (int o = 1; o < 64; o <<= 1) { ulo |= __shfl_xor(ulo, o); uhi |= __shfl_xor(uhi, o); }
    const unsigned long long U = ((unsigned long long)(unsigned)__builtin_amdgcn_readfirstlane((int)uhi) << 32) | (unsigned)__builtin_amdgcn_readfirstlane((int)ulo);
    fa::bf16x8 qr[4]; fa::load_q(qr, Q + row * DM + head * 64, hi);
    fa::State st; st.o0 = fa::f32x16{}; st.o1 = fa::f32x16{}; st.m = fa::NEGBIG; st.l = 0.f;
    int kt = 0; while (kt <= tb && !((U >> (kt >> 1)) & 1ull)) ++kt;
    fa::Frag fc, fn; if (kt <= tb) fa::load_tile(fc, Kbh, Vbh, SEQ, kt * 32, r32, hi);
    while (kt <= tb) {
        int kn = kt + 1; while (kn <= tb && !((U >> (kn >> 1)) & 1ull)) ++kn;
        if (kn <= tb) fa::load_tile(fn, Kbh, Vbh, SEQ, kn * 32, r32, hi);
        const bool mine = (selm >> (kt >> 1)) & 1ull;
        const bool nm = (kt == tb) || !__all(mine);
        fa::step(st, fc, qr, kt * 32, hi, nm, 0, mine ? t : -1);
        fc = fn; kt = kn;
    }
    const float inv = fa::finish(st);
    const float* gates = (const float*)(ws + WS_GATES) + row * 96 + head * 3; const float g0 = gates[0], g1 = gates[1] * inv, g2 = gates[2];
    const bf16* oc = (const bf16*)(ws + WS_OCMP) + row * DM + head * 64; const bf16* ow = (const bf16*)(ws + WS_OWIN) + row * DM + head * 64; bf16* od = OUT + row * DM + head * 64;
#pragma unroll
    for (int g = 0; g < 4; ++g)
#pragma unroll
        for (int db = 0; db < 2; ++db) { const int d = 32 * db + 8 * g + 4 * hi; const u32x2g c = *(const u32x2g*)(oc + d), w = *(const u32x2g*)(ow + d);
            const fa::f32x16& oo = db ? st.o1 : st.o0;
            const float v0 = g0 * fa::bflo(c.x) + g1 * oo[4 * g] + g2 * fa::bflo(w.x), v1 = g0 * fa::bfhi(c.x) + g1 * oo[4 * g + 1] + g2 * fa::bfhi(w.x);
            const float v2 = g0 * fa::bflo(c.y) + g1 * oo[4 * g + 2] + g2 * fa::bflo(w.y), v3 = g0 * fa::bfhi(c.y) + g1 * oo[4 * g + 3] + g2 * fa::bfhi(w.y);
            u32x2g o; o.x = fa::cvtpk(v0, v1); o.y = fa::cvtpk(v2, v3); *(u32x2g*)(od + d) = o; }
}
namespace fb {
using fa::bf16x8; using fa::f32x16; using fa::u32x4;
constexpr int PITCH = 144, TILE = 64 * PITCH, BUF = 2 * TILE;
struct Stage { v4u k, v; };
__device__ __forceinline__ void stage_load(Stage& s, const bf16* Kbh, const bf16* Vbh, int VP, int key0, int tid) {
    const int row = tid >> 3, ch = tid & 7;
    s.k = *(const GAS v4u*)(Kbh + (size_t)(key0 + row) * 64 + ch * 8);
    s.v = *(const GAS v4u*)(Vbh + (size_t)row * VP + key0 + ch * 8);
}
__device__ __forceinline__ void stage_store(const Stage& s, LAS unsigned char* lds, int buf, int tid) {
    const int row = tid >> 3, ch = tid & 7; LAS unsigned char* p = lds + buf * BUF + row * PITCH + ch * 16;
    *(LAS v4u*)p = s.k; *(LAS v4u*)(p + TILE) = s.v;
}
__device__ __forceinline__ void frag_load_k(bf16x8 (&k)[8], const LAS unsigned char* lds, int buf, int r32, int hi) {
    const LAS unsigned char* kb = lds + buf * BUF + fa::kap(r32) * PITCH + hi * 16;
#pragma unroll
    for (int h = 0; h < 2; ++h)
#pragma unroll
        for (int d0 = 0; d0 < 4; ++d0) k[h * 4 + d0] = *(const LAS bf16x8*)(kb + h * 32 * PITCH + d0 * 32);
}
__device__ __forceinline__ void frag_load_v(bf16x8 (&v)[8], const LAS unsigned char* lds, int buf, int r32, int hi) {
    const LAS unsigned char* vb = lds + buf * BUF + TILE + r32 * PITCH + hi * 16;
#pragma unroll
    for (int db = 0; db < 2; ++db)
#pragma unroll
        for (int h = 0; h < 2; ++h)
#pragma unroll
            for (int s = 0; s < 2; ++s) v[(db * 2 + h) * 2 + s] = *(const LAS bf16x8*)(vb + db * 32 * PITCH + h * 64 + s * 32);
}
struct QState { f32x16 o0, o1; float m, l; };
__device__ __forceinline__ void block_step(QState& st, const LAS unsigned char* lds, int buf, int r32, const LAS unsigned char* qlds  , int key0, int hi, bool sel, bool emask, int lo, int hi_) {
    f32x16 p0 = f32x16{}, p1 = f32x16{};
    { bf16x8 fk[8], qr[4]; frag_load_k(fk, lds, buf, r32, hi);
#pragma unroll
      for (int d0 = 0; d0 < 4; ++d0) qr[d0] = *(const LAS bf16x8*)(qlds + d0 * 1024);
#pragma unroll
    for (int d0 = 0; d0 < 4; ++d0) { p0 = __builtin_amdgcn_mfma_f32_32x32x16_bf16(fk[d0], qr[d0], p0, 0, 0, 0); p1 = __builtin_amdgcn_mfma_f32_32x32x16_bf16(fk[4 + d0], qr[d0], p1, 0, 0, 0); } }
    if (emask) { fa::mask_range(p0, key0, hi, lo, hi_); fa::mask_range(p1, key0 + 32, hi, lo, hi_); }
    float ta = fmaxf(p0[0], p0[1]), tb = fmaxf(p1[0], p1[1]);
#pragma unroll
    for (int r = 2; r < 16; ++r) { ta = fmaxf(ta, p0[r]); tb = fmaxf(tb, p1[r]); }
    const float tm = fa::xmax(fmaxf(ta, tb));
    const float mn = sel ? fmaxf(st.m, tm) : st.m; const float alpha = __builtin_amdgcn_exp2f(st.m - mn); st.m = mn;
    const float me = sel ? mn : INFINITY;
    float rs0 = 0.f, rs1 = 0.f;
#pragma unroll
    for (int r = 0; r < 16; ++r) { p0[r] = __builtin_amdgcn_exp2f(p0[r] - me); p1[r] = __builtin_amdgcn_exp2f(p1[r] - me); rs0 += p0[r]; rs1 += p1[r]; }
#if defined(ATT_PROBE) && ATT_PROBE == 1
    {
#pragma unroll
      for (int r = 0; r < 32; ++r) { float d_; asm volatile("v_exp_f32 %0, %1" : "=v"(d_) : "v"(p0[r & 15])); } }
#endif
    st.l = st.l * alpha + (rs0 + rs1);
    if (!__all(alpha == 1.0f)) { st.o0 = st.o0 * alpha; st.o1 = st.o1 * alpha; }
    u32x4 w;
    w.x = fa::cvtpk(p0[0], p0[1]); w.y = fa::cvtpk(p0[2], p0[3]); w.z = fa::cvtpk(p0[4], p0[5]); w.w = fa::cvtpk(p0[6], p0[7]); const bf16x8 a0 = __builtin_bit_cast(bf16x8, w);
    w.x = fa::cvtpk(p0[8], p0[9]); w.y = fa::cvtpk(p0[10], p0[11]); w.z = fa::cvtpk(p0[12], p0[13]); w.w = fa::cvtpk(p0[14], p0[15]); const bf16x8 a1 = __builtin_bit_cast(bf16x8, w);
    w.x = fa::cvtpk(p1[0], p1[1]); w.y = fa::cvtpk(p1[2], p1[3]); w.z = fa::cvtpk(p1[4], p1[5]); w.w = fa::cvtpk(p1[6], p1[7]); const bf16x8 b0 = __builtin_bit_cast(bf16x8, w);
    w.x = fa::cvtpk(p1[8], p1[9]); w.y = fa::cvtpk(p1[10], p1[11]); w.z = fa::cvtpk(p1[12], p1[13]); w.w = fa::cvtpk(p1[14], p1[15]); const bf16x8 b1 = __builtin_bit_cast(bf16x8, w);
    bf16x8 fv[8]; frag_load_v(fv, lds, buf, r32, hi);
#if defined(ATT_PROBE) && ATT_PROBE == 2
    { f32x16 dm = f32x16{};
#pragma unroll
      for (int r = 0; r < 8; ++r) dm = __builtin_amdgcn_mfma_f32_32x32x16_bf16(fv[r], a0, dm, 0, 0, 0);
      asm volatile("" :: "v"(dm)); }
#endif
#if defined(ATT_PROBE) && ATT_PROBE == 3
    { bf16x8 fx[8]; frag_load_k(fx, lds, buf, r32 ^ 1, hi);
#pragma unroll
      for (int r = 0; r < 8; ++r) asm volatile("" :: "v"(fx[r])); }
#endif
    st.o0 = __builtin_amdgcn_mfma_f32_32x32x16_bf16(fv[0], a0, st.o0, 0, 0, 0); st.o1 = __builtin_amdgcn_mfma_f32_32x32x16_bf16(fv[4], a0, st.o1, 0, 0, 0);
    st.o0 = __builtin_amdgcn_mfma_f32_32x32x16_bf16(fv[1], a1, st.o0, 0, 0, 0); st.o1 = __builtin_amdgcn_mfma_f32_32x32x16_bf16(fv[5], a1, st.o1, 0, 0, 0);
    st.o0 = __builtin_amdgcn_mfma_f32_32x32x16_bf16(fv[2], b0, st.o0, 0, 0, 0); st.o1 = __builtin_amdgcn_mfma_f32_32x32x16_bf16(fv[6], b0, st.o1, 0, 0, 0);
    st.o0 = __builtin_amdgcn_mfma_f32_32x32x16_bf16(fv[3], b1, st.o0, 0, 0, 0); st.o1 = __builtin_amdgcn_mfma_f32_32x32x16_bf16(fv[7], b1, st.o1, 0, 0, 0);
}
__device__ __forceinline__ void qk2(f32x16& pa0, f32x16& pa1, f32x16& pb0, f32x16& pb1, const LAS unsigned char* lds, int buf, int r32, const LAS unsigned char* qpark, int hi) {
    pa0 = f32x16{}; pa1 = f32x16{}; pb0 = f32x16{}; pb1 = f32x16{};
    { bf16x8 fk[8]; frag_load_k(fk, lds, buf, r32, hi);
#pragma unroll
      for (int d0 = 0; d0 < 4; ++d0) { const bf16x8 qa = *(const LAS bf16x8*)(qpark + d0 * 1024);
          pa0 = __builtin_amdgcn_mfma_f32_32x32x16_bf16(fk[d0], qa, pa0, 0, 0, 0); pa1 = __builtin_amdgcn_mfma_f32_32x32x16_bf16(fk[4 + d0], qa, pa1, 0, 0, 0); }
#pragma unroll
      for (int d0 = 0; d0 < 4; ++d0) { const bf16x8 qb = *(const LAS bf16x8*)(qpark + 4096 + d0 * 1024);
          pb0 = __builtin_amdgcn_mfma_f32_32x32x16_bf16(fk[d0], qb, pb0, 0, 0, 0); pb1 = __builtin_amdgcn_mfma_f32_32x32x16_bf16(fk[4 + d0], qb, pb1, 0, 0, 0); } }
}
__device__ __forceinline__ void sp2(QState& s0, QState& s1, f32x16& pa0, f32x16& pa1, f32x16& pb0, f32x16& pb1, const LAS unsigned char* lds, int buf, int r32, int key0, int hi,
                                    bool sel0, bool sel1, bool emask, int lo0, int hi0, int lo1, int hi1) {
    bf16x8 fv[8];
#define SP_(st, p0, p1, sel, lo, hi_, LOADV) do { \
    if (emask) { fa::mask_range(p0, key0, hi, lo, hi_); fa::mask_range(p1, key0 + 32, hi, lo, hi_); } \
    float ta = fmaxf(p0[0], p0[1]), tb = fmaxf(p1[0], p1[1]); \
    _Pragma("unroll") for (int r = 2; r < 16; ++r) { ta = fmaxf(ta, p0[r]); tb = fmaxf(tb, p1[r]); } \
    const float tm = fa::xmax(fmaxf(ta, tb)); \
    const float mn = sel ? fmaxf(st.m, tm) : st.m; const float alpha = __builtin_amdgcn_exp2f(st.m - mn); st.m = mn; \
    const float me = sel ? mn : INFINITY; \
    float rs0 = 0.f, rs1 = 0.f; \
    _Pragma("unroll") for (int r = 0; r < 16; ++r) { p0[r] = __builtin_amdgcn_exp2f(p0[r] - me); p1[r] = __builtin_amdgcn_exp2f(p1[r] - me); rs0 += p0[r]; rs1 += p1[r]; } \
    st.l = st.l * alpha + (rs0 + rs1); \
    if (!__all(alpha == 1.0f)) { st.o0 = st.o0 * alpha; st.o1 = st.o1 * alpha; } \
    u32x4 w; \
    w.x = fa::cvtpk(p0[0], p0[1]); w.y = fa::cvtpk(p0[2], p0[3]); w.z = fa::cvtpk(p0[4], p0[5]); w.w = fa::cvtpk(p0[6], p0[7]); const bf16x8 a0 = __builtin_bit_cast(bf16x8, w); \
    w.x = fa::cvtpk(p0[8], p0[9]); w.y = fa::cvtpk(p0[10], p0[11]); w.z = fa::cvtpk(p0[12], p0[13]); w.w = fa::cvtpk(p0[14], p0[15]); const bf16x8 a1 = __builtin_bit_cast(bf16x8, w); \
    w.x = fa::cvtpk(p1[0], p1[1]); w.y = fa::cvtpk(p1[2], p1[3]); w.z = fa::cvtpk(p1[4], p1[5]); w.w = fa::cvtpk(p1[6], p1[7]); const bf16x8 b0 = __builtin_bit_cast(bf16x8, w); \
    w.x = fa::cvtpk(p1[8], p1[9]); w.y = fa::cvtpk(p1[10], p1[11]); w.z = fa::cvtpk(p1[12], p1[13]); w.w = fa::cvtpk(p1[14], p1[15]); const bf16x8 b1 = __builtin_bit_cast(bf16x8, w); \
    if (LOADV) { __builtin_amdgcn_sched_barrier(0); frag_load_v(fv, lds, buf, r32, hi); } \
    st.o0 = __builtin_amdgcn_mfma_f32_32x32x16_bf16(fv[0], a0, st.o0, 0, 0, 0); st.o1 = __builtin_amdgcn_mfma_f32_32x32x16_bf16(fv[4], a0, st.o1, 0, 0, 0); \
    st.o0 = __builtin_amdgcn_mfma_f32_32x32x16_bf16(fv[1], a1, st.o0, 0, 0, 0); st.o1 = __builtin_amdgcn_mfma_f32_32x32x16_bf16(fv[5], a1, st.o1, 0, 0, 0); \
    st.o0 = __builtin_amdgcn_mfma_f32_32x32x16_bf16(fv[2], b0, st.o0, 0, 0, 0); st.o1 = __builtin_amdgcn_mfma_f32_32x32x16_bf16(fv[6], b0, st.o1, 0, 0, 0); \
    st.o0 = __builtin_amdgcn_mfma_f32_32x32x16_bf16(fv[3], b1, st.o0, 0, 0, 0); st.o1 = __builtin_amdgcn_mfma_f32_32x32x16_bf16(fv[7], b1, st.o1, 0, 0, 0); } while (0)
    SP_(s0, pa0, pa1, sel0, lo0, hi0, true);
    __builtin_amdgcn_sched_barrier(0);
    SP_(s1, pb0, pb1, sel1, lo1, hi1, false);
#undef SP_
}
__device__ __forceinline__ float finish(QState& st) { const float lt = fa::xsum(st.l); return lt > 0.f ? 1.0f / lt : 0.f; }
}

template <int MODE, int W>
__device__ __forceinline__ void attn64_unit(unsigned char* ws, LAS unsigned char* lds, int b, int hkv, int c, int tid, int wave, int lane, const bf16* Q, const bf16* K, const bf16* VT, bf16* OUT, const float* sinks) {
    const int r32 = lane & 31, hi = lane >> 5, head = hkv * 8 + wave, q0 = c * 64;
    const bf16* Kbh = K + (size_t)(b * 4 + hkv) * SEQ * 64; const bf16* Vbh = VT + (size_t)(b * 4 + hkv) * 64 * SEQ;
    fb::QState st[2]; unsigned long long selm[2] = {~0ull, ~0ull};
    LAS unsigned char* qpark = lds + 2 * fb::BUF + wave * 8192 + lane * 16;
#pragma unroll
    for (int g = 0; g < 2; ++g) { const size_t row = (size_t)b * SEQ + q0 + 32 * g + r32;
        { fa::bf16x8 qr[4]; fa::load_q(qr, Q + row * DM + head * 64, hi);
#pragma unroll
          for (int d0 = 0; d0 < 4; ++d0) *(LAS fa::bf16x8*)(qpark + (g * 4 + d0) * 1024) = qr[d0]; }
        st[g].o0 = fa::f32x16{}; st[g].o1 = fa::f32x16{};
        if (MODE == 0) { st[g].m = sinks[head] * LOG2E; st[g].l = hi == 0 ? 1.0f : 0.0f; } else { st[g].m = fa::NEGBIG; st[g].l = 0.f; }
        if (MODE == 2) { const unsigned long long sm = ((const unsigned long long*)(ws + WS_SELM))[(size_t)(b * 4 + hkv) * SEQ + q0 + 32 * g + r32];
            unsigned lo_ = (unsigned)sm, hi_ = (unsigned)(sm >> 32), lo2, hi2;
            asm volatile("v_mov_b32 %0, %2\n\tv_mov_b32 %1, %3" : "=&v"(lo2), "=&v"(hi2) : "v"(lo_), "v"(hi_));
            selm[g] = ((unsigned long long)hi2 << 32) | lo2; } }
    const int jlo = (MODE == 2) ? 0 : (c - W / 64 > 0 ? c - W / 64 : 0);
    fb::Stage sg; fb::stage_load(sg, Kbh, Vbh, SEQ, jlo * 64, tid); fb::stage_store(sg, lds, 0, tid);
    LDS_WAIT(); __syncthreads();
    for (int j = jlo; j <= c; ++j) {
        const int buf = (j - jlo) & 1;
        const bool em = (j == c) || (MODE != 2 && j == c - W / 64);
        if (MODE == 0) {
          if (j < c) fb::stage_load(sg, Kbh, Vbh, SEQ, (j + 1) * 64, tid);
#pragma unroll
          for (int g = 0; g < 2; ++g) { const int t = q0 + 32 * g + r32;
              fb::block_step(st[g], lds, buf, r32, qpark + g * 4096, j * 64, hi, true, em, t - W + 1, t);
              __builtin_amdgcn_sched_barrier(0); }
        } else { const int t0 = q0 + r32, t1 = t0 + 32;
          const bool sel0 = (MODE == 2) ? (bool)((selm[0] >> j) & 1ull) : true, sel1 = (MODE == 2) ? (bool)((selm[1] >> j) & 1ull) : true;
          fa::f32x16 pa0, pa1, pb0, pb1;
          fb::qk2(pa0, pa1, pb0, pb1, lds, buf, r32, qpark, hi);
          __builtin_amdgcn_sched_barrier(0);
          if (j < c) fb::stage_load(sg, Kbh, Vbh, SEQ, (j + 1) * 64, tid);
          fb::sp2(st[0], st[1], pa0, pa1, pb0, pb1, lds, buf, r32, j * 64, hi, sel0, sel1, em, (MODE == 2) ? 0 : t0 - W + 1, t0, (MODE == 2) ? 0 : t1 - W + 1, t1);
          __builtin_amdgcn_sched_barrier(0); }
        if (j < c) fb::stage_store(sg, lds, buf ^ 1, tid);
        LDS_WAIT(); __syncthreads();
    }
#pragma unroll
    for (int g = 0; g < 2; ++g) { const size_t row = (size_t)b * SEQ + q0 + 32 * g + r32; const float inv = fb::finish(st[g]);
        if (MODE != 2) { fa::State so; so.o0 = st[g].o0; so.o1 = st[g].o1; fa::store_o(so, inv, OUT + row * DM + head * 64, hi); }
        else {
            const float* gates = (const float*)(ws + WS_GATES) + row * 96 + head * 3; const float g0 = gates[0], g1 = gates[1] * inv, g2 = gates[2];
            const bf16* oc = (const bf16*)(ws + WS_OCMP) + row * DM + head * 64; const bf16* ow = (const bf16*)(ws + WS_OWIN) + row * DM + head * 64; bf16* od = OUT + row * DM + head * 64;
#pragma unroll
            for (int gg = 0; gg < 4; ++gg)
#pragma unroll
                for (int db = 0; db < 2; ++db) { const int d = 32 * db + 8 * gg + 4 * hi; const u32x2g cc = *(const u32x2g*)(oc + d), w = *(const u32x2g*)(ow + d);
                    const fa::f32x16& oo = db ? st[g].o1 : st[g].o0;
                    const float v0 = g0 * fa::bflo(cc.x) + g1 * oo[4 * gg] + g2 * fa::bflo(w.x), v1 = g0 * fa::bfhi(cc.x) + g1 * oo[4 * gg + 1] + g2 * fa::bfhi(w.x);
                    const float v2 = g0 * fa::bflo(cc.y) + g1 * oo[4 * gg + 2] + g2 * fa::bflo(w.y), v3 = g0 * fa::bfhi(cc.y) + g1 * oo[4 * gg + 3] + g2 * fa::bfhi(w.y);
                    u32x2g o; o.x = fa::cvtpk(v0, v1); o.y = fa::cvtpk(v2, v3); *(u32x2g*)(od + d) = o; }
        }
    }
}
template <int MODE, int W>
__device__ __forceinline__ void phase_attn64(unsigned char* ws, LAS unsigned char* lds, int vcu, int tid, int wave, int lane, const bf16* Q, const bf16* K, const bf16* VT, bf16* OUT, const float* sinks) {
    const int bh = (vcu >> 5) & 7, x = vcu & 31;
#pragma unroll 1
    for (int i = 0; i < 2; ++i) attn64_unit<MODE, W>(ws, lds, bh >> 2, bh & 3, i ? 63 - x : x, tid, wave, lane, Q, K, VT, OUT, sinks);
}
__device__ __forceinline__ int mk_lane() { int l; asm volatile("v_mbcnt_lo_u32_b32 %0, -1, 0\n\tv_mbcnt_hi_u32_b32 %0, -1, %0" : "=v"(l)); return l; }
typedef const void* const __attribute__((address_space(4))) * karg_ptr_t;
__device__ __forceinline__ void load_in(In& I) {
    karg_ptr_t ap = (karg_ptr_t)__builtin_amdgcn_kernarg_segment_ptr(); asm volatile("" : "+s"(ap));
#define GP(T, k) ((const T*)(const GAS T*)(unsigned long long)ap[k])
    I.x = GP(float, 0); I.c = GP(float, 1); I.positions = GP(int, 2); I.w_ada = GP(float, 3); I.b_ada = GP(float, 4);
    I.swa_w_qkv = GP(float, 5); I.swa_b_qkv = GP(float, 6); I.swa_sinks = GP(float, 7); I.swa_w_o = GP(float, 8);
    I.nsa_w_in = GP(float, 9); I.nsa_pe_k = GP(float, 10); I.nsa_pe_v = GP(float, 11); I.nsa_phi_k1 = GP(float, 12); I.nsa_phi_k2 = GP(float, 13);
    I.nsa_phi_v1 = GP(float, 14); I.nsa_phi_v2 = GP(float, 15); I.nsa_w_o = GP(float, 16);
    I.moe_w_group = GP(float, 17); I.moe_b_group = GP(float, 18); I.moe_w_router = GP(float, 19); I.moe_b_router = GP(float, 20);
    I.moe_w1 = GP(float, 21); I.moe_w3 = GP(float, 22); I.moe_w2 = GP(float, 23);
    I.ln_t_g = GP(float, 24); I.ln_t_b = GP(float, 25); I.ln_c_g = GP(float, 26); I.ln_c_b = GP(float, 27);
#undef GP
}
struct Args { const void* in[28]; float* out; unsigned char* ws; int ph_lo, ph_hi, li, pad; };
__global__ void __launch_bounds__(NWAVES * 64, 2) hyb_fwd(Args args) {
    extern __shared__ __attribute__((aligned(16))) unsigned char lds_raw[];
    LAS unsigned char* lds = (LAS unsigned char*)lds_raw;
    volatile LAS unsigned* MISC = (volatile LAS unsigned*)(lds + MISC_OFF);
    const int wave_s = __builtin_amdgcn_readfirstlane((int)threadIdx.x >> 6);
#define MK_TID() (wave_s * 64 + mk_lane())
    const int G0 = gridDim.x, bx0 = blockIdx.x; const int vcu0 = (G0 % 8 == 0) ? (bx0 % 8) * (G0 / 8) + bx0 / 8 : bx0;
    unsigned char* const ws0 = args.ws; gu32* ctl = (gu32*)(ws0 + WS_CTL);
    for (int u = MK_TID(); u < (LDS_BYTES - LDSCTL_OFF) / 4; u += NWAVES * 64) ((LAS unsigned*)(lds + LDSCTL_OFF))[u] = 0u;
    __syncthreads();
    XcdBarrier bar; bar.bar = (unsigned*)(ctl + CW_BAR); bar.x = 0; bar.st = nullptr;
    if (N_LAUNCHES == 1) bar = xcd_barrier_post((unsigned*)(ctl + CW_BAR), MISC + 8, MK_TID());
#if MK_N_LAUNCHES == 1
    constexpr int lo = 0, hi = NPHASE;
#else
    const int lo = args.ph_lo, hi = args.ph_hi;
#endif
    float* const out0 = args.out;
    if (lo == 0) { In I; load_in(I); rope_table(I.positions, (float*)(ws0 + WS_ROPE), vcu0 * (NWAVES * 64) + MK_TID(), G0 * NWAVES * 64); }
#ifdef FULL_TWICE
#pragma unroll 1
    for (int pass_ = 0; pass_ < 2; ++pass_) {
    if (pass_) { XcdBarrier b3 = bar; asm volatile("" : "+s"(b3.bar)); xcd_barrier(b3, MK_TID()); }
#endif
#pragma unroll 1
    for (int ph = lo; ph < hi; ++ph) {
        if (ph == 6 || ph == 17) continue;
#ifdef DOUBLE_MASK
        const int nrep = ((DOUBLE_MASK >> ph) & 1) ? 2 : 1;
#else
        const int nrep = 1;
#endif
#pragma unroll 1
        for (int rep = 0; rep < nrep; ++rep) {
        if (rep) __syncthreads();
        unsigned long long wsi = (unsigned long long)ws0, outi = (unsigned long long)out0; int G = G0, bx = bx0, vcu = vcu0; int phx = ph;
        int tid = MK_TID();
        asm volatile("" : "+s"(wsi), "+s"(G), "+s"(bx), "+s"(vcu), "+s"(outi), "+s"(phx), "+v"(tid));
        unsigned char* ws = (unsigned char*)(GAS unsigned char*)wsi; float* outp = (float*)(GAS float*)outi;
#ifdef ONLYP
        phx = ONLYP;
#endif
        const int lane = tid & 63, wave = __builtin_amdgcn_readfirstlane(tid >> 6);
#if defined(FULL_TWICE) && defined(SKIP2_MASK)
        if (pass_ == 1 && ((SKIP2_MASK >> ph) & 1)) phx = 99;
#endif
#if defined(FULL_TWICE) && defined(ABLATE)
        const int ablate_ = pass_ == 1 ? ABLATE : 0;
#else
        const int ablate_ = 0;
#endif
        const int gw = vcu * NWAVES + wave, NGW = G * NWAVES;
        const int layer = phx >= 10 ? 1 : 0, cp = phx - (layer ? 15 : 4);
        switch (phx) {
        case 0: {
            In I; load_in(I); phase_mod_partial(I.c, I.w_ada, (float*)(ws + WS_MODP), (LAS float*)(lds + wave * 16384), gw, NGW, lane);
        } break;
        case 1: {
            In I; load_in(I); phase_prologue(I, ws, lds, tid, lane, wave, vcu, G);
        } break;
        case 2: {
            In I; load_in(I); pg8::Gemm g{(const bf16*)(ws + WS_H), (const bf16*)(ws + WS_WQKV), NTOK, 2560, DM}; pg8::StaticOrder S; S.init(NTOK, 2560, G, bx);
            pg8::EpiQKV E{(bf16*)(ws + WS_Q), (bf16*)(ws + WS_K0), (bf16*)(ws + WS_VT0), I.swa_b_qkv, (const float*)(ws + WS_ROPE), QSCALE};
            pg8::gemm_phase<pg8::EpiQKV, pg8::StaticOrder, true, true>(lds + RING_OFF, g, S, E, tid);
            conv_fill(I, ws, lds, 0, G, tid, wave, lane);
        } break;
        case 3: {
            In I; load_in(I); conv_drain(I, ws, lds, CV_B, tid, wave, lane); phase_attn64<0, 128>(ws, lds, vcu, tid, wave, lane, (const bf16*)(ws + WS_Q), (const bf16*)(ws + WS_K0), (const bf16*)(ws + WS_VT0), (bf16*)(ws + WS_ATT), I.swa_sinks);
        } break;
        case 10: {
            In I; load_in(I); pg8::Gemm g{(const bf16*)(ws + WS_H), (const bf16*)(ws + WS_WIN), NTOK, 3840, DM}; pg8::StaticOrder S; S.init(NTOK, 3840, G, bx);
            pg8::EpiNSA E{(bf16*)(ws + WS_QRAW), (bf16*)(ws + WS_Q), (bf16*)(ws + WS_KC), (bf16*)(ws + WS_VC), (bf16*)(ws + WS_KS), (bf16*)(ws + WS_VST), (bf16*)(ws + WS_KW), (bf16*)(ws + WS_VWT), (float*)(ws + WS_GATES), (const float*)(ws + WS_ROPE), QSCALE, ablate_};
            pg8::gemm_phase<pg8::EpiNSA, pg8::StaticOrder, true, true>(lds + RING_OFF, g, S, E, tid);
            conv_fill(I, ws, lds, 3, G, tid, wave, lane);
        } break;
        case 11: {
#pragma unroll 1
            for (int which = 0; which < 2; ++which) {
                pg8::Gemm g{(const bf16*)(ws + (which ? WS_VC : WS_KC)), (const bf16*)(ws + (which ? WS_PHIV : WS_PHIK)), 2048, 512, 1024}; pg8::StaticOrder S; S.init(2048, 512, G, which ? (bx + G - 16) % G : bx);
                pg8::EpiF32 E{(float*)(ws + (which ? WS_ULV : WS_ULK)), 512};
                pg8::gemm_phase<pg8::EpiF32, pg8::StaticOrder, false, true>(lds + RING_OFF, g, S, E, tid); }
            phase_attn64<1, 512>(ws, lds, vcu, tid, wave, lane, (const bf16*)(ws + WS_Q), (const bf16*)(ws + WS_KW), (const bf16*)(ws + WS_VWT), (bf16*)(ws + WS_OWIN), nullptr);
        } break;
        case 12: {
            In I; load_in(I); conv_drain(I, ws, lds, CV_D - 16 * 512, tid, wave, lane); phase_cmp2(I, ws, lds, gw, NGW, lane, tid, wave);
        } break;
        case 13: {
            { const int bh = (vcu >> 5) & 7;
              const bf16* kc = (const bf16*)(ws + WS_KCMP) + (size_t)bh * 256 * 64;
              for (int i = tid; i < 256 * 8; i += NWAVES * 64) { const int r = i >> 3, ch = i & 7; *(LAS v4u*)(lds + CMP_K + r * 144 + ch * 16) = *(const GAS v4u*)(kc + (size_t)r * 64 + ch * 8); }
              const bf16* vc = (const bf16*)(ws + WS_VCMPT) + (size_t)bh * 64 * 256;
              for (int i = tid; i < 64 * 32; i += NWAVES * 64) { const int r = i >> 5, ch = i & 31; *(LAS v4u*)(lds + CMP_V + r * CMP_VP + ch * 16) = *(const GAS v4u*)(vc + (size_t)r * 256 + ch * 8); }
              LDS_WAIT(); __syncthreads(); }
            for (int u = vcu; u < 1024; u += G) cmp_unit(ws, lds, (u >> 7) & 1, (u >> 5) & 3, ((u >> 8) << 5) | (u & 31), tid, wave, lane);
        } break;
        case 14: {
            phase_attn64<2, 0>(ws, lds, vcu, tid, wave, lane, (const bf16*)(ws + WS_Q), (const bf16*)(ws + WS_KS), (const bf16*)(ws + WS_VST), (bf16*)(ws + WS_ATT), nullptr);
        } break;
        default: switch (cp) {
        case 0: {
            In I; load_in(I); pg8::Gemm g{(const bf16*)(ws + WS_ATT), (const bf16*)(ws + (layer ? WS_WO1 : WS_WO0)), NTOK, DM, DM}; pg8::StaticOrder S; S.init(NTOK, DM, G, bx);
            pg8::EpiWoRes E{layer ? nullptr : I.x, (const bf16*)(ws + WS_XB), (const float*)(ws + WS_MOD) + (size_t)layer * 2 * 12288 + 4096, 12288, (bf16*)(ws + WS_Y), ALPHA_RES};
            pg8::gemm_phase<pg8::EpiWoRes, pg8::StaticOrder, true, true>(lds + RING_OFF, g, S, E, tid);
        } break;
        case 1: {
            In I; load_in(I); phase_lnt2(I, ws, lds, (LAS int*)(lds + 131072 + 1024), layer, (const bf16*)(ws + WS_Y), gw, lane, tid, wave, vcu);
        } break;
        case 2: {
        } break;
        case 3: {
            Seg sg; seg_load(sg, (const unsigned*)(ws + WS_CTL) + CW_CNT + layer * 16 * CW_CNT_STRIDE); pg8::GroupOrder S; build_units(S, sg, 4, G, bx);
            pg8::Gemm g{(const bf16*)(ws + WS_H), (const bf16*)(ws + WS_W13) + (size_t)layer * 16 * 1024 * 2048, NTOK, 0, DM, (const int*)(ws + WS_ROWSRC)}; pg8::EpiUp E{(bf16*)(ws + WS_HE)};
            pg8::gemm_phase<pg8::EpiUp, pg8::GroupOrder, true, true, true>(lds + RING_OFF, g, S, E, tid);
            { In I; load_in(I); conv_fill(I, ws, lds, 1 + 3 * layer, G, tid, wave, lane); if (layer) conv_drain(I, ws, lds, CV_D, tid, wave, lane); }
        } break;
        case 4: {
            Seg sg; seg_load(sg, (const unsigned*)(ws + WS_CTL) + CW_CNT + layer * 16 * CW_CNT_STRIDE); pg8::GroupOrder S; build_units(S, sg, 8, G, bx);
            pg8::Gemm g{(const bf16*)(ws + WS_HE), (const bf16*)(ws + WS_W2) + (size_t)layer * 16 * 2048 * 512, 0, 0, DEXP}; pg8::EpiDown E{(bf16*)(ws + WS_YS), (const int*)(ws + WS_ROWTOK), (const float*)(ws + WS_ROWW)};
            pg8::gemm_phase<pg8::EpiDown, pg8::GroupOrder, true, true>(lds + RING_OFF, g, S, E, tid);
            { In I; load_in(I); conv_fill(I, ws, lds, 2 + 3 * layer, G, tid, wave, lane); }
        } break;
        case 5: {
            In I; load_in(I); if (layer == 0) conv_drain(I, ws, lds, CV_C, tid, wave, lane);
            for (int rb = gw; rb < NTOK / 4; rb += NGW) phase_lnc(I, ws, layer, outp, (bf16*)(ws + WS_XB), layer == 0, rb, lane);
        } break;
        default: break; }
        break; }
        }
        if (ph + 1 < hi) { XcdBarrier b2 = bar; asm volatile("" : "+s"(b2.bar)); xcd_barrier(b2, MK_TID()); }
    }
#ifdef FULL_TWICE
    }
#endif
}

extern "C" void kernel_launch(void* const* d_in, const int* in_sizes, int n_in, void* d_out, int out_size, void* d_ws, size_t ws_size, hipStream_t stream) {
    static int grid = 0;
    if (grid == 0) {
        if (n_in != 28 || in_sizes[0] != NTOK * DM || out_size != NTOK * DM || ws_size < WS_END) { fprintf(stderr, "kernel_launch: built for 28 inputs, x/out of %d floats, >= %zu bytes of workspace; got n_in %d, in0 %d, out %d, ws %zu; nothing launched\n", NTOK * DM, (size_t)WS_END, n_in, n_in > 0 ? in_sizes[0] : -1, out_size, ws_size); grid = -1; return; }
        int dev = 0, cus = 0, per_cu = 0;
        if (hipGetDevice(&dev) != hipSuccess || hipDeviceGetAttribute(&cus, hipDeviceAttributeMultiprocessorCount, dev) != hipSuccess) { fprintf(stderr, "kernel_launch: device query failed\n"); grid = -1; return; }
        if (hipFuncSetAttribute((const void*)hyb_fwd, hipFuncAttributeMaxDynamicSharedMemorySize, LDS_BYTES) != hipSuccess) { fprintf(stderr, "kernel_launch: hipFuncSetAttribute failed\n"); grid = -1; return; }
        if (hipOccupancyMaxActiveBlocksPerMultiprocessor(&per_cu, (const void*)hyb_fwd, NWAVES * 64, LDS_BYTES) != hipSuccess || per_cu < 1) { fprintf(stderr, "kernel_launch: occupancy query reports %d workgroups per CU\n", per_cu); }
        (void)hipGetLastError();
        grid = cus;
        if (grid != 256) { fprintf(stderr, "kernel_launch: %d CUs; this kernel is built for exactly 256 workgroups; nothing launched\n", grid); grid = -1; return; }
    }
    if (grid < 0) return;
    if (hipMemsetAsync((char*)d_ws + WS_CTL, 0, CTL_ZERO_BYTES, stream) != hipSuccess) { fprintf(stderr, "kernel_launch: memset failed\n"); return; }
    Args a{};
    for (int i = 0; i < 28; ++i) a.in[i] = d_in[i];
    a.out = (float*)d_out; a.ws = (unsigned char*)d_ws;
    for (int li = 0; li < N_LAUNCHES; ++li) {
        if (N_LAUNCHES == 1) { a.ph_lo = 0; a.ph_hi = NPHASE; } else { a.ph_lo = li; a.ph_hi = li + 1; }
        a.li = li;
        hipLaunchKernelGGL(hyb_fwd, dim3(grid), dim3(NWAVES * 64), LDS_BYTES, stream, a);
        const hipError_t le = hipPeekAtLastError();
        if (le != hipSuccess) { fprintf(stderr, "kernel_launch: launch %d failed: %s\n", li, hipGetErrorName(le)); break; }
    }
}
```

```cpp
#include <hip/hip_runtime.h>
#include <hip/hip_bf16.h>
#include <cstdio>
#include <cstdint>
#include <cmath>
namespace pg8 {
#define PG8_LAS __attribute__((address_space(3)))
typedef unsigned short bf16_t;
typedef short bf16x8 __attribute__((ext_vector_type(8)));
typedef float f32x4 __attribute__((ext_vector_type(4)));
typedef unsigned u32x4 __attribute__((ext_vector_type(4)));
constexpr int BM = 256, BK = 64, HALF = 128, HTB = HALF * BK * 2  , STAGE_BYTES = 8 * HTB, NXCD = 8, WGM = 8;

__host__ __device__ __forceinline__ int lds_byte(int r, int c) { const int st = (r >> 4) * 2 + (c >> 5), rr = r & 15, cc = c & 31, ob = rr * 64 + cc * 2; return st * 1024 + (ob ^ (((ob >> 9) & 1) << 5)); }
__host__ __device__ __forceinline__ void stage_rc(int b, int& R, int& C) { const int st = b / 1024, sb = b % 1024, swz = sb ^ (((sb >> 9) & 1) << 5); R = (st >> 1) * 16 + swz / 64; C = (st & 1) * 32 + (swz % 64) / 2; }
__host__ __device__ __forceinline__ int perm32(int rho) { const int n = rho >> 4, i = rho & 15; return 8 * (i >> 2) + 4 * n + (i & 3); }

struct Unit { int pm, pn, pnl, nvalid; };
struct Gemm { const bf16_t* A; const bf16_t* Bt; int M, N, K; const int* rowmap; };

struct StaticOrder {
    int nM, nN, nwg, G, c;
    __host__ __device__ void init(int M, int N, int G_, int c_) { nM = M / BM; nN = N / BM; nwg = nM * nN; G = G_; c = c_; }
    __host__ __device__ bool next(int i, Unit& u) const {
        const long L = (long)i * G + c; if (L >= nwg) return false;
        int wgid = (int)L; { const int q = nwg / NXCD, r = nwg % NXCD, xcd = wgid % NXCD, off = wgid / NXCD; wgid = (xcd < r ? xcd * (q + 1) : r * (q + 1) + (xcd - r) * q) + off; }
        const int nig = WGM * nN, gid = wgid / nig, fm = gid * WGM, gsz = (nM - fm) < WGM ? (nM - fm) : WGM;
        u.pm = fm + ((wgid % nig) % gsz); u.pn = (wgid % nig) / gsz; return true;
    }
    __device__ __forceinline__ void a_ready(const Unit&) const {}
    __device__ __forceinline__ void done(const Unit&) const {}
};
__device__ __forceinline__ unsigned cvt_pk_bf16(float lo, float hi) { unsigned r; asm volatile("v_cvt_pk_bf16_f32 %0, %1, %2" : "=v"(r) : "v"(lo), "v"(hi)); return r; }
typedef float f32x2 __attribute__((ext_vector_type(2)));
typedef unsigned u32x2 __attribute__((ext_vector_type(2)));
__device__ __forceinline__ float silu_f(float a) { return a * __builtin_amdgcn_rcpf(1.0f + __builtin_amdgcn_exp2f(-1.4426950408889634f * a)); }
__device__ __forceinline__ float sigmoid_f(float a) { return __builtin_amdgcn_rcpf(1.0f + __builtin_amdgcn_exp2f(-1.4426950408889634f * a)); }
__device__ __forceinline__ u32x4 pack8(const f32x4& a, const f32x4& b) { u32x4 w; w.x = cvt_pk_bf16(a[0], a[1]); w.y = cvt_pk_bf16(a[2], a[3]); w.z = cvt_pk_bf16(b[0], b[1]); w.w = cvt_pk_bf16(b[2], b[3]); return w; }
__device__ __forceinline__ unsigned short bf1(float v) { return (unsigned short)(cvt_pk_bf16(v, 0.f) & 0xffffu); }

__device__ __forceinline__ void rope8(f32x4& v0, f32x4& v1, const f32x4 (&cs)[4], int fq) {
    f32x4 p0, p1;
#pragma unroll
    for (int i = 0; i < 4; ++i) { p0[i] = __shfl_xor(v0[i], 16); p1[i] = __shfl_xor(v1[i], 16); }
    if (fq < 2) { const float sg = fq == 0 ? -1.f : 1.f; v0 = v0 * cs[0] + (p0 * cs[2]) * sg; v1 = v1 * cs[1] + (p1 * cs[3]) * sg; }
}
__device__ __forceinline__ void rope_ld(f32x4 (&cs)[4], const float* ropeRow, bool want) {
    if (want) { cs[0] = *(const f32x4*)(ropeRow); cs[1] = *(const f32x4*)(ropeRow + 4); cs[2] = *(const f32x4*)(ropeRow + 8); cs[3] = *(const f32x4*)(ropeRow + 12); }
}
__device__ __forceinline__ void store_vt8(bf16_t* VT, int b, int hk, int d0, int s, const f32x4& v0, const f32x4& v1) {
    bf16_t* p = VT + ((size_t)((b * 4 + hk) * 64 + d0)) * 4096 + s;
#pragma unroll
    for (int i = 0; i < 4; ++i) { p[(size_t)i * 4096] = bf1(v0[i]); p[(size_t)(i + 4) * 4096] = bf1(v1[i]); }
}

struct EpiQKV {
    static constexpr bool PERM = true, AFTER_DRAIN = false;
    bf16_t* Q; bf16_t* K; bf16_t* VT; const float* bias; const float* rope; float qscale;
    __device__ __forceinline__ void operator()(const f32x4 (&acc)[2][2][4][2], const Unit& u, int wr, int wc, int fr, int fq) const {
        const int pn = u.pn; const bool rot = (pn <= 8) && ((wc & 1) == 0);
        f32x4 bv[2][2];
#pragma unroll
        for (int bj = 0; bj < 2; ++bj)
#pragma unroll
            for (int n = 0; n < 2; ++n) bv[bj][n] = *(const f32x4*)(bias + pn * BM + bj * HALF + wc * 32 + 8 * fq + 4 * n);
        const bool wantr = rot && fq < 2; const int rowb = u.pm * BM + wr * 64 + fr;
        f32x4 cs[4] = {}; rope_ld(cs, rope + (size_t)rowb * 16, wantr);
#pragma unroll
        for (int ai = 0; ai < 2; ++ai)
#pragma unroll
            for (int m = 0; m < 4; ++m) {
                const int row = rowb + ai * HALF + m * 16, b = row >> 12, s = row & 4095;
                f32x4 w0[2], w1[2];
#pragma unroll
                for (int bj = 0; bj < 2; ++bj) { w0[bj] = acc[ai][bj][m][0] + bv[bj][0]; w1[bj] = acc[ai][bj][m][1] + bv[bj][1]; if (rot) rope8(w0[bj], w1[bj], cs, fq); }
                if (ai * 4 + m < 7) { const int nx = ai * 4 + m + 1; rope_ld(cs, rope + (size_t)(rowb + (nx >> 2) * HALF + (nx & 3) * 16) * 16, wantr); }
#pragma unroll
                for (int bj = 0; bj < 2; ++bj) {
                    const int col = bj * HALF + wc * 32 + 8 * fq;
                    f32x4 v0 = w0[bj], v1 = w1[bj];
                    if (pn < 8) { v0 = v0 * qscale; v1 = v1 * qscale; *(u32x4*)(Q + (size_t)row * 2048 + pn * BM + col) = pack8(v0, v1); }
                    else if (pn == 8) { *(u32x4*)(K + ((size_t)((b * 4 + (col >> 6)) * 4096 + s)) * 64 + (col & 63)) = pack8(v0, v1); }
                    else store_vt8(VT, b, col >> 6, col & 63, s, v0, v1);
                }
            }
    }
};
struct EpiNSA {
    static constexpr bool PERM = true, AFTER_DRAIN = false;
    bf16_t *QRAW, *QROT, *KC, *VC, *KS, *VST, *KW, *VWT; float* GATES; const float* rope; float qscale; int ablate;
    __device__ __forceinline__ void operator()(const f32x4 (&acc)[2][2][4][2], const Unit& u, int wr, int wc, int fr, int fq) const {
        if (ablate & 2) return;
        const int pn = u.pn; const bool rot = (pn < 8 || pn == 10 || pn == 12) && ((wc & 1) == 0);
        const bool wantr = rot && fq < 2; const int rowb = u.pm * BM + wr * 64 + fr;
        f32x4 cs[4] = {}; rope_ld(cs, rope + (size_t)rowb * 16, wantr);
#pragma unroll
        for (int ai = 0; ai < 2; ++ai)
#pragma unroll
            for (int m = 0; m < 4; ++m) {
                const int row = rowb + ai * HALF + m * 16, b = row >> 12, s = row & 4095;
                f32x4 w0[2], w1[2];
#pragma unroll
                for (int bj = 0; bj < 2; ++bj) { w0[bj] = acc[ai][bj][m][0]; w1[bj] = acc[ai][bj][m][1]; if (rot) rope8(w0[bj], w1[bj], cs, fq); }
                if (ai * 4 + m < 7) { const int nx = ai * 4 + m + 1; rope_ld(cs, rope + (size_t)(rowb + (nx >> 2) * HALF + (nx & 3) * 16) * 16, wantr); }
#pragma unroll
                for (int bj = 0; bj < 2; ++bj) {
                    const int col = bj * HALF + wc * 32 + 8 * fq;
                    f32x4 v0 = w0[bj], v1 = w1[bj];
                    if (pn < 8) { *(u32x4*)(QROT + (size_t)row * 2048 + pn * BM + col) = pack8(v0 * qscale, v1 * qscale); }
                    else if (pn == 8 || pn == 9 || pn == 10 || pn == 12) {
                        bf16_t* dst = pn == 8 ? KC : pn == 9 ? VC : pn == 10 ? KS : KW;
                        *(u32x4*)(dst + ((size_t)((b * 4 + (col >> 6)) * 4096 + s)) * 64 + (col & 63)) = pack8(v0, v1); }
                    else if ((pn == 11 || pn == 13) && (ablate & 1)) {}
                    else if (pn == 11 || pn == 13) store_vt8(pn == 11 ? VST : VWT, b, col >> 6, col & 63, s, v0, v1);
                    else if (col < 96) {
                        f32x4 g0, g1;
#pragma unroll
                        for (int i = 0; i < 4; ++i) { g0[i] = sigmoid_f(v0[i]); g1[i] = sigmoid_f(v1[i]); }
                        *(f32x4*)(GATES + (size_t)row * 96 + col) = g0; *(f32x4*)(GATES + (size_t)row * 96 + col + 4) = g1; }
                }
            }
    }
};
__device__ __forceinline__ float bf_lo(unsigned w) { return __uint_as_float(w << 16); }
__device__ __forceinline__ float bf_hi(unsigned w) { return __uint_as_float(w & 0xffff0000u); }
struct EpiWoRes {
    static constexpr bool PERM = true, AFTER_DRAIN = false;
    const float* x32; const bf16_t* x16; const float* gate; int gstride; bf16_t* Y; float alpha;
    __device__ __forceinline__ void operator()(const f32x4 (&acc)[2][2][4][2], const Unit& u, int wr, int wc, int fr, int fq) const {
        const int b = (u.pm * BM) >> 12; const int col0 = u.pn * BM + wc * 32 + 8 * fq;
        f32x4 gv[2][2];
#pragma unroll
        for (int bj = 0; bj < 2; ++bj)
#pragma unroll
            for (int n = 0; n < 2; ++n) gv[bj][n] = *(const f32x4*)(gate + (size_t)b * gstride + col0 + bj * HALF + n * 4);
#pragma unroll
        for (int ai = 0; ai < 2; ++ai)
#pragma unroll
            for (int m = 0; m < 4; ++m) { const size_t off = (size_t)(u.pm * BM + ai * HALF + wr * 64 + m * 16 + fr) * 2048 + col0;
#pragma unroll
                for (int bj = 0; bj < 2; ++bj) { f32x4 x0, x1;
                    if (x32) { x0 = *(const f32x4*)(x32 + off + bj * HALF); x1 = *(const f32x4*)(x32 + off + bj * HALF + 4); }
                    else { const u32x4 w = *(const u32x4*)(x16 + off + bj * HALF); x0 = (f32x4){bf_lo(w.x), bf_hi(w.x), bf_lo(w.y), bf_hi(w.y)}; x1 = (f32x4){bf_lo(w.z), bf_hi(w.z), bf_lo(w.w), bf_hi(w.w)}; }
                    *(u32x4*)(Y + off + bj * HALF) = pack8(x0 * alpha + gv[bj][0] * acc[ai][bj][m][0], x1 * alpha + gv[bj][1] * acc[ai][bj][m][1]); }
                if (m & 1) asm volatile("" ::: "memory"); }
    }
};
struct EpiF32 {
    static constexpr bool PERM = false, AFTER_DRAIN = false;
    float* O; int ldc;
    __device__ __forceinline__ void operator()(const f32x4 (&acc)[2][2][4][2], const Unit& u, int wr, int wc, int fr, int fq) const {
        const int col0 = u.pn * BM + wc * 32 + 4 * fq;
#pragma unroll
        for (int ai = 0; ai < 2; ++ai)
#pragma unroll
            for (int m = 0; m < 4; ++m) { const size_t off = (size_t)(u.pm * BM + ai * HALF + wr * 64 + m * 16 + fr) * ldc + col0;
#pragma unroll
                for (int bj = 0; bj < 2; ++bj)
#pragma unroll
                    for (int n = 0; n < 2; ++n) *(f32x4*)(O + off + bj * HALF + n * 16) = acc[ai][bj][m][n]; }
    }
};
struct EpiUp {
    static constexpr bool PERM = true, AFTER_DRAIN = false;
    bf16_t* HE;
    __device__ __forceinline__ void operator()(const f32x4 (&acc)[2][2][4][2], const Unit& u, int wr, int wc, int fr, int fq) const {
#pragma unroll
        for (int ai = 0; ai < 2; ++ai)
#pragma unroll
            for (int m = 0; m < 4; ++m) { const int row = u.pm * BM + ai * HALF + wr * 64 + m * 16 + fr; f32x4 h[2];
#pragma unroll
                for (int n = 0; n < 2; ++n)
#pragma unroll
                    for (int i = 0; i < 4; ++i) h[n][i] = silu_f(acc[ai][0][m][n][i]) * acc[ai][1][m][n][i];
                *(u32x4*)(HE + (size_t)row * 512 + u.pnl * HALF + wc * 32 + 8 * fq) = pack8(h[0], h[1]); }
    }
};
struct EpiDown {
    static constexpr bool PERM = true, AFTER_DRAIN = false;
    bf16_t* YS; const int* rowtok; const float* roww;
    __device__ __forceinline__ void operator()(const f32x4 (&acc)[2][2][4][2], const Unit& u, int wr, int wc, int fr, int fq) const {
#pragma unroll
        for (int ai = 0; ai < 2; ++ai)
#pragma unroll
            for (int m = 0; m < 4; ++m) { const int lrow = ai * HALF + wr * 64 + m * 16 + fr;
                if (lrow < u.nvalid) { const int grow = u.pm * BM + lrow; const int tk = rowtok[grow]; const float w = roww[grow];
#pragma unroll
                    for (int bj = 0; bj < 2; ++bj)
                        *(u32x4*)(YS + (size_t)tk * 2048 + u.pnl * BM + bj * HALF + wc * 32 + 8 * fq) = pack8(acc[ai][bj][m][0] * w, acc[ai][bj][m][1] * w); } }
    }
};
constexpr int SEG_TILES = 32;
struct GroupOrder {
    unsigned cnt[16]; int nT, nN, G, c;
    __device__ __forceinline__ bool next(int i, Unit& u) const {
        const int nwg = nT * nN, L = i * G + c; if (L >= nwg) return false;
        const int q = nwg / 8, r = nwg % 8, xcd = L % 8, off = L / 8; const int wgid = (xcd < r ? xcd * (q + 1) : r * (q + 1) + (xcd - r) * q) + off;
        const int pm = wgid / nN, pnl = wgid % nN; int run = 0, ee = 0, nv = 0;
        int loc = 0;
#pragma unroll
        for (int e = 0; e < 16; ++e) { const int te = (int)((cnt[e] + 255u) >> 8); if (pm >= run && pm < run + te) { ee = e; loc = pm - run; const int left = (int)cnt[e] - (pm - run) * 256; nv = left < 256 ? left : 256; } run += te; }
        u.pm = ee * SEG_TILES + loc; u.pn = ee * nN + pnl; u.pnl = pnl; u.nvalid = nv; return true;
    }
    __device__ __forceinline__ void a_ready(const Unit&) const {}
    __device__ __forceinline__ void done(const Unit&) const {}
};
template <class Epi, class Sched, bool ALIGN_EPI = false, bool SP2 = false, bool GATHER = false>
__device__ __forceinline__ void gemm_phase(PG8_LAS unsigned char* lds, const Gemm g, const Sched& S, const Epi& E, int tid_in) {
    int tid_ = tid_in; asm volatile("" : "+v"(tid_)); const int tid = tid_, wid = __builtin_amdgcn_readfirstlane(tid >> 6), lane = tid & 63, wr = wid >> 2, wc = wid & 3, fr = lane & 15, fq = lane >> 4;
    const int K = g.K, nt = K / BK;
    unsigned voffA[2], voffB[2];
#pragma unroll
    for (int i = 0; i < 2; ++i) { int R, C; stage_rc(tid * 16 + i * 8192, R, C); const int Rb = Epi::PERM ? ((R & ~31) + perm32(R & 31)) : R;
        voffA[i] = (unsigned)(R * K + C) * 2u; voffB[i] = (unsigned)(Rb * K + C) * 2u; }
    static_assert(!GATHER || SP2, "GATHER is wired into the SP2 loop only");
    unsigned gc0[2] = {0u, 0u}, gc1[2] = {0u, 0u}, gn0[2] = {0u, 0u}, gn1[2] = {0u, 0u};
#define PG8_GOFF(pm_, o0, o1) do { _Pragma("unroll") for (int _i = 0; _i < 2; ++_i) { int R_, C_; stage_rc(tid * 16 + _i * 8192, R_, C_); \
        int r0_ = g.rowmap[(pm_) * BM + R_], r1_ = g.rowmap[(pm_) * BM + HALF + R_]; r0_ = (unsigned)r0_ < (unsigned)g.M ? r0_ : 0; r1_ = (unsigned)r1_ < (unsigned)g.M ? r1_ : 0;     \
        o0[_i] = (unsigned)(r0_ * K + C_) * 2u; o1[_i] = (unsigned)(r1_ * K + C_) * 2u; } } while (0)
#define PG8_STAGE_A(bufoff, base, half, nx) do { if constexpr (GATHER) { unsigned vo_[2]; \
        vo_[0] = (nx) ? ((half) ? gn1[0] : gn0[0]) : ((half) ? gc1[0] : gc0[0]); vo_[1] = (nx) ? ((half) ? gn1[1] : gn0[1]) : ((half) ? gc1[1] : gc0[1]); PG8_STAGE(bufoff, base, vo_); } \
        else { PG8_STAGE(bufoff, (base) + ((half) ? hstep : (size_t)0), voffA); } } while (0)
    const size_t kstep = (size_t)(BK * 2);
    const size_t hstep = (size_t)HALF * K * 2;
    const size_t tstep = 2 * hstep;
    const unsigned ldsw = (unsigned)wid * 1024u;
    const int aoff = lds_byte(wr * 64 + fr, fq * 8), boff = lds_byte(wc * 32 + fr, fq * 8);
#define PG8_SA(b, h) (((b) * 2 + (h)) * HTB)
#define PG8_SB(b, h) ((4 + (b) * 2 + (h)) * HTB)
#define PG8_STAGE(bufoff, gbase, voff) do { _Pragma("unroll") for (int _i = 0; _i < 2; ++_i) \
        __builtin_amdgcn_global_load_lds((const unsigned*)((const char*)(gbase) + (voff)[_i]), (PG8_LAS unsigned*)(lds + (bufoff) + ldsw + _i * 8192), 16, 0, 0); } while (0)
#define PG8_LDA(dst, b, h) do { _Pragma("unroll") for (int m = 0; m < 4; ++m) _Pragma("unroll") for (int k = 0; k < 2; ++k) dst[m][k] = *(const PG8_LAS bf16x8*)(lds + PG8_SA(b, h) + aoff + m * 2048 + k * 1024); } while (0)
#define PG8_LDB(dst, b, h) do { _Pragma("unroll") for (int n = 0; n < 2; ++n) _Pragma("unroll") for (int k = 0; k < 2; ++k) dst[n][k] = *(const PG8_LAS bf16x8*)(lds + PG8_SB(b, h) + boff + n * 2048 + k * 1024); } while (0)
#define PG8_MMA(ai, bj, At, Bt) do { __builtin_amdgcn_s_setprio(1); _Pragma("unroll") for (int m = 0; m < 4; ++m) _Pragma("unroll") for (int n = 0; n < 2; ++n) _Pragma("unroll") for (int k = 0; k < 2; ++k) \
        acc[ai][bj][m][n] = __builtin_amdgcn_mfma_f32_16x16x32_bf16(Bt[n][k], At[m][k], acc[ai][bj][m][n], 0, 0, 0); __builtin_amdgcn_s_setprio(0); } while (0)
#define PG8_WAIT_V(n) asm volatile("s_waitcnt vmcnt(" #n ")" ::: "memory")
#define PG8_WAIT_L(n) asm volatile("s_waitcnt lgkmcnt(" #n ")" ::: "memory")
#define PG8_BAR __builtin_amdgcn_s_barrier()
#define PG8_SCHED __builtin_amdgcn_sched_barrier(0)
    Unit cur, nxt; int ui = 0;
    if (!S.next(0, cur)) return;
    f32x4 acc[2][2][4][2];
#pragma unroll
    for (int a = 0; a < 2; ++a)
#pragma unroll
        for (int b = 0; b < 2; ++b)
#pragma unroll
            for (int m = 0; m < 4; ++m)
#pragma unroll
                for (int n = 0; n < 2; ++n) acc[a][b][m][n] = (f32x4){0.f, 0.f, 0.f, 0.f};
    bf16x8 At[4][2], B0[2][2], B1[2][2];
    const char* cA = (const char*)g.A + (GATHER ? (size_t)0 : (size_t)cur.pm * tstep); const char* cB = (const char*)g.Bt + (size_t)cur.pn * tstep;
    S.a_ready(cur);
    if constexpr (SP2) {
        if constexpr (GATHER) PG8_GOFF(cur.pm, gc0, gc1);
        PG8_STAGE(PG8_SB(0, 0), cB, voffB); PG8_STAGE(PG8_SB(0, 1), cB + hstep, voffB); PG8_STAGE_A(PG8_SA(0, 0), cA, 0, false); PG8_STAGE_A(PG8_SA(0, 1), cA, 1, false);
        if (wr == 1) PG8_BAR;
        PG8_WAIT_V(2); PG8_BAR;
        PG8_STAGE(PG8_SB(1, 0), cB + kstep, voffB); PG8_STAGE_A(PG8_SA(1, 0), cA + kstep, 0, false); PG8_STAGE(PG8_SB(1, 1), cB + hstep + kstep, voffB);
        PG8_WAIT_V(6); PG8_BAR;
    } else {
        PG8_STAGE(PG8_SB(0, 0), cB, voffB); PG8_STAGE(PG8_SA(0, 0), cA, voffA); PG8_STAGE(PG8_SB(0, 1), cB + hstep, voffB); PG8_STAGE(PG8_SA(0, 1), cA + hstep, voffA);
        if (wr == 1) PG8_BAR;
        PG8_WAIT_V(4); PG8_BAR;
        PG8_STAGE(PG8_SB(1, 0), cB + kstep, voffB); PG8_STAGE(PG8_SA(1, 0), cA + kstep, voffA); PG8_STAGE(PG8_SB(1, 1), cB + hstep + kstep, voffB);
        PG8_WAIT_V(6); PG8_BAR;
    }
    for (;;) {
        const bool has_next = S.next(ui + 1, nxt);
        if constexpr (GATHER) { if (has_next) PG8_GOFF(nxt.pm, gn0, gn1); else { gn0[0] = gc0[0]; gn0[1] = gc0[1]; gn1[0] = gc1[0]; gn1[1] = gc1[1]; } }
        const char* nA = GATHER ? (const char*)g.A : (has_next ? (const char*)g.A + (size_t)nxt.pm * tstep : cA); const char* nB = has_next ? (const char*)g.Bt + (size_t)nxt.pn * tstep : cB;
        for (int t = 0; t < nt; t += 2) {
            const bool last = (t == nt - 2);
            const char* a1 = cA + (size_t)(t + 1) * kstep;
            const char* a2 = last ? nA : cA + (size_t)(t + 2) * kstep; const char* b2 = last ? nB : cB + (size_t)(t + 2) * kstep;
            const char* a3 = a2 + kstep; const char* b3 = b2 + kstep;
            if (last && has_next) S.a_ready(nxt);
            if constexpr (SP2) {
            PG8_LDB(B0, 0, 0); PG8_LDB(B1, 0, 1); PG8_SCHED; PG8_LDA(At, 0, 0); PG8_STAGE_A(PG8_SA(1, 1), a1, 1, false);
            PG8_WAIT_V(8); PG8_WAIT_L(0); PG8_BAR; PG8_MMA(0, 0, At, B0); PG8_MMA(0, 1, At, B1); PG8_BAR; PG8_SCHED;
            PG8_LDA(At, 0, 1); PG8_STAGE(PG8_SB(0, 0), b2, voffB); PG8_STAGE(PG8_SB(0, 1), b2 + hstep, voffB); PG8_STAGE_A(PG8_SA(0, 0), a2, 0, last);
            PG8_WAIT_V(8); PG8_WAIT_L(0); PG8_BAR; PG8_MMA(1, 0, At, B0); PG8_MMA(1, 1, At, B1); PG8_BAR; PG8_SCHED;
            PG8_LDB(B0, 1, 0); PG8_LDB(B1, 1, 1); PG8_SCHED; PG8_LDA(At, 1, 0); PG8_STAGE_A(PG8_SA(0, 1), a2, 1, last);
            PG8_WAIT_V(8); PG8_WAIT_L(0); PG8_BAR; PG8_MMA(0, 0, At, B0); PG8_MMA(0, 1, At, B1); PG8_BAR; PG8_SCHED;
            PG8_LDA(At, 1, 1); PG8_STAGE(PG8_SB(1, 0), b3, voffB); PG8_STAGE(PG8_SB(1, 1), b3 + hstep, voffB); PG8_STAGE_A(PG8_SA(1, 0), a3, 0, last);
            PG8_WAIT_V(8); PG8_WAIT_L(0); PG8_BAR; PG8_MMA(1, 0, At, B0); PG8_MMA(1, 1, At, B1); PG8_BAR; PG8_SCHED;
            } else {
            PG8_LDB(B0, 0, 0); PG8_SCHED; PG8_LDA(At, 0, 0); PG8_STAGE(PG8_SA(1, 1), a1 + hstep, voffA);
            PG8_WAIT_L(8); PG8_BAR; PG8_WAIT_L(0); PG8_MMA(0, 0, At, B0); PG8_BAR; PG8_SCHED;
            PG8_LDB(B1, 0, 1); PG8_STAGE(PG8_SB(0, 0), b2, voffB);
            PG8_BAR; PG8_WAIT_L(0); PG8_MMA(0, 1, At, B1); PG8_BAR;
            PG8_LDA(At, 0, 1); PG8_STAGE(PG8_SA(0, 0), a2, voffA);
            PG8_BAR; PG8_WAIT_L(0); PG8_MMA(1, 0, At, B0); PG8_BAR; PG8_SCHED;
            PG8_STAGE(PG8_SB(0, 1), b2 + hstep, voffB);
            PG8_WAIT_V(6); PG8_BAR; PG8_MMA(1, 1, At, B1); PG8_BAR;
            PG8_LDB(B0, 1, 0); PG8_SCHED; PG8_LDA(At, 1, 0); PG8_STAGE(PG8_SA(0, 1), a2 + hstep, voffA);
            PG8_WAIT_L(8); PG8_BAR; PG8_WAIT_L(0); PG8_MMA(0, 0, At, B0); PG8_BAR; PG8_SCHED;
            PG8_LDB(B1, 1, 1); PG8_STAGE(PG8_SB(1, 0), b3, voffB);
            PG8_BAR; PG8_WAIT_L(0); PG8_MMA(0, 1, At, B1); PG8_BAR;
            PG8_LDA(At, 1, 1); PG8_STAGE(PG8_SA(1, 0), a3, voffA);
            PG8_BAR; PG8_WAIT_L(0); PG8_MMA(1, 0, At, B0); PG8_BAR; PG8_SCHED;
            PG8_STAGE(PG8_SB(1, 1), b3 + hstep, voffB);
            PG8_WAIT_V(6); PG8_BAR; PG8_MMA(1, 1, At, B1); PG8_BAR;
            }
        }
        if constexpr (ALIGN_EPI) { if (wr == 0) PG8_BAR; }
        if constexpr (!Epi::AFTER_DRAIN) { E(acc, cur, wr, wc, fr, fq); S.done(cur); }
        if (!has_next) break;
#pragma unroll
        for (int a = 0; a < 2; ++a)
#pragma unroll
            for (int b = 0; b < 2; ++b)
#pragma unroll
                for (int m = 0; m < 4; ++m)
#pragma unroll
                    for (int n = 0; n < 2; ++n) acc[a][b][m][n] = (f32x4){0.f, 0.f, 0.f, 0.f};
        cur = nxt; cA = nA; cB = nB; ++ui;
        if constexpr (GATHER) { gc0[0] = gn0[0]; gc0[1] = gn0[1]; gc1[0] = gn1[0]; gc1[1] = gn1[1]; }
        if constexpr (ALIGN_EPI) { if (wr == 1) PG8_BAR; }
    }
    PG8_WAIT_V(0);
    if constexpr (!ALIGN_EPI) { if (wr == 0) PG8_BAR; }
    PG8_BAR;
    if constexpr (Epi::AFTER_DRAIN) { E.fused(acc, cur, wr, wc, fr, fq, lds, wid, lane); S.done(cur); }
#undef PG8_SA
#undef PG8_SB
#undef PG8_STAGE
#undef PG8_STAGE_A
#undef PG8_GOFF
#undef PG8_LDA
#undef PG8_LDB
#undef PG8_MMA
#undef PG8_WAIT_V
#undef PG8_WAIT_L
#undef PG8_BAR
#undef PG8_SCHED
}
}
#define GAS __attribute__((address_space(1)))
#define LAS __attribute__((address_space(3)))
typedef unsigned short bf16;
typedef unsigned v4u __attribute__((ext_vector_type(4)));
typedef float f32x4 __attribute__((ext_vector_type(4)));
typedef short bf16x8 __attribute__((ext_vector_type(8)));
typedef GAS unsigned gu32;
typedef GAS unsigned long long gu64;
#define RLX_AGENT __ATOMIC_RELAXED, __HIP_MEMORY_SCOPE_AGENT
#define LDS_WAIT() asm volatile("s_waitcnt lgkmcnt(0)" ::: "memory")
#define VM_WAIT() asm volatile("s_waitcnt vmcnt(0)" ::: "memory")
__device__ __forceinline__ unsigned long long rt() { return __builtin_amdgcn_s_memrealtime(); }
__device__ __forceinline__ unsigned f2bf(float f) { unsigned u = __builtin_bit_cast(unsigned, f); return (u + 0x7fffu + ((u >> 16) & 1u)) >> 16; }
__device__ __forceinline__ unsigned pk2(float lo, float hi) { return f2bf(lo) | (f2bf(hi) << 16); }
#define XB_TMO      128
#define XB_XCNT(j)  (256  + 64 * (j))
#define XB_XSUB(j)  (1280 + 64 * (j))
#define XB_XGEN(j)  (2304 + 64 * (j))
#define XB_TOP      3328
#define XB_TOPGEN   3392
#define XCD_BAR_WORDS 3456
#define XB_SPIN_CAP (1u << 18)

__device__ __forceinline__ unsigned xb_ld(unsigned* p)              { return __hip_atomic_load(p, __ATOMIC_RELAXED, __HIP_MEMORY_SCOPE_AGENT); }
__device__ __forceinline__ unsigned xb_add(unsigned* p, unsigned v) { return __hip_atomic_fetch_add(p, v, __ATOMIC_RELAXED, __HIP_MEMORY_SCOPE_AGENT); }
__device__ __forceinline__ unsigned xb_xcc_id() { return (unsigned)__builtin_amdgcn_s_getreg((3 << 11) | 20) & 0xFu; }
#define XB_SPIN(cond, bar) do { unsigned _sp = 0; while (cond) { __builtin_amdgcn_s_sleep(1); \
    if ((++_sp & 255u) == 0u) { if (xb_ld(&(bar)[XB_TMO])) break; if (_sp > XB_SPIN_CAP) { atomicAdd(&(bar)[XB_TMO], 1u); break; } } } } while (0)

struct XcdBarrier {
    unsigned* bar; unsigned x;
    volatile LAS unsigned* st;
};

__device__ __forceinline__ XcdBarrier xcd_barrier_post(unsigned* bar, volatile LAS unsigned* st, int tid) {
    XcdBarrier b; b.bar = bar; b.x = xb_xcc_id(); b.st = st;
    if (tid == 0) (void)xb_add(&bar[XB_XCNT(b.x)], 1u);
    return b;
}
__device__ __forceinline__ void xcd_barrier_complete(unsigned* bar, unsigned x, unsigned& nloc, unsigned& nx) {
    const unsigned G = gridDim.x * gridDim.y * gridDim.z;
    unsigned sum, cnt, mine, sp = 0u;
    for (;;) {
        sum = 0u; cnt = 0u; mine = 0u;
#pragma unroll
        for (unsigned j = 0; j < 16; ++j) { const unsigned c = xb_ld(&bar[XB_XCNT(j)]); sum += c; cnt += (c > 0u) ? 1u : 0u; mine = (j == x) ? c : mine; }
        if (sum == G) break;
        __builtin_amdgcn_s_sleep(1);
        if ((++sp & 255u) == 0u) { if (xb_ld(&bar[XB_TMO])) break; if (sp > XB_SPIN_CAP) { atomicAdd(&bar[XB_TMO], 1u); break; } }
    }
    nloc = mine > 0u ? mine : 1u; nx = cnt > 0u ? cnt : 1u;
}

__device__ __forceinline__ void xcd_barrier(const XcdBarrier& b, int tid) {
    asm volatile("s_waitcnt vmcnt(0)" ::: "memory");
    __syncthreads();
    if (tid == 0) {
        unsigned* bar = b.bar;
        __builtin_amdgcn_s_waitcnt(0);
        unsigned nloc = b.st[0], nx = b.st[1];
        if (nloc == 0u) { xcd_barrier_complete(bar, b.x, nloc, nx); b.st[0] = nloc; b.st[1] = nx; }
        const unsigned old = xb_add(&bar[XB_XSUB(b.x)], 1u);
        const unsigned gen = old / nloc;
        if (old + 1u == (gen + 1u) * nloc) {
            __builtin_amdgcn_fence(__ATOMIC_RELEASE, "agent");
            asm volatile("s_waitcnt vmcnt(0)" ::: "memory");
            const unsigned og = xb_add(&bar[XB_TOP], 1u);
            const unsigned tg = og / nx;
            if (og + 1u == (tg + 1u) * nx) xb_add(&bar[XB_TOPGEN], 1u);
            else XB_SPIN(xb_ld(&bar[XB_TOPGEN]) == tg, bar);
            __builtin_amdgcn_fence(__ATOMIC_ACQUIRE, "agent");
            xb_add(&bar[XB_XGEN(b.x)], 1u);
            asm volatile("s_waitcnt vmcnt(0)" ::: "memory");
        } else {
            XB_SPIN(xb_ld(&bar[XB_XGEN(b.x)]) == gen, bar);
            __builtin_amdgcn_fence(__ATOMIC_ACQUIRE, "agent");
            asm volatile("s_waitcnt vmcnt(0)" ::: "memory");
        }
    }
    __syncthreads();
}
namespace fa {
typedef short bf16x8 __attribute__((ext_vector_type(8)));
typedef float f32x16 __attribute__((ext_vector_type(16)));
typedef float f32x2_t __attribute__((ext_vector_type(2))); typedef __bf16 bf16x2_t __attribute__((ext_vector_type(2)));
typedef unsigned u32x4 __attribute__((ext_vector_type(4)));
typedef unsigned u32x2 __attribute__((ext_vector_type(2)));
__device__ __forceinline__ unsigned cvtpk(float lo, float hi) { f32x2_t v = {lo, hi}; bf16x2_t b = __builtin_convertvector(v, bf16x2_t); return __builtin_bit_cast(unsigned, b); }
__device__ __forceinline__ int kap(int r32) { return (r32 & ~12) | ((r32 & 4) << 1) | ((r32 & 8) >> 1); }
__device__ __forceinline__ float xmax(float v) { auto rr = __builtin_amdgcn_permlane32_swap(__float_as_uint(v), __float_as_uint(v), false, false); return fmaxf(__uint_as_float(rr[0]), __uint_as_float(rr[1])); }
__device__ __forceinline__ float xsum(float v) { auto rr = __builtin_amdgcn_permlane32_swap(__float_as_uint(v), __float_as_uint(v), false, false); return __uint_as_float(rr[0]) + __uint_as_float(rr[1]); }
constexpr float NEGBIG = -1e30f;

struct Frag { bf16x8 k[4]; bf16x8 v[4]; };
struct State { f32x16 o0, o1; float m, l; };

__device__ __forceinline__ void load_tile(Frag& f, const bf16* Kbh, const bf16* Vbh, int VP, int key0, int r32, int hi) {
    const bf16* kp = Kbh + (size_t)(key0 + kap(r32)) * 64 + hi * 8;
#pragma unroll
    for (int d0 = 0; d0 < 4; ++d0) f.k[d0] = *(const bf16x8*)(kp + d0 * 16);
    const bf16* vp = Vbh + (size_t)r32 * VP + key0 + hi * 8;
#pragma unroll
    for (int db = 0; db < 2; ++db)
#pragma unroll
        for (int s = 0; s < 2; ++s) f.v[db * 2 + s] = *(const bf16x8*)(vp + (size_t)db * 32 * VP + s * 16);
}
__device__ __forceinline__ void load_v(Frag& f, const bf16* Vbh, int VP, int key0, int r32, int hi) {
    const bf16* vp = Vbh + (size_t)r32 * VP + key0 + hi * 8;
#pragma unroll
    for (int db = 0; db < 2; ++db)
#pragma unroll
        for (int s = 0; s < 2; ++s) f.v[db * 2 + s] = *(const bf16x8*)(vp + (size_t)db * 32 * VP + s * 16);
}
__device__ __forceinline__ void load_k(Frag& f, const bf16* Kbh, int key0, int r32, int hi) {
    const bf16* kp = Kbh + (size_t)(key0 + kap(r32)) * 64 + hi * 8;
#pragma unroll
    for (int d0 = 0; d0 < 4; ++d0) f.k[d0] = *(const bf16x8*)(kp + d0 * 16);
}
__device__ __forceinline__ void scores(f32x16& p, const Frag& f, const bf16x8 (&qr)[4]) {
    p = f32x16{};
#pragma unroll
    for (int d0 = 0; d0 < 4; ++d0) p = __builtin_amdgcn_mfma_f32_32x32x16_bf16(f.k[d0], qr[d0], p, 0, 0, 0);
}
__device__ __forceinline__ void mask_range(f32x16& p, int key0, int hi, int lo, int hi_) {
#pragma unroll
    for (int r = 0; r < 16; ++r) { const int kpos = key0 + 16 * (r >> 3) + 8 * hi + (r & 7); p[r] = (kpos >= lo && kpos <= hi_) ? p[r] : -INFINITY; }
}
__device__ __forceinline__ void step(State& st, const Frag& f, const bf16x8 (&qr)[4], int key0, int hi, bool need_mask, int lo, int hi_) {
    f32x16 p; scores(p, f, qr);
    if (need_mask) mask_range(p, key0, hi, lo, hi_);
    float tm = fmaxf(p[0], p[1]);
#pragma unroll
    for (int r = 2; r < 16; ++r) tm = fmaxf(tm, p[r]);
    tm = xmax(tm);
    const float mn = fmaxf(st.m, tm); const float alpha = __builtin_amdgcn_exp2f(st.m - mn); st.m = mn;
    float rs = 0.f;
#pragma unroll
    for (int r = 0; r < 16; ++r) { p[r] = __builtin_amdgcn_exp2f(p[r] - mn); rs += p[r]; }
    st.l = st.l * alpha + rs;
    if (!__all(alpha == 1.0f)) { st.o0 = st.o0 * alpha; st.o1 = st.o1 * alpha; }
    u32x4 w0, w1;
    w0.x = cvtpk(p[0], p[1]); w0.y = cvtpk(p[2], p[3]); w0.z = cvtpk(p[4], p[5]); w0.w = cvtpk(p[6], p[7]);
    w1.x = cvtpk(p[8], p[9]); w1.y = cvtpk(p[10], p[11]); w1.z = cvtpk(p[12], p[13]); w1.w = cvtpk(p[14], p[15]);
    const bf16x8 pb0 = __builtin_bit_cast(bf16x8, w0), pb1 = __builtin_bit_cast(bf16x8, w1);
    st.o0 = __builtin_amdgcn_mfma_f32_32x32x16_bf16(f.v[0], pb0, st.o0, 0, 0, 0);
    st.o0 = __builtin_amdgcn_mfma_f32_32x32x16_bf16(f.v[1], pb1, st.o0, 0, 0, 0);
    st.o1 = __builtin_amdgcn_mfma_f32_32x32x16_bf16(f.v[2], pb0, st.o1, 0, 0, 0);
    st.o1 = __builtin_amdgcn_mfma_f32_32x32x16_bf16(f.v[3], pb1, st.o1, 0, 0, 0);
}
__device__ __forceinline__ void load_q(bf16x8 (&qr)[4], const bf16* Qrow  , int hi) {
#pragma unroll
    for (int d0 = 0; d0 < 4; ++d0) qr[d0] = *(const bf16x8*)(Qrow + d0 * 16 + hi * 8);
}
__device__ __forceinline__ float finish(State& st) { const float lt = xsum(st.l); return lt > 0.f ? 1.0f / lt : 0.f; }
__device__ __forceinline__ void store_o(const State& st, float inv, bf16* Orow  , int hi) {
#pragma unroll
    for (int g = 0; g < 4; ++g) {
        u32x2 a, b; a.x = cvtpk(st.o0[4 * g] * inv, st.o0[4 * g + 1] * inv); a.y = cvtpk(st.o0[4 * g + 2] * inv, st.o0[4 * g + 3] * inv);
        b.x = cvtpk(st.o1[4 * g] * inv, st.o1[4 * g + 1] * inv); b.y = cvtpk(st.o1[4 * g + 2] * inv, st.o1[4 * g + 3] * inv);
        *(u32x2*)(Orow + 8 * g + 4 * hi) = a; *(u32x2*)(Orow + 32 + 8 * g + 4 * hi) = b; }
}
__device__ __forceinline__ float bflo(unsigned w) { return __uint_as_float(w << 16); }
__device__ __forceinline__ float bfhi(unsigned w) { return __uint_as_float(w & 0xffff0000u); }
}
constexpr int NWAVES = 8;
constexpr int NB = 2, SEQ = 4096, DM = 2048, NTOK = NB * SEQ, NEXP = 16, DEXP = 512;
constexpr float ALPHA_RES = 1.4142135623730951f;
constexpr float LN_EPS = 1e-5f;
constexpr float QSCALE = 0.125f * 1.4426950408889634f;
constexpr float LOG2E = 1.4426950408889634f;
constexpr int NPHASE = 21;
#ifndef MK_N_LAUNCHES
#define MK_N_LAUNCHES 1
#endif
constexpr int N_LAUNCHES = MK_N_LAUNCHES;

constexpr size_t MiB = 1u << 20, KiB = 1u << 10;
constexpr size_t WS_CTL = 0, CTL_ZERO_BYTES = 32 * KiB;
constexpr size_t WS_MODP = 1 * MiB;
constexpr size_t WS_MOD = 4 * MiB;
constexpr size_t WS_ROPE = 4 * MiB + 512 * KiB;
constexpr size_t WS_CMPB = 5 * MiB;
constexpr size_t WS_TOKE = 5 * MiB + 256 * KiB;
constexpr size_t WS_TOKW = WS_TOKE + 64 * KiB;
constexpr size_t WS_TOKS = WS_TOKW + 64 * KiB;
constexpr int SEG_CAP = 8192;
constexpr size_t WS_ROWTOK = 10 * MiB;
constexpr size_t WS_ROWW = WS_ROWTOK + 512 * KiB;
constexpr size_t WS_BCNT = 5 * MiB + 768 * KiB;
constexpr size_t WS_ROWSRC = WS_ROWW + 512 * KiB;
constexpr size_t WS_SELM = 6 * MiB;
constexpr size_t WS_KCMP = 6 * MiB + 256 * KiB;
constexpr size_t WS_VCMPT = 6 * MiB + 512 * KiB;
constexpr size_t WS_GATES = 7 * MiB;
constexpr size_t WS_ULK = 10 * MiB, WS_ULV = 14 * MiB;
constexpr size_t WS_WQKV = 18 * MiB, WS_WO0 = 28 * MiB, WS_WIN = 36 * MiB, WS_WO1 = 51 * MiB, WS_PHIK = 59 * MiB, WS_PHIV = 60 * MiB;
constexpr size_t WS_W13 = 64 * MiB;
constexpr size_t WS_W2 = 192 * MiB;
constexpr size_t WS_H = 256 * MiB;
constexpr size_t WS_XA = 288 * MiB, WS_Y = 320 * MiB, WS_XB = 352 * MiB;
constexpr size_t WS_Q = 416 * MiB, WS_QRAW = 448 * MiB, WS_ATT = 480 * MiB;
constexpr size_t WS_HPERM = 416 * MiB;
constexpr size_t WS_OCMP = 512 * MiB, WS_OWIN = 544 * MiB;
constexpr size_t WS_K0 = 576 * MiB, WS_VT0 = 580 * MiB, WS_KC = 584 * MiB, WS_VC = 588 * MiB, WS_KS = 592 * MiB, WS_VST = 596 * MiB, WS_KW = 600 * MiB, WS_VWT = 604 * MiB;
constexpr size_t WS_HE = 416 * MiB;
constexpr size_t WS_YS = 628 * MiB;
constexpr size_t WS_END = 692 * MiB;
constexpr int CW_TMO = 0, CW_CODE = 1;
constexpr int CW_DONE = 512;
constexpr int CW_FQ = 128;
constexpr int CW_CNT = 1024, CW_CNT_STRIDE = 64;
constexpr int CW_BAR = 4096;

constexpr int RING_OFF = 0, RING_BYTES = 131072;
constexpr int LDSCTL_OFF = RING_BYTES, MISC_OFF = LDSCTL_OFF + 320;
constexpr int LDS_BYTES = 147456;
typedef float f32x16g __attribute__((ext_vector_type(16)));
typedef unsigned u32x2g __attribute__((ext_vector_type(2)));
__device__ __forceinline__ float wave_sum(float v) {
#pragma unroll
    for (int o = 1; o < 64; o <<= 1) v += __shfl_xor(v, o);
    return v;
}
__device__ __forceinline__ unsigned ld_u32_agent(const unsigned* p) { return __hip_atomic_load(p, __ATOMIC_RELAXED, __HIP_MEMORY_SCOPE_AGENT); }

__device__ __forceinline__ void transpose_item(const float* W, int ldw, bf16* WT, int ldt, int k0, int n0, int drow0, LAS float* scr, int lane) {
    float t[32]; const float* wp = W + (size_t)(k0 + (lane >> 5)) * ldw + n0 + (lane & 31);
#pragma unroll
    for (int i = 0; i < 32; ++i) t[i] = __builtin_nontemporal_load(wp + (size_t)(2 * i) * ldw);
#pragma unroll
    for (int i = 0; i < 32; ++i) scr[(2 * i + (lane >> 5)) * 33 + (lane & 31)] = t[i];
    LDS_WAIT(); asm volatile("" ::: "memory");
    const int c = lane & 7;
#pragma unroll
    for (int j = 0; j < 4; ++j) { const int n = (lane >> 3) + 8 * j; const LAS float* s = scr + (8 * c) * 33 + n;
        v4u o; o.x = pk2(s[0 * 33], s[1 * 33]); o.y = pk2(s[2 * 33], s[3 * 33]); o.z = pk2(s[4 * 33], s[5 * 33]); o.w = pk2(s[6 * 33], s[7 * 33]);
        *(GAS v4u*)(WT + (size_t)(drow0 + n) * ldt + k0 + 8 * c) = o; }
    LDS_WAIT(); asm volatile("" ::: "memory");
}

__device__ __forceinline__ void phase_mod_partial(const float* c, const float* w_ada, float* modp, LAS float* scr, int gw, int NGW, int lane) {
    typedef float f32x3 __attribute__((ext_vector_type(3)));
    for (int task = gw; task < 2048; task += NGW) {
        const int ks = task & 15, chunk = (task >> 4) & 63, layer = task >> 10, k0 = ks * 128;
        for (int i = lane; i < 256; i += 64) { const float v = c[(i >> 7) * DM + k0 + (i & 127)]; scr[i] = v / (1.0f + __expf(-v)); }
        LDS_WAIT(); asm volatile("" ::: "memory");
        const float* wp = w_ada + ((size_t)layer * DM + k0) * 12288 + chunk * 192 + lane * 3;
        f32x3 a0 = {0.f, 0.f, 0.f}, a1 = {0.f, 0.f, 0.f};
#pragma unroll 16
        for (int k = 0; k < 128; ++k) { const f32x3 w = __builtin_nontemporal_load((const f32x3*)(wp + (size_t)k * 12288)); const float s0 = scr[k], s1 = scr[128 + k]; a0 += w * s0; a1 += w * s1; }
        float* o = modp + ((size_t)((ks * 2 + layer) * 2) * 12288) + chunk * 192 + lane * 3;
        *(f32x3*)o = a0; *(f32x3*)(o + 12288) = a1;
        LDS_WAIT(); asm volatile("" ::: "memory");
    }
}
__device__ __forceinline__ void rope_table(const int* positions, float* rope, int gtid, int nthr) {
    for (int idx = gtid; idx < NTOK * 8; idx += nthr) {
        const int tok = idx >> 3, i = idx & 7;
        const double invf = i == 0 ? 1.0 : i == 1 ? 0.19392274474868576 : i == 2 ? 0.03760603093086393 : i == 3 ? 0.007292664737217109 : i == 4 ? 0.001414213562373095 : i == 5 ? 0.0002742481756762073 : i == 6 ? 5.318295896944988e-05 : 1.031338537721246e-05;
        const double a = (double)positions[tok] * invf;
        const double kq = __builtin_rint(a * 0.6366197723675814);
        double r = __builtin_fma(-kq, 1.5707963267948966, a); r = __builtin_fma(-kq, 6.123233995736766e-17, r);
        const double r2 = r * r;
        double sn = 1.0 / 6227020800.0; sn = sn * r2 - 1.0 / 39916800.0; sn = sn * r2 + 1.0 / 362880.0; sn = sn * r2 - 1.0 / 5040.0; sn = sn * r2 + 1.0 / 120.0; sn = sn * r2 - 1.0 / 6.0; sn = sn * r2 + 1.0; sn *= r;
        double cs = -1.0 / 87178291200.0; cs = cs * r2 + 1.0 / 479001600.0; cs = cs * r2 - 1.0 / 3628800.0; cs = cs * r2 + 1.0 / 40320.0; cs = cs * r2 - 1.0 / 720.0; cs = cs * r2 + 1.0 / 24.0; cs = cs * r2 - 0.5; cs = cs * r2 + 1.0;
        const int q = ((int)(long long)kq) & 3;
        const double co = q == 0 ? cs : q == 1 ? -sn : q == 2 ? -cs : sn, si = q == 0 ? sn : q == 1 ? cs : q == 2 ? -sn : -cs;
        rope[(size_t)tok * 16 + i] = (float)co; rope[(size_t)tok * 16 + 8 + i] = (float)si;
    }
}

__device__ __forceinline__ void modulate_row_lds(const float* xrow, const LAS float* sh, const LAS float* sc, bf16* orow, int lane) {
    const GAS f32x4* xr = (const GAS f32x4*)xrow + lane; GAS unsigned long long* o8 = (GAS unsigned long long*)orow + lane;
#pragma unroll
    for (int j = 0; j < 8; ++j) { const f32x4 v = xr[64 * j]; const f32x4 s = *(const LAS f32x4*)(sc + 256 * j + 4 * lane), h = *(const LAS f32x4*)(sh + 256 * j + 4 * lane);
        const f32x4 o = v * (s + 1.0f) + h; o8[64 * j] = (unsigned long long)pk2(o.x, o.y) | ((unsigned long long)pk2(o.z, o.w) << 32); }
}

struct In {
    const float *x, *c; const int* positions; const float *w_ada, *b_ada, *swa_w_qkv, *swa_b_qkv, *swa_sinks, *swa_w_o, *nsa_w_in, *nsa_pe_k, *nsa_pe_v, *nsa_phi_k1, *nsa_phi_k2, *nsa_phi_v1, *nsa_phi_v2, *nsa_w_o,
        *moe_w_group, *moe_b_group, *moe_w_router, *moe_b_router, *moe_w1, *moe_w3, *moe_w2, *ln_t_g, *ln_t_b, *ln_c_g, *ln_c_b;
};

constexpr int CV_QKV = 32 * 80, CV_WO = 32 * 64, CV_WIN = 32 * 115, CV_PHI = 16 * 8, CV_MOE = 16 * 3 * 512;
constexpr int CV_A = CV_QKV + CV_WO;
constexpr int CV_B = CV_A + CV_MOE;
constexpr int CV_C = CV_B + CV_WIN + CV_WO + 4 * CV_PHI;
constexpr int CV_D = CV_C + CV_MOE;
__device__ __forceinline__ void conv_moe_item(const In& I, unsigned char* ws, int layer, int r, LAS float* scr, int lane) {
    if (r < 16 * 2 * 512) { const int mat = r / 512, q = r % 512, le = layer * 16 + (mat >> 1), which = mat & 1;
        const int n0 = 32 * (q % 16);
        transpose_item((which ? I.moe_w3 : I.moe_w1) + (size_t)le * 2048 * 512, 512, (bf16*)(ws + WS_W13) + (size_t)le * 1024 * 2048, 2048, 64 * (q / 16), n0, (n0 >> 7) * 256 + which * 128 + (n0 & 127), scr, lane); return; }
    r -= 16 * 2 * 512;
    { const int le = layer * 16 + r / 512, q = r % 512;
      transpose_item(I.moe_w2 + (size_t)le * 512 * 2048, 2048, (bf16*)(ws + WS_W2) + (size_t)le * 2048 * 512, 512, 64 * (q / 64), 32 * (q % 64), 32 * (q % 64), scr, lane); }
}
__device__ __forceinline__ void conv_item(const In& I, unsigned char* ws, int it, LAS float* scr, int lane) {
    int r = it;
    if (r < CV_QKV) { transpose_item(I.swa_w_qkv, 2560, (bf16*)(ws + WS_WQKV), 2048, 64 * (r / 80), 32 * (r % 80), 32 * (r % 80), scr, lane); return; } r -= CV_QKV;
    if (r < CV_WO) { transpose_item(I.swa_w_o, 2048, (bf16*)(ws + WS_WO0), 2048, 64 * (r / 64), 32 * (r % 64), 32 * (r % 64), scr, lane); return; } r -= CV_WO;
    if (r < CV_MOE) { conv_moe_item(I, ws, 0, r, scr, lane); return; } r -= CV_MOE;
    if (r < CV_WIN) { transpose_item(I.nsa_w_in, 3680, (bf16*)(ws + WS_WIN), 2048, 64 * (r / 115), 32 * (r % 115), 32 * (r % 115), scr, lane); return; } r -= CV_WIN;
    if (r < CV_WO) { transpose_item(I.nsa_w_o, 2048, (bf16*)(ws + WS_WO1), 2048, 64 * (r / 64), 32 * (r % 64), 32 * (r % 64), scr, lane); return; } r -= CV_WO;
    if (r < 4 * CV_PHI) { const int j = r / CV_PHI, q = r % CV_PHI, which = j >> 1, half = j & 1;
        transpose_item((which ? I.nsa_phi_v1 : I.nsa_phi_k1) + (size_t)half * 1024 * 256, 256, (bf16*)(ws + (which ? WS_PHIV : WS_PHIK)), 1024, 64 * (q / 8), 32 * (q % 8), half * 256 + 32 * (q % 8), scr, lane); return; }
    r -= 4 * CV_PHI;
    if (r < CV_MOE) conv_moe_item(I, ws, 1, r, scr, lane);
}
__device__ __forceinline__ bool conv_batch(const In& I, unsigned char* ws, LAS unsigned char* lds, int limit, const unsigned* donew, unsigned done_target, int tid, int wave, int lane) {
    volatile LAS int* sb = (volatile LAS int*)(lds + 131072 + 2048);
    if (tid == 0) { const bool stop = donew && ld_u32_agent(donew) >= done_target;
        sb[0] = stop ? 0x7fffffff : (int)atomicAdd((unsigned*)(ws + WS_CTL) + CW_FQ, 8u); }
    LDS_WAIT(); __syncthreads();
    const int sv = sb[0];
    __syncthreads();
    if (sv == 0x7fffffff) return false;
    const int base = CV_A + sv, it = base + wave;
    if (it < CV_D) conv_item(I, ws, it, (LAS float*)(lds + wave * 16384), lane);
    return base < limit;
}
__device__ __forceinline__ void conv_fill(const In& I, unsigned char* ws, LAS unsigned char* lds, int slot, int G, int tid, int wave, int lane) {
    unsigned* donew = (unsigned*)(ws + WS_CTL) + CW_DONE + 64 * slot;
    if (tid == 0) atomicAdd(donew, 1u);
    for (int n = 0; n < 64; ++n) if (!conv_batch(I, ws, lds, CV_D, donew, (unsigned)G, tid, wave, lane)) break;
    __syncthreads();
}
__device__ __forceinline__ void conv_drain(const In& I, unsigned char* ws, LAS unsigned char* lds, int limit, int tid, int wave, int lane) {
    while (conv_batch(I, ws, lds, limit, nullptr, 0u, tid, wave, lane)) {}
    __syncthreads();
}

__device__ __forceinline__ void phase_prologue(const In& I, unsigned char* ws, LAS unsigned char* lds, int tid, int lane, int wave, int vcu, int G) {
    const float* modp = (const float*)(ws + WS_MODP); float* mod = (float*)(ws + WS_MOD);
    LAS float* msm = (LAS float*)(lds + 65536);
#pragma unroll 1
    for (int it = 0; it < 2; ++it) {
        f32x4 pv[2][16];
#pragma unroll
        for (int u = 0; u < 2; ++u) { const int i4 = tid + (NWAVES * 64) * (2 * it + u), b = i4 >> 10, col = (i4 & 1023) * 4;
#pragma unroll
            for (int ks = 0; ks < 16; ++ks) pv[u][ks] = *(const f32x4*)(modp + (size_t)((ks * 2 + 0) * 2 + b) * 12288 + col); }
#pragma unroll
        for (int u = 0; u < 2; ++u) { const int i4 = tid + (NWAVES * 64) * (2 * it + u), col = (i4 & 1023) * 4; f32x4 sacc = *(const f32x4*)(I.b_ada + col);
#pragma unroll
            for (int ks = 0; ks < 16; ++ks) sacc += pv[u][ks];
            *(LAS f32x4*)(msm + 4 * i4) = sacc; } }
    { const int gidx = vcu * 192 + tid;
      if (tid < 192 && gidx < 2 * 2 * 12288) { const int layer = gidx / 24576, rem = gidx % 24576, b = rem / 12288, col = rem % 12288; float s = I.b_ada[layer * 12288 + col];
#pragma unroll
          for (int ks = 0; ks < 16; ++ks) s += modp[(size_t)((ks * 2 + layer) * 2 + b) * 12288 + col];
          mod[gidx] = s; } }
    __syncthreads();
    const int gw = vcu * NWAVES + wave, NGW = G * NWAVES;
    bf16* H = (bf16*)(ws + WS_H);
    for (int m0 = gw; m0 < NTOK; m0 += 4 * NGW) {
        f32x4 xv[4][8];
#pragma unroll
        for (int r = 0; r < 4; ++r) { const int m = m0 + r * NGW; if (m < NTOK) { const GAS f32x4* xr = (const GAS f32x4*)(I.x + (size_t)m * DM) + lane;
#pragma unroll
            for (int j = 0; j < 8; ++j) xv[r][j] = __builtin_nontemporal_load(xr + 64 * j); } }
#pragma unroll
        for (int r = 0; r < 4; ++r) { const int m = m0 + r * NGW; if (m < NTOK) { const int b = m >> 12; const LAS float* sh = msm + b * 4096; const LAS float* sc = sh + 2048;
            GAS unsigned long long* o8 = (GAS unsigned long long*)(H + (size_t)m * DM) + lane;
#pragma unroll
            for (int j = 0; j < 8; ++j) { const f32x4 sv = *(const LAS f32x4*)(sc + 256 * j + 4 * lane), hv = *(const LAS f32x4*)(sh + 256 * j + 4 * lane);
                const f32x4 o = xv[r][j] * (sv + 1.0f) + hv; o8[64 * j] = (unsigned long long)pk2(o.x, o.y) | ((unsigned long long)pk2(o.z, o.w) << 32); } } }
    }
    if (gw < 512) { const int which = gw >> 8, cc = gw & 255; const float* pe = which ? I.nsa_pe_v : I.nsa_pe_k; const float* phi = which ? I.nsa_phi_v1 : I.nsa_phi_k1; float s = 0.f;
#pragma unroll 4
        for (int i = 0; i < 32; ++i) { const int k = lane + 64 * i; s += pe[k] * phi[(size_t)k * 256 + cc]; }
        s = wave_sum(s); if (lane == 0) ((float*)(ws + WS_CMPB))[which * 256 + cc] = s; }
    __syncthreads();
    LAS float* scr = (LAS float*)(lds + wave * 16384);
    for (int it = gw; it < CV_A; it += NGW) conv_item(I, ws, it, scr, lane);
}

template <int W, bool SINK>
__device__ __forceinline__ void banded_unit(int b, int hkv, int tb, int g, int lane, const bf16* Q, const bf16* K, const bf16* VT, bf16* OUT, const float* sinks) {
    const int r32 = lane & 31, hi = lane >> 5, head = hkv * 8 + g, q0 = tb * 32, t = q0 + r32;
    const size_t row = (size_t)b * SEQ + t;
    fa::bf16x8 qr[4]; fa::load_q(qr, Q + row * DM + head * 64, hi);
    const bf16* Kbh = K + (size_t)(b * 4 + hkv) * SEQ * 64; const bf16* Vbh = VT + (size_t)(b * 4 + hkv) * 64 * SEQ;
    fa::State st; st.o0 = fa::f32x16{}; st.o1 = fa::f32x16{};
    if (SINK) { st.m = sinks[head] * LOG2E; st.l = hi == 0 ? 1.0f : 0.0f; } else { st.m = fa::NEGBIG; st.l = 0.f; }
    const int ktA = tb - W / 32 > 0 ? tb - W / 32 : 0;
    fa::Frag fc, fn; fa::load_tile(fc, Kbh, Vbh, SEQ, ktA * 32, r32, hi);
    for (int kt = ktA; kt <= tb; ++kt) {
        if (kt < tb) fa::load_tile(fn, Kbh, Vbh, SEQ, (kt + 1) * 32, r32, hi);
        const bool nm = (kt == tb) || (kt == tb - W / 32);
        fa::step(st, fc, qr, kt * 32, hi, nm, t - W + 1, t);
        fc = fn;
    }
    const float inv = fa::finish(st);
    fa::store_o(st, inv, OUT + row * DM + head * 64, hi);
}
template <int W, bool SINK>
__device__ __forceinline__ void phase_banded(int vcu, int G, int wave, int lane, const bf16* Q, const bf16* K, const bf16* VT, bf16* OUT, const float* sinks) {
    for (int u = vcu; u < 1024; u += G) { const int bh = (u >> 5) & 7, tb = ((u >> 8) << 5) | (u & 31); banded_unit<W, SINK>(bh >> 2, bh & 3, tb, wave, lane, Q, K, VT, OUT, sinks); }
}

__device__ __forceinline__ void phase_lnt(const In& I, unsigned char* ws, LAS unsigned char* wsm  , LAS int* esm  , int layer, const bf16* Y, int gw, int lane_in, int tid, int vcu) {
    const float* mod = (const float*)(ws + WS_MOD); bf16* XA = (bf16*)(ws + WS_XA); bf16* H = (bf16*)(ws + WS_H);
    const float* lng = I.ln_t_g + layer * DM; const float* lnb = I.ln_t_b + layer * DM;
    const float* wg = I.moe_w_group + (size_t)layer * DM * 4; const float* wr = I.moe_w_router + (size_t)layer * DM * 16;
    int* tokE = (int*)(ws + WS_TOKE); float* tokW = (float*)(ws + WS_TOKW); int* tokS = (int*)(ws + WS_TOKS);
    constexpr int WCH = 64 * 272 + 64 * 80;
    f32x4 sr0, sr1, sgp = {0.f, 0.f, 0.f, 0.f};
    const int sk0 = tid >> 2, sk1 = (tid + 512) >> 2, sq = tid & 3;
    const float* srp0 = wr + (size_t)sk0 * 16 + 4 * sq; const float* srp1 = wr + (size_t)sk1 * 16 + 4 * sq; const float* sgpp = wg + (size_t)tid * 4;
    const int so0 = (sk0 >> 2) * 272 + (sk0 & 3) * 64 + sq * 16, so1 = (sk1 >> 2) * 272 + (sk1 & 3) * 64 + sq * 16, sog = 64 * 272 + (tid >> 2) * 80 + (tid & 3) * 16;
#define STAGE_LD(ch) do { sr0 = *(const f32x4*)(srp0 + (size_t)(ch) * 4096); sr1 = *(const f32x4*)(srp1 + (size_t)(ch) * 4096); if (tid < 256) sgp = *(const f32x4*)(sgpp + (size_t)(ch) * 1024); } while (0)
#define STAGE_ST(buf) do { LAS unsigned char* base_ = wsm + (buf) * WCH; *(LAS f32x4*)(base_ + so0) = sr0; *(LAS f32x4*)(base_ + so1) = sr1; if (tid < 256) *(LAS f32x4*)(base_ + sog) = sgp; } while (0)
    STAGE_LD(0); STAGE_ST(0); LDS_WAIT(); __syncthreads();
#pragma unroll 1
    for (int it = 0; it < 2; ++it) {
        int lane_o = lane_in; asm volatile("" : "+v"(lane_o)); const int lane = lane_o;
        const int rA = gw * 4 + it * 2, b = rA >> 12;
        const float* shc = mod + (size_t)(layer * 2 + b) * 12288 + 6144; const float* scc = shc + 2048;
        f32x4 v[2][8]; float rstd[2];
#pragma unroll
        for (int r = 0; r < 2; ++r) {
            const GAS u32x2g* yr = (const GAS u32x2g*)(Y + (size_t)(rA + r) * DM) + lane; float s = 0.f;
#pragma unroll
            for (int j = 0; j < 8; ++j) { const u32x2g w = yr[64 * j]; v[r][j] = (f32x4){fa::bflo(w.x), fa::bfhi(w.x), fa::bflo(w.y), fa::bfhi(w.y)}; s += (v[r][j].x + v[r][j].y) + (v[r][j].z + v[r][j].w); }
            const float mean = wave_sum(s) * (1.f / DM); float s2 = 0.f;
#pragma unroll
            for (int j = 0; j < 8; ++j) { v[r][j] = v[r][j] - mean; s2 += (v[r][j].x * v[r][j].x + v[r][j].y * v[r][j].y) + (v[r][j].z * v[r][j].z + v[r][j].w * v[r][j].w); }
            rstd[r] = 1.f / sqrtf(wave_sum(s2) * (1.f / DM) + LN_EPS);
        }
        float acc[2][20];
#pragma unroll
        for (int r = 0; r < 2; ++r)
#pragma unroll
            for (int e = 0; e < 20; ++e) acc[r][e] = 0.f;
#pragma unroll
        for (int j = 0; j < 8; ++j) { const int col = 256 * j + 4 * lane; const int step = it * 8 + j;
            const f32x4 gg = *(const f32x4*)(lng + col), bb = *(const f32x4*)(lnb + col), sc = *(const f32x4*)(scc + col), sh = *(const f32x4*)(shc + col);
            f32x4 h[2];
#pragma unroll
            for (int r = 0; r < 2; ++r) { const f32x4 x1 = v[r][j] * rstd[r] * gg + bb; ((GAS unsigned long long*)(XA + (size_t)(rA + r) * DM) + lane)[64 * j] = (unsigned long long)pk2(x1.x, x1.y) | ((unsigned long long)pk2(x1.z, x1.w) << 32);
                h[r] = x1 * (sc + 1.0f) + sh;
                ((GAS unsigned long long*)(H + (size_t)(rA + r) * DM) + lane)[64 * j] = (unsigned long long)pk2(h[r].x, h[r].y) | ((unsigned long long)pk2(h[r].z, h[r].w) << 32); }
            if (step < 15) STAGE_LD((j + 1) & 7);
            const LAS unsigned char* cb = wsm + (step & 1) * WCH;
#pragma unroll 1
            for (int i = 0; i < 4; ++i) {
                const float hA = i == 0 ? h[0][0] : i == 1 ? h[0][1] : i == 2 ? h[0][2] : h[0][3], hB = i == 0 ? h[1][0] : i == 1 ? h[1][1] : i == 2 ? h[1][2] : h[1][3];
#pragma unroll
                for (int q = 0; q < 4; ++q) { const f32x4 w = *(const LAS f32x4*)(cb + lane * 272 + i * 64 + q * 16);
#pragma unroll
                    for (int e = 0; e < 4; ++e) { acc[0][4 * q + e] += hA * w[e]; acc[1][4 * q + e] += hB * w[e]; } }
                const f32x4 w = *(const LAS f32x4*)(cb + 64 * 272 + lane * 80 + i * 16);
#pragma unroll
                for (int e = 0; e < 4; ++e) { acc[0][16 + e] += hA * w[e]; acc[1][16 + e] += hB * w[e]; }
            }
            if (step < 15) STAGE_ST((step + 1) & 1);
            LDS_WAIT(); __syncthreads(); __builtin_amdgcn_sched_barrier(0);
        }
#pragma unroll
        for (int r = 0; r < 2; ++r)
#pragma unroll
            for (int e = 0; e < 20; ++e) acc[r][e] = wave_sum(acc[r][e]);
        if (lane < 2) {
            float a[20];
#pragma unroll
            for (int e = 0; e < 20; ++e) a[e] = lane == 0 ? acc[0][e] : acc[1][e];
            const int row = rA + lane;
            float gl[4];
#pragma unroll
            for (int e = 0; e < 4; ++e) gl[e] = a[16 + e] + I.moe_b_group[layer * 4 + e];
            int gi = 0; float gm = gl[0];
#pragma unroll
            for (int e = 1; e < 4; ++e) if (gl[e] > gm) { gm = gl[e]; gi = e; }
            float gs = 0.f;
#pragma unroll
            for (int e = 0; e < 4; ++e) gs += __expf(gl[e] - gm);
            const float gprob = 1.0f / gs;
            float le[4];
#pragma unroll
            for (int e = 0; e < 4; ++e) le[e] = (gi == 0 ? a[e] : gi == 1 ? a[4 + e] : gi == 2 ? a[8 + e] : a[12 + e]) + I.moe_b_router[layer * 16 + gi * 4 + e];
            int i1 = 0; float m1 = le[0];
#pragma unroll
            for (int e = 1; e < 4; ++e) if (le[e] > m1) { m1 = le[e]; i1 = e; }
            int i2 = -1; float m2 = -INFINITY;
#pragma unroll
            for (int e = 0; e < 4; ++e) if (e != i1 && le[e] > m2) { m2 = le[e]; i2 = e; }
            const float p2 = __expf(m2 - m1), den = 1.0f / (1.0f + p2);
            const int e1 = gi * 4 + i1, e2 = gi * 4 + i2; const float w1 = gprob * den, w2 = gprob * p2 * den;
            tokE[row * 2] = e1; tokE[row * 2 + 1] = e2; tokW[row * 2] = w1; tokW[row * 2 + 1] = w2;
            esm[(row & 31) * 2] = e1; esm[(row & 31) * 2 + 1] = e2;
        }
    }
    LDS_WAIT(); __syncthreads();
    {
        int* tokS = (int*)(ws + WS_TOKS); int* bcnt = (int*)(ws + WS_BCNT) + (layer * 256 + vcu) * 16;
        if (tid < 64) { const int my = esm[tid]; int rk = 0;
            for (int j = 0; j < 64; ++j) rk += (j < tid && esm[j] == my) ? 1 : 0;
            tokS[(size_t)(vcu * 32) * 2 + tid] = rk; }
        else if (tid < 80) { const int e = tid - 64; int c = 0;
            for (int j = 0; j < 64; ++j) c += (esm[j] == e) ? 1 : 0;
            bcnt[e] = c; }
    }
    __syncthreads();
}

__device__ __forceinline__ void phase_lnt2(const In& I, unsigned char* ws, LAS unsigned char* lds, LAS int* esm  , int layer, const bf16* Y, int gw, int lane, int tid, int wave, int vcu) {
    typedef float f32x16r __attribute__((ext_vector_type(16)));
    const float* mod = (const float*)(ws + WS_MOD); bf16* XA = (bf16*)(ws + WS_XA); bf16* H = (bf16*)(ws + WS_H);
    const float* lng = I.ln_t_g + layer * DM; const float* lnb = I.ln_t_b + layer * DM;
    const float* wg = I.moe_w_group + (size_t)layer * DM * 4; const float* wr = I.moe_w_router + (size_t)layer * DM * 16;
    constexpr int APITCH = 129, ABYTES = 16640  , RBUF = ABYTES + 128 * 32 * 4;
    const int r0 = gw * 4, b = r0 >> 12;
    const float* shc = mod + (size_t)(layer * 2 + b) * 12288 + 6144; const float* scc = shc + 2048;
    for (int i = tid; i < 2 * 128 * 12; i += NWAVES * 64) { const int bf = i / (128 * 12), rem = i % (128 * 12); ((LAS float*)(lds + bf * RBUF + ABYTES))[(rem / 12) * 32 + 20 + rem % 12] = 0.f; }
    f32x4 v[4][8]; float rstd[4];
#pragma unroll
    for (int r = 0; r < 4; ++r) {
        const GAS u32x2g* yr = (const GAS u32x2g*)(Y + (size_t)(r0 + r) * DM) + lane; float s = 0.f;
#pragma unroll
        for (int j = 0; j < 8; ++j) { const u32x2g w = yr[64 * j]; v[r][j] = (f32x4){fa::bflo(w.x), fa::bfhi(w.x), fa::bflo(w.y), fa::bfhi(w.y)}; s += (v[r][j].x + v[r][j].y) + (v[r][j].z + v[r][j].w); }
        const float mean = wave_sum(s) * (1.f / DM); float s2 = 0.f;
#pragma unroll
        for (int j = 0; j < 8; ++j) { v[r][j] = v[r][j] - mean; s2 += (v[r][j].x * v[r][j].x + v[r][j].y * v[r][j].y) + (v[r][j].z * v[r][j].z + v[r][j].w * v[r][j].w); }
        rstd[r] = 1.f / sqrtf(wave_sum(s2) * (1.f / DM) + LN_EPS);
    }
    const int wk = tid >> 2, wq = tid & 3;
    f32x4 swr = *(const f32x4*)(wr + (size_t)wk * 16 + 4 * wq), swg = {0.f, 0.f, 0.f, 0.f};
    if (tid < 128) swg = *(const f32x4*)(wg + (size_t)tid * 4);
    f32x16r acc = f32x16r{};
    f32x4 h[4];
#pragma unroll
    for (int st = 0; st < 16; ++st) { const int j = st >> 1, hf = st & 1; LAS float* Ab = (LAS float*)(lds + (st & 1) * RBUF); LAS float* Wb = (LAS float*)(lds + (st & 1) * RBUF + ABYTES);
        if (hf == 0) { const int col = 256 * j + 4 * lane;
            const f32x4 gg = *(const f32x4*)(lng + col), bb = *(const f32x4*)(lnb + col), sc = *(const f32x4*)(scc + col), sh = *(const f32x4*)(shc + col);
#pragma unroll
            for (int r = 0; r < 4; ++r) { const f32x4 x1 = v[r][j] * rstd[r] * gg + bb;
                ((GAS unsigned long long*)(XA + (size_t)(r0 + r) * DM) + lane)[64 * j] = (unsigned long long)pk2(x1.x, x1.y) | ((unsigned long long)pk2(x1.z, x1.w) << 32);
                h[r] = x1 * (sc + 1.0f) + sh;
                ((GAS unsigned long long*)(H + (size_t)(r0 + r) * DM) + lane)[64 * j] = (unsigned long long)pk2(h[r].x, h[r].y) | ((unsigned long long)pk2(h[r].z, h[r].w) << 32); } }
        if ((lane >> 5) == hf) {
#pragma unroll
            for (int r = 0; r < 4; ++r) { LAS float* ap = Ab + (wave * 4 + r) * APITCH + 4 * (lane & 31); ap[0] = h[r].x; ap[1] = h[r].y; ap[2] = h[r].z; ap[3] = h[r].w; } }
        *(LAS f32x4*)(Wb + wk * 32 + 4 * wq) = swr; if (tid < 128) *(LAS f32x4*)(Wb + tid * 32 + 16) = swg;
        LDS_WAIT(); __syncthreads();
        if (st < 15) { swr = *(const f32x4*)(wr + (size_t)(128 * (st + 1) + wk) * 16 + 4 * wq); if (tid < 128) swg = *(const f32x4*)(wg + (size_t)(128 * (st + 1) + tid) * 4); }
#pragma unroll
        for (int m = 0; m < 8; ++m) { const int kk = 16 * wave + 2 * m + (lane >> 5);
            acc = __builtin_amdgcn_mfma_f32_32x32x2f32(Ab[(lane & 31) * APITCH + kk], Wb[kk * 32 + (lane & 31)], acc, 0, 0, 0); }
        __builtin_amdgcn_sched_barrier(0);
    }
    __syncthreads();
    { LAS float* red = (LAS float*)lds;
#pragma unroll
      for (int r = 0; r < 16; ++r) red[(wave * 16 + r) * 64 + lane] = acc[r]; }
    LDS_WAIT(); __syncthreads();
    LAS float* lg = (LAS float*)(lds + 40960);
    for (int i = tid; i < 32 * 20; i += NWAVES * 64) { const int row = i / 20, col = i % 20, ln = col + 32 * ((row >> 2) & 1), rg = (row & 3) + 4 * (row >> 3); float s = 0.f;
#pragma unroll
        for (int w = 0; w < 8; ++w) s += ((LAS float*)lds)[(w * 16 + rg) * 64 + ln];
        lg[i] = s; }
    LDS_WAIT(); __syncthreads();
    if (tid < 32) {
        float l2e = 1.4426950408889634f; asm volatile("" : "+v"(l2e));
        float a[20];
#pragma unroll
        for (int e = 0; e < 20; ++e) a[e] = lg[tid * 20 + e];
        const int row = vcu * 32 + tid;
        float gl[4];
#pragma unroll
        for (int e = 0; e < 4; ++e) gl[e] = a[16 + e] + I.moe_b_group[layer * 4 + e];
        int gi = 0; float gm = gl[0];
#pragma unroll
        for (int e = 1; e < 4; ++e) if (gl[e] > gm) { gm = gl[e]; gi = e; }
        float gs = 0.f;
#pragma unroll
        for (int e = 0; e < 4; ++e) gs += __builtin_amdgcn_exp2f((gl[e] - gm) * l2e);
        const float gprob = __builtin_amdgcn_rcpf(gs);
        float le[4];
#pragma unroll
        for (int e = 0; e < 4; ++e) le[e] = (gi == 0 ? a[e] : gi == 1 ? a[4 + e] : gi == 2 ? a[8 + e] : a[12 + e]) + I.moe_b_router[layer * 16 + gi * 4 + e];
        int i1 = 0; float m1 = le[0];
#pragma unroll
        for (int e = 1; e < 4; ++e) if (le[e] > m1) { m1 = le[e]; i1 = e; }
        int i2 = -1; float m2 = -INFINITY;
#pragma unroll
        for (int e = 0; e < 4; ++e) if (e != i1 && le[e] > m2) { m2 = le[e]; i2 = e; }
        const float p2 = __builtin_amdgcn_exp2f((m2 - m1) * l2e), den = __builtin_amdgcn_rcpf(1.0f + p2);
        const int e1 = gi * 4 + i1, e2 = gi * 4 + i2; const float w1 = gprob * den, w2 = gprob * p2 * den;
        esm[tid * 2] = e1; esm[tid * 2 + 1] = e2; ((LAS float*)esm)[64 + tid * 2] = w1; ((LAS float*)esm)[64 + tid * 2 + 1] = w2;
    }
    LDS_WAIT(); __syncthreads();
    {
        int rk = 0, my = 0;
        if (tid < 64) { my = esm[tid];
            for (int jj = 0; jj < 64; ++jj) rk += (jj < tid && esm[jj] == my) ? 1 : 0; }
        else if (tid < 80) { const int e = tid - 64; int c = 0;
            for (int jj = 0; jj < 64; ++jj) c += (esm[jj] == e) ? 1 : 0;
            esm[128 + e] = c ? (int)atomicAdd((unsigned*)(ws + WS_CTL) + CW_CNT + (layer * 16 + e) * CW_CNT_STRIDE, (unsigned)c) : 0; }
        LDS_WAIT(); __syncthreads();
        if (tid < 64) { const int row = vcu * 32 + (tid >> 1), dst = my * SEG_CAP + esm[128 + my] + rk;
            ((int*)(ws + WS_ROWTOK))[dst] = row * 2 + (tid & 1); ((float*)(ws + WS_ROWW))[dst] = ((LAS float*)esm)[64 + tid]; ((int*)(ws + WS_ROWSRC))[dst] = row; }
    }
    __syncthreads();
}

struct Seg { unsigned cnt[16]; };
__device__ __forceinline__ void seg_load(Seg& s, const unsigned* cnt) {
#pragma unroll
    for (int e = 0; e < 16; ++e) s.cnt[e] = ld_u32_agent(cnt + e * CW_CNT_STRIDE);
}
__device__ __forceinline__ int seg_row_base(const Seg& s, int e) {
    int run = 0, base = 0;
#pragma unroll
    for (int k = 0; k < 16; ++k) { if (k == e) base = run; run += (int)((s.cnt[k] + 255u) >> 8); }
    return base * 256;
}
__device__ __forceinline__ void phase_permute(unsigned char* ws, LAS int* psm  , int layer, int gw, int lane, int tid, int vcu) {
    const int* bc = (const int*)(ws + WS_BCNT) + layer * 256 * 16;
    { const int e = tid & 15, part = tid >> 4; int s = 0, pre = 0;
#pragma unroll
      for (int i = 0; i < 8; ++i) { const int v = part * 8 + i; const int c = bc[v * 16 + e]; s += c; pre += (v < vcu) ? c : 0; }
      psm[part * 16 + e] = s; if (part == (vcu >> 3)) psm[512 + 16 + e] = pre; }
    LDS_WAIT(); __syncthreads();
    if (tid < 16) { int tot = 0, bef = 0;
        for (int p = 0; p < 32; ++p) { const int c = psm[p * 16 + tid]; tot += c; bef += (p < (vcu >> 3)) ? c : 0; }
        psm[512 + tid] = tot; psm[512 + 16 + tid] += bef;
        if (vcu == 0) ((unsigned*)(ws + WS_CTL))[CW_CNT + (layer * 16 + tid) * CW_CNT_STRIDE] = (unsigned)tot; }
    LDS_WAIT(); __syncthreads();
    Seg sg;
#pragma unroll
    for (int e = 0; e < 16; ++e) sg.cnt[e] = (unsigned)psm[512 + e];
    const int* tokE = (const int*)(ws + WS_TOKE); const float* tokW = (const float*)(ws + WS_TOKW); const int* tokS = (const int*)(ws + WS_TOKS);
    int* rowtok = (int*)(ws + WS_ROWTOK); float* roww = (float*)(ws + WS_ROWW); int* rowsrc = (int*)(ws + WS_ROWSRC);
    if (tid < 64) { const int row = vcu * 32 + (tid >> 1), k = tid & 1; const int e = tokE[row * 2 + k], dst = seg_row_base(sg, e) + psm[512 + 16 + e] + tokS[row * 2 + k];
        rowtok[dst] = row * 2 + k; roww[dst] = tokW[row * 2 + k]; rowsrc[dst] = row; }
    if (vcu < 16) { const int e = vcu, c = psm[512 + e], b0 = seg_row_base(sg, e) + c, npad = ((c + 255) & ~255) - c;
        if (tid < npad) rowsrc[b0 + tid] = 0; }
    __syncthreads();
}
__device__ __forceinline__ void build_units(pg8::GroupOrder& S, const Seg& sg, int nN, int G, int c) {
    int nT = 0;
#pragma unroll
    for (int e = 0; e < 16; ++e) { S.cnt[e] = (unsigned)__builtin_amdgcn_readfirstlane((int)sg.cnt[e]); nT += (int)((S.cnt[e] + 255u) >> 8); }
    S.nT = nT; S.nN = nN; S.G = G; S.c = c;
}

__device__ __forceinline__ void phase_lnc(const In& I, unsigned char* ws, int layer, float* xout32  , bf16* xout16  , bool write_h, int gw, int lane) {
    const float* mod = (const float*)(ws + WS_MOD); const bf16* XA = (const bf16*)(ws + WS_XA); const bf16* YS = (const bf16*)(ws + WS_YS); bf16* H = (bf16*)(ws + WS_H);
    const float* lng = I.ln_c_g + layer * DM; const float* lnb = I.ln_c_b + layer * DM;
    const int row0 = gw * 4, b = row0 >> 12;
    const float* gc = mod + (size_t)(layer * 2 + b) * 12288 + 10240;
    const float* shn = mod + (size_t)(2 + b) * 12288; const float* scn = shn + 2048;
    u32x2g rx[2][8], ra[2][8], rc[2][8];
#define LNC_LOAD(pp) do { _Pragma("unroll") for (int r = 0; r < 2; ++r) { const int row = row0 + 2 * (pp) + r; \
        const GAS u32x2g* xr = (const GAS u32x2g*)(XA + (size_t)row * DM) + lane; const GAS u32x2g* s0 = (const GAS u32x2g*)(YS + (size_t)(row * 2) * DM) + lane; const GAS u32x2g* s1 = (const GAS u32x2g*)(YS + (size_t)(row * 2 + 1) * DM) + lane; \
        _Pragma("unroll") for (int j = 0; j < 8; ++j) { rx[r][j] = xr[64 * j]; ra[r][j] = s0[64 * j]; rc[r][j] = s1[64 * j]; } } } while (0)
#pragma unroll 1
    for (int pp = 0; pp < 2; ++pp) {
        LNC_LOAD(pp);
        f32x4 v[2][8]; float s[2] = {0.f, 0.f};
#pragma unroll
        for (int r = 0; r < 2; ++r)
#pragma unroll
            for (int j = 0; j < 8; ++j) { const u32x2g xw = rx[r][j], a = ra[r][j], c = rc[r][j]; const f32x4 g = *(const f32x4*)(gc + 256 * j + 4 * lane);
                const f32x4 x1 = {fa::bflo(xw.x), fa::bfhi(xw.x), fa::bflo(xw.y), fa::bfhi(xw.y)};
                f32x4 m; m.x = fa::bflo(a.x) + fa::bflo(c.x); m.y = fa::bfhi(a.x) + fa::bfhi(c.x); m.z = fa::bflo(a.y) + fa::bflo(c.y); m.w = fa::bfhi(a.y) + fa::bfhi(c.y);
                v[r][j] = x1 * ALPHA_RES + g * m; s[r] += (v[r][j].x + v[r][j].y) + (v[r][j].z + v[r][j].w); }
#pragma unroll
        for (int r = 0; r < 2; ++r) { const int row = row0 + 2 * pp + r;
            const float mean = wave_sum(s[r]) * (1.f / DM); float s2 = 0.f;
#pragma unroll
            for (int j = 0; j < 8; ++j) { v[r][j] = v[r][j] - mean; s2 += (v[r][j].x * v[r][j].x + v[r][j].y * v[r][j].y) + (v[r][j].z * v[r][j].z + v[r][j].w * v[r][j].w); }
            const float rstd = 1.f / sqrtf(wave_sum(s2) * (1.f / DM) + LN_EPS);
            GAS f32x4* xo = (GAS f32x4*)(xout32 + (size_t)row * DM) + lane; GAS unsigned long long* xo16 = (GAS unsigned long long*)(xout16 + (size_t)row * DM) + lane; GAS unsigned long long* ho = (GAS unsigned long long*)(H + (size_t)row * DM) + lane;
#pragma unroll
            for (int j = 0; j < 8; ++j) { const int col = 256 * j + 4 * lane; const f32x4 gg = *(const f32x4*)(lng + col), bb = *(const f32x4*)(lnb + col);
                const f32x4 x2 = v[r][j] * rstd * gg + bb; if (write_h) xo16[64 * j] = (unsigned long long)pk2(x2.x, x2.y) | ((unsigned long long)pk2(x2.z, x2.w) << 32); else xo[64 * j] = x2;
                if (write_h) { const f32x4 sc = *(const f32x4*)(scn + col), sh = *(const f32x4*)(shn + col); const f32x4 h = x2 * (sc + 1.0f) + sh;
                    ho[64 * j] = (unsigned long long)pk2(h.x, h.y) | ((unsigned long long)pk2(h.z, h.w) << 32); } } }
    }
#undef LNC_LOAD
}

__device__ __forceinline__ void phase_cmp2(const In& I, unsigned char* ws, LAS unsigned char* lds, int gw, int NGW, int lane, int tid, int wave) {
    LAS float* hid = (LAS float*)(lds + wave * 1024);
    LAS float* phl = (LAS float*)(lds + 16384);
    for (int which = 0; which < 2; ++which) {
        const float* phi2 = which ? I.nsa_phi_v2 : I.nsa_phi_k2;
        __syncthreads();
        for (int i = tid; i < 256 * 16; i += NWAVES * 64) *(LAS f32x4*)(phl + 4 * i) = *(const f32x4*)(phi2 + 4 * i);
        LDS_WAIT(); __syncthreads();
        for (int task = which * 2048 + gw; task < (which + 1) * 2048; task += NGW) { const int bh = (task >> 8) & 7, n = task & 255;
            bf16* kc = (bf16*)(ws + WS_KCMP); bf16* vct = (bf16*)(ws + WS_VCMPT); float o = 0.f;
            if (n < 255) { const float* UL = (const float*)(ws + (which ? WS_ULV : WS_ULK)); const float* cb = (const float*)(ws + WS_CMPB) + which * 256;
                const f32x4 u = *(const f32x4*)(UL + (size_t)(bh * 256 + n) * 512 + 4 * lane), l = *(const f32x4*)(UL + (size_t)(bh * 256 + n + 1) * 512 + 256 + 4 * lane), bb = *(const f32x4*)(cb + 4 * lane);
                f32x4 h = u + l + bb;
#pragma unroll
                for (int i = 0; i < 4; ++i) h[i] = h[i] / (1.0f + __expf(-h[i]));
                *(LAS f32x4*)(hid + 4 * lane) = h; LDS_WAIT(); asm volatile("" ::: "memory");
                float o0 = 0.f, o1 = 0.f, o2 = 0.f, o3 = 0.f;
#pragma unroll 4
                for (int cidx = 0; cidx < 256; cidx += 4) { const f32x4 hv = *(const LAS f32x4*)(hid + cidx);
                    o0 += hv.x * phl[cidx * 64 + lane]; o1 += hv.y * phl[(cidx + 1) * 64 + lane]; o2 += hv.z * phl[(cidx + 2) * 64 + lane]; o3 += hv.w * phl[(cidx + 3) * 64 + lane]; }
                o = (o0 + o1) + (o2 + o3);
                LDS_WAIT(); asm volatile("" ::: "memory"); }
            if (which == 0) kc[(size_t)(bh * 256 + n) * 64 + lane] = (bf16)f2bf(o); else vct[(size_t)(bh * 64 + lane) * 256 + n] = (bf16)f2bf(o);
        }
    }
    __syncthreads();
}

constexpr int CMP_XS = 0, CMP_TOT = 34816, CMP_K = 45056, CMP_V = 81920, CMP_VP = 528;
__device__ __forceinline__ fa::bf16x8 ov_frag(int d, bool spill_only) {
    fa::u32x4 w = {0u, 0u, 0u, 0u};
    if (!spill_only) {
        if (d == 0) { w.x = 0x3F803F80u; w.y = 0x3F003F80u; }
        else if (d == 1) { w.y = 0x3F000000u; w.z = 0x3F803F80u; w.w = 0x3F003F80u; }
        else if (d == 2) { w.w = 0x3F000000u; } }
    else if (d == 2) w.w = 0x3F000000u;
    return __builtin_bit_cast(fa::bf16x8, w);
}
__device__ __forceinline__ void cmp_unit(unsigned char* ws, LAS unsigned char* lds, int b, int hkv, int tb, int tid, int wave, int lane) {
    const int r32 = lane & 31, hi = lane >> 5, head = hkv * 8 + wave, q0 = tb * 32, t = q0 + r32; const size_t row = (size_t)b * SEQ + t;
    const bf16* Q = (const bf16*)(ws + WS_Q); bf16* OUT = (bf16*)(ws + WS_OCMP);
    LAS float* tot = (LAS float*)(lds + CMP_TOT);
    fa::bf16x8 qr[4]; fa::load_q(qr, Q + row * DM + head * 64, hi);
    {
        const fa::u32x4 mine = __builtin_bit_cast(fa::u32x4, qr[0]); fa::u32x4 oth;
#pragma unroll
        for (int i = 0; i < 4; ++i) { const auto rr = __builtin_amdgcn_permlane32_swap(mine[i], mine[i], false, false); oth[i] = hi ? rr[0] : rr[1]; }
        const float* rp = (const float*)(ws + WS_ROPE) + row * 16; const f32x4 c0 = *(const f32x4*)rp, c1 = *(const f32x4*)(rp + 4), s0 = *(const f32x4*)(rp + 8), s1 = *(const f32x4*)(rp + 12);
        const float sg = hi ? -1.f : 1.f; fa::u32x4 o;
        o.x = fa::cvtpk(fa::bflo(mine.x) * c0.x + sg * fa::bflo(oth.x) * s0.x, fa::bfhi(mine.x) * c0.y + sg * fa::bfhi(oth.x) * s0.y);
        o.y = fa::cvtpk(fa::bflo(mine.y) * c0.z + sg * fa::bflo(oth.y) * s0.z, fa::bfhi(mine.y) * c0.w + sg * fa::bfhi(oth.y) * s0.w);
        o.z = fa::cvtpk(fa::bflo(mine.z) * c1.x + sg * fa::bflo(oth.z) * s1.x, fa::bfhi(mine.z) * c1.y + sg * fa::bfhi(oth.z) * s1.y);
        o.w = fa::cvtpk(fa::bflo(mine.w) * c1.z + sg * fa::bflo(oth.w) * s1.z, fa::bfhi(mine.w) * c1.w + sg * fa::bfhi(oth.w) * s1.w);
        qr[0] = __builtin_bit_cast(fa::bf16x8, o); }
    fa::State st; st.o0 = fa::f32x16{}; st.o1 = fa::f32x16{}; st.m = fa::NEGBIG; st.l = 0.f;
    fa::f32x16 impA = fa::f32x16{}, impB = fa::f32x16{};
    const int nhi = (t - 31) >> 4;
    const int nhi_min = (q0 - 31) >> 4;
    const int ntile = ((2 * tb) >> 5) + 1;
    const LAS unsigned char* kl = lds + CMP_K + fa::kap(r32) * 144 + hi * 16;
    const LAS unsigned char* vl = lds + CMP_V + r32 * CMP_VP + hi * 16;
    for (int kt = 0; kt < ntile; ++kt) {
        fa::Frag f;
#pragma unroll
        for (int d0 = 0; d0 < 4; ++d0) f.k[d0] = *(const LAS fa::bf16x8*)(kl + kt * 32 * 144 + d0 * 32);
#pragma unroll
        for (int db = 0; db < 2; ++db)
#pragma unroll
            for (int sx = 0; sx < 2; ++sx) f.v[db * 2 + sx] = *(const LAS fa::bf16x8*)(vl + db * 32 * CMP_VP + kt * 64 + sx * 32);
        fa::f32x16 p; fa::scores(p, f, qr);
        if (kt * 32 + 31 > nhi_min) fa::mask_range(p, kt * 32, hi, 0, nhi);
        float tm = fmaxf(p[0], p[1]);
#pragma unroll
        for (int r = 2; r < 16; ++r) tm = fmaxf(tm, p[r]);
        tm = fa::xmax(tm);
        const float mn = fmaxf(st.m, tm); const float alpha = __builtin_amdgcn_exp2f(st.m - mn); st.m = mn;
        float rs = 0.f;
#pragma unroll
        for (int r = 0; r < 16; ++r) { p[r] = __builtin_amdgcn_exp2f(p[r] - mn); rs += p[r]; }
        st.l = st.l * alpha + rs;
        if (!__all(alpha == 1.0f)) { st.o0 = st.o0 * alpha; st.o1 = st.o1 * alpha; impA = impA * alpha; impB = impB * alpha; }
        fa::u32x4 w0, w1;
        w0.x = fa::cvtpk(p[0], p[1]); w0.y = fa::cvtpk(p[2], p[3]); w0.z = fa::cvtpk(p[4], p[5]); w0.w = fa::cvtpk(p[6], p[7]);
        w1.x = fa::cvtpk(p[8], p[9]); w1.y = fa::cvtpk(p[10], p[11]); w1.z = fa::cvtpk(p[12], p[13]); w1.w = fa::cvtpk(p[14], p[15]);
        const fa::bf16x8 pb0 = __builtin_bit_cast(fa::bf16x8, w0), pb1 = __builtin_bit_cast(fa::bf16x8, w1);
        st.o0 = __builtin_amdgcn_mfma_f32_32x32x16_bf16(f.v[0], pb0, st.o0, 0, 0, 0);
        st.o0 = __builtin_amdgcn_mfma_f32_32x32x16_bf16(f.v[1], pb1, st.o0, 0, 0, 0);
        st.o1 = __builtin_amdgcn_mfma_f32_32x32x16_bf16(f.v[2], pb0, st.o1, 0, 0, 0);
        st.o1 = __builtin_amdgcn_mfma_f32_32x32x16_bf16(f.v[3], pb1, st.o1, 0, 0, 0);
        { const int T = kt >> 2, S = 32 * T + r32;
          const fa::bf16x8 o0f = ov_frag(S - (8 * kt + 2 * hi), false), o1f = ov_frag(S - (8 * kt + 4 + 2 * hi), false);
          if (T == 0) { impA = __builtin_amdgcn_mfma_f32_32x32x16_bf16(o0f, pb0, impA, 0, 0, 0); impA = __builtin_amdgcn_mfma_f32_32x32x16_bf16(o1f, pb1, impA, 0, 0, 0); }
          else        { impB = __builtin_amdgcn_mfma_f32_32x32x16_bf16(o0f, pb0, impB, 0, 0, 0); impB = __builtin_amdgcn_mfma_f32_32x32x16_bf16(o1f, pb1, impB, 0, 0, 0); }
          if (kt == 3) {
              const fa::bf16x8 sp = ov_frag((r32 == 0 && hi == 1) ? 2 : 9, true);
              impB = __builtin_amdgcn_mfma_f32_32x32x16_bf16(sp, pb1, impB, 0, 0, 0); } }
    }
    const float inv = fa::finish(st);
    fa::store_o(st, inv, OUT + row * DM + head * 64, hi);
    LAS float* xs = (LAS float*)(lds + CMP_XS) + (wave & 3) * (32 * 66) + r32 * 66 + 4 * hi;
#define CMP_XW(EXPR_A, EXPR_B) do { _Pragma("unroll") for (int r = 0; r < 16; ++r) { const int sl = (r & 3) + 8 * (r >> 2); xs[sl] = (EXPR_A); xs[32 + sl] = (EXPR_B); } } while (0)
    if (wave >= 4) CMP_XW(impA[r] * inv, impB[r] * inv);
    LDS_WAIT(); __syncthreads();
    if (wave < 4) CMP_XW(impA[r] * inv + xs[sl], impB[r] * inv + xs[32 + sl]);
#undef CMP_XW
    LDS_WAIT(); __syncthreads();
    for (int i = tid; i < 32 * 64; i += NWAVES * 64) { const int q = i >> 6, j = i & 63; float s = 0.f;
#pragma unroll
        for (int w = 0; w < 4; ++w) s += ((LAS float*)(lds + CMP_XS))[w * (32 * 66) + q * 66 + j];
        const int tq = q0 + q, cur = tq >> 6; const bool causal = j * 64 <= tq, forced = (j == 0) || (j == cur) || (j == cur - 1);
        tot[q * 68 + j] = causal ? s + (forced ? 1e4f : 0.f) : -1e30f; }
    LDS_WAIT(); __syncthreads();
    {
        const int q = tid >> 4, part = tid & 15, tq = q0 + q;
        float sc[4];
#pragma unroll
        for (int i = 0; i < 4; ++i) sc[i] = tot[q * 68 + 4 * part + i];
        int rk[4] = {0, 0, 0, 0};
#pragma unroll 8
        for (int jp = 0; jp < 64; ++jp) { const float sp = tot[q * 68 + jp];
#pragma unroll
            for (int i = 0; i < 4; ++i) { const int j = 4 * part + i; rk[i] += (sp > sc[i] || (sp == sc[i] && jp < j)) ? 1 : 0; } }
        unsigned lo = 0u, hi32 = 0u;
#pragma unroll
        for (int i = 0; i < 4; ++i) { const int j = 4 * part + i; if (rk[i] < 16) { if (j < 32) lo |= 1u << j; else hi32 |= 1u << (j - 32); } }
#pragma unroll
        for (int o = 1; o < 16; o <<= 1) { lo |= __shfl_xor(lo, o); hi32 |= __shfl_xor(hi32, o); }
        if (part == 0) ((unsigned long long*)(ws + WS_SELM))[(size_t)(b * 4 + hkv) * SEQ + tq] = ((unsigned long long)hi32 << 32) | lo;
    }
    __syncthreads();
}

__device__ __forceinline__ void sel_unit(unsigned char* ws, int b, int hkv, int tb, int wave, int lane) {
    const int r32 = lane & 31, hi = lane >> 5, head = hkv * 8 + wave, q0 = tb * 32, t = q0 + r32; const size_t row = (size_t)b * SEQ + t;
    const bf16* Q = (const bf16*)(ws + WS_Q); bf16* OUT = (bf16*)(ws + WS_ATT);
    const bf16* Kbh = (const bf16*)(ws + WS_KS) + (size_t)(b * 4 + hkv) * SEQ * 64; const bf16* Vbh = (const bf16*)(ws + WS_VST) + (size_t)(b * 4 + hkv) * 64 * SEQ;
    const unsigned long long selm = ((const unsigned long long*)(ws + WS_SELM))[(size_t)(b * 4 + hkv) * SEQ + t];
    unsigned ulo = (unsigned)selm, uhi = (unsigned)(selm >> 32);
#pragma unroll
    for (int o = 1; o < 64; o <<= 1) { ulo |= __shfl_xor(ulo, o); uhi |= __shfl_xor(uhi, o); }
    const unsigned long long U = ((unsigned long long)(unsigned)__builtin_amdgcn_readfirstlane((int)uhi) << 32) | (unsigned)__builtin_amdgcn_readfirstlane((int)ulo);
    fa::bf16x8 qr[4]; fa::load_q(qr, Q + row * DM + head * 64, hi);
    fa::State st; st.o0 = fa::f32x16{}; st.o1 = fa::f32x16{}; st.m = fa::NEGBIG; st.l = 0.f;
    int kt = 0; while (kt <= tb && !((U >> (kt >> 1)) & 1ull)) ++kt;
    fa::Frag fc, fn; if (kt <= tb) fa::load_tile(fc, Kbh, Vbh, SEQ, kt * 32, r32, hi);
    while (kt <= tb) {
        int kn = kt + 1; while (kn <= tb && !((U >> (kn >> 1)) & 1ull)) ++kn;
        if (kn <= tb) fa::load_tile(fn, Kbh, Vbh, SEQ, kn * 32, r32, hi);
        const bool mine = (selm >> (kt >> 1)) & 1ull;
        const bool nm = (kt == tb) || !__all(mine);
        fa::step(st, fc, qr, kt * 32, hi, nm, 0, mine ? t : -1);
        fc = fn; kt = kn;
    }
    const float inv = fa::finish(st);
    const float* gates = (const float*)(ws + WS_GATES) + row * 96 + head * 3; const float g0 = gates[0], g1 = gates[1] * inv, g2 = gates[2];
    const bf16* oc = (const bf16*)(ws + WS_OCMP) + row * DM + head * 64; const bf16* ow = (const bf16*)(ws + WS_OWIN) + row * DM + head * 64; bf16* od = OUT + row * DM + head * 64;
#pragma unroll
    for (int g = 0; g < 4; ++g)
#pragma unroll
        for (int db = 0; db < 2; ++db) { const int d = 32 * db + 8 * g + 4 * hi; const u32x2g c = *(const u32x2g*)(oc + d), w = *(const u32x2g*)(ow + d);
            const fa::f32x16& oo = db ? st.o1 : st.o0;
            const float v0 = g0 * fa::bflo(c.x) + g1 * oo[4 * g] + g2 * fa::bflo(w.x), v1 = g0 * fa::bfhi(c.x) + g1 * oo[4 * g + 1] + g2 * fa::bfhi(w.x);
            const float v2 = g0 * fa::bflo(c.y) + g1 * oo[4 * g + 2] + g2 * fa::bflo(w.y), v3 = g0 * fa::bfhi(c.y) + g1 * oo[4 * g + 3] + g2 * fa::bfhi(w.y);
            u32x2g o; o.x = fa::cvtpk(v0, v1); o.y = fa::cvtpk(v2, v3); *(u32x2g*)(od + d) = o; }
}
namespace fb {
using fa::bf16x8; using fa::f32x16; using fa::u32x4;
constexpr int PITCH = 144, TILE = 64 * PITCH, BUF = 2 * TILE;
struct Stage { v4u k, v; };
__device__ __forceinline__ void stage_load(Stage& s, const bf16* Kbh, const bf16* Vbh, int VP, int key0, int tid) {
    const int row = tid >> 3, ch = tid & 7;
    s.k = *(const GAS v4u*)(Kbh + (size_t)(key0 + row) * 64 + ch * 8);
    s.v = *(const GAS v4u*)(Vbh + (size_t)row * VP + key0 + ch * 8);
}
__device__ __forceinline__ void stage_store(const Stage& s, LAS unsigned char* lds, int buf, int tid) {
    const int row = tid >> 3, ch = tid & 7; LAS unsigned char* p = lds + buf * BUF + row * PITCH + ch * 16;
    *(LAS v4u*)p = s.k; *(LAS v4u*)(p + TILE) = s.v;
}
__device__ __forceinline__ void frag_load_k(bf16x8 (&k)[8], const LAS unsigned char* lds, int buf, int r32, int hi) {
    const LAS unsigned char* kb = lds + buf * BUF + fa::kap(r32) * PITCH + hi * 16;
#pragma unroll
    for (int h = 0; h < 2; ++h)
#pragma unroll
        for (int d0 = 0; d0 < 4; ++d0) k[h * 4 + d0] = *(const LAS bf16x8*)(kb + h * 32 * PITCH + d0 * 32);
}
__device__ __forceinline__ void frag_load_v(bf16x8 (&v)[8], const LAS unsigned char* lds, int buf, int r32, int hi) {
    const LAS unsigned char* vb = lds + buf * BUF + TILE + r32 * PITCH + hi * 16;
#pragma unroll
    for (int db = 0; db < 2; ++db)
#pragma unroll
        for (int h = 0; h < 2; ++h)
#pragma unroll
            for (int s = 0; s < 2; ++s) v[(db * 2 + h) * 2 + s] = *(const LAS bf16x8*)(vb + db * 32 * PITCH + h * 64 + s * 32);
}
struct QState { f32x16 o0, o1; float m, l; };
__device__ __forceinline__ void block_step(QState& st, const LAS unsigned char* lds, int buf, int r32, const LAS unsigned char* qlds  , int key0, int hi, bool sel, bool emask, int lo, int hi_) {
    f32x16 p0 = f32x16{}, p1 = f32x16{};
    { bf16x8 fk[8], qr[4]; frag_load_k(fk, lds, buf, r32, hi);
#pragma unroll
      for (int d0 = 0; d0 < 4; ++d0) qr[d0] = *(const LAS bf16x8*)(qlds + d0 * 1024);
#pragma unroll
    for (int d0 = 0; d0 < 4; ++d0) { p0 = __builtin_amdgcn_mfma_f32_32x32x16_bf16(fk[d0], qr[d0], p0, 0, 0, 0); p1 = __builtin_amdgcn_mfma_f32_32x32x16_bf16(fk[4 + d0], qr[d0], p1, 0, 0, 0); } }
    if (emask) { fa::mask_range(p0, key0, hi, lo, hi_); fa::mask_range(p1, key0 + 32, hi, lo, hi_); }
    float ta = fmaxf(p0[0], p0[1]), tb = fmaxf(p1[0], p1[1]);
#pragma unroll
    for (int r = 2; r < 16; ++r) { ta = fmaxf(ta, p0[r]); tb = fmaxf(tb, p1[r]); }
    const float tm = fa::xmax(fmaxf(ta, tb));
    const float mn = sel ? fmaxf(st.m, tm) : st.m; const float alpha = __builtin_amdgcn_exp2f(st.m - mn); st.m = mn;
    const float me = sel ? mn : INFINITY;
    float rs0 = 0.f, rs1 = 0.f;
#pragma unroll
    for (int r = 0; r < 16; ++r) { p0[r] = __builtin_amdgcn_exp2f(p0[r] - me); p1[r] = __builtin_amdgcn_exp2f(p1[r] - me); rs0 += p0[r]; rs1 += p1[r]; }
#if defined(ATT_PROBE) && ATT_PROBE == 1
    {
#pragma unroll
      for (int r = 0; r < 32; ++r) { float d_; asm volatile("v_exp_f32 %0, %1" : "=v"(d_) : "v"(p0[r & 15])); } }
#endif
    st.l = st.l * alpha + (rs0 + rs1);
    if (!__all(alpha == 1.0f)) { st.o0 = st.o0 * alpha; st.o1 = st.o1 * alpha; }
    u32x4 w;
    w.x = fa::cvtpk(p0[0], p0[1]); w.y = fa::cvtpk(p0[2], p0[3]); w.z = fa::cvtpk(p0[4], p0[5]); w.w = fa::cvtpk(p0[6], p0[7]); const bf16x8 a0 = __builtin_bit_cast(bf16x8, w);
    w.x = fa::cvtpk(p0[8], p0[9]); w.y = fa::cvtpk(p0[10], p0[11]); w.z = fa::cvtpk(p0[12], p0[13]); w.w = fa::cvtpk(p0[14], p0[15]); const bf16x8 a1 = __builtin_bit_cast(bf16x8, w);
    w.x = fa::cvtpk(p1[0], p1[1]); w.y = fa::cvtpk(p1[2], p1[3]); w.z = fa::cvtpk(p1[4], p1[5]); w.w = fa::cvtpk(p1[6], p1[7]); const bf16x8 b0 = __builtin_bit_cast(bf16x8, w);
    w.x = fa::cvtpk(p1[8], p1[9]); w.y = fa::cvtpk(p1[10], p1[11]); w.z = fa::cvtpk(p1[12], p1[13]); w.w = fa::cvtpk(p1[14], p1[15]); const bf16x8 b1 = __builtin_bit_cast(bf16x8, w);
    bf16x8 fv[8]; frag_load_v(fv, lds, buf, r32, hi);
#if defined(ATT_PROBE) && ATT_PROBE == 2
    { f32x16 dm = f32x16{};
#pragma unroll
      for (int r = 0; r < 8; ++r) dm = __builtin_amdgcn_mfma_f32_32x32x16_bf16(fv[r], a0, dm, 0, 0, 0);
      asm volatile("" :: "v"(dm)); }
#endif
#if defined(ATT_PROBE) && ATT_PROBE == 3
    { bf16x8 fx[8]; frag_load_k(fx, lds, buf, r32 ^ 1, hi);
#pragma unroll
      for (int r = 0; r < 8; ++r) asm volatile("" :: "v"(fx[r])); }
#endif
    st.o0 = __builtin_amdgcn_mfma_f32_32x32x16_bf16(fv[0], a0, st.o0, 0, 0, 0); st.o1 = __builtin_amdgcn_mfma_f32_32x32x16_bf16(fv[4], a0, st.o1, 0, 0, 0);
    st.o0 = __builtin_amdgcn_mfma_f32_32x32x16_bf16(fv[1], a1, st.o0, 0, 0, 0); st.o1 = __builtin_amdgcn_mfma_f32_32x32x16_bf16(fv[5], a1, st.o1, 0, 0, 0);
    st.o0 = __builtin_amdgcn_mfma_f32_32x32x16_bf16(fv[2], b0, st.o0, 0, 0, 0); st.o1 = __builtin_amdgcn_mfma_f32_32x32x16_bf16(fv[6], b0, st.o1, 0, 0, 0);
    st.o0 = __builtin_amdgcn_mfma_f32_32x32x16_bf16(fv[3], b1, st.o0, 0, 0, 0); st.o1 = __builtin_amdgcn_mfma_f32_32x32x16_bf16(fv[7], b1, st.o1, 0, 0, 0);
}
__device__ __forceinline__ void qk2(f32x16& pa0, f32x16& pa1, f32x16& pb0, f32x16& pb1, const LAS unsigned char* lds, int buf, int r32, const LAS unsigned char* qpark, int hi) {
    pa0 = f32x16{}; pa1 = f32x16{}; pb0 = f32x16{}; pb1 = f32x16{};
    { bf16x8 fk[8]; frag_load_k(fk, lds, buf, r32, hi);
#pragma unroll
      for (int d0 = 0; d0 < 4; ++d0) { const bf16x8 qa = *(const LAS bf16x8*)(qpark + d0 * 1024);
          pa0 = __builtin_amdgcn_mfma_f32_32x32x16_bf16(fk[d0], qa, pa0, 0, 0, 0); pa1 = __builtin_amdgcn_mfma_f32_32x32x16_bf16(fk[4 + d0], qa, pa1, 0, 0, 0); }
#pragma unroll
      for (int d0 = 0; d0 < 4; ++d0) { const bf16x8 qb = *(const LAS bf16x8*)(qpark + 4096 + d0 * 1024);
          pb0 = __builtin_amdgcn_mfma_f32_32x32x16_bf16(fk[d0], qb, pb0, 0, 0, 0); pb1 = __builtin_amdgcn_mfma_f32_32x32x16_bf16(fk[4 + d0], qb, pb1, 0, 0, 0); } }
}
__device__ __forceinline__ void sp2(QState& s0, QState& s1, f32x16& pa0, f32x16& pa1, f32x16& pb0, f32x16& pb1, const LAS unsigned char* lds, int buf, int r32, int key0, int hi,
                                    bool sel0, bool sel1, bool emask, int lo0, int hi0, int lo1, int hi1) {
    bf16x8 fv[8];
#define SP_(st, p0, p1, sel, lo, hi_, LOADV) do { \
    if (emask) { fa::mask_range(p0, key0, hi, lo, hi_); fa::mask_range(p1, key0 + 32, hi, lo, hi_); } \
    float ta = fmaxf(p0[0], p0[1]), tb = fmaxf(p1[0], p1[1]); \
    _Pragma("unroll") for (int r = 2; r < 16; ++r) { ta = fmaxf(ta, p0[r]); tb = fmaxf(tb, p1[r]); } \
    const float tm = fa::xmax(fmaxf(ta, tb)); \
    const float mn = sel ? fmaxf(st.m, tm) : st.m; const float alpha = __builtin_amdgcn_exp2f(st.m - mn); st.m = mn; \
    const float me = sel ? mn : INFINITY; \
    float rs0 = 0.f, rs1 = 0.f; \
    _Pragma("unroll") for (int r = 0; r < 16; ++r) { p0[r] = __builtin_amdgcn_exp2f(p0[r] - me); p1[r] = __builtin_amdgcn_exp2f(p1[r] - me); rs0 += p0[r]; rs1 += p1[r]; } \
    st.l = st.l * alpha + (rs0 + rs1); \
    if (!__all(alpha == 1.0f)) { st.o0 = st.o0 * alpha; st.o1 = st.o1 * alpha; } \
    u32x4 w; \
    w.x = fa::cvtpk(p0[0], p0[1]); w.y = fa::cvtpk(p0[2], p0[3]); w.z = fa::cvtpk(p0[4], p0[5]); w.w = fa::cvtpk(p0[6], p0[7]); const bf16x8 a0 = __builtin_bit_cast(bf16x8, w); \
    w.x = fa::cvtpk(p0[8], p0[9]); w.y = fa::cvtpk(p0[10], p0[11]); w.z = fa::cvtpk(p0[12], p0[13]); w.w = fa::cvtpk(p0[14], p0[15]); const bf16x8 a1 = __builtin_bit_cast(bf16x8, w); \
    w.x = fa::cvtpk(p1[0], p1[1]); w.y = fa::cvtpk(p1[2], p1[3]); w.z = fa::cvtpk(p1[4], p1[5]); w.w = fa::cvtpk(p1[6], p1[7]); const bf16x8 b0 = __builtin_bit_cast(bf16x8, w); \
    w.x = fa::cvtpk(p1[8], p1[9]); w.y = fa::cvtpk(p1[10], p1[11]); w.z = fa::cvtpk(p1[12], p1[13]); w.w = fa::cvtpk(p1[14], p1[15]); const bf16x8 b1 = __builtin_bit_cast(bf16x8, w); \
    if (LOADV) { __builtin_amdgcn_sched_barrier(0); frag_load_v(fv, lds, buf, r32, hi); } \
    st.o0 = __builtin_amdgcn_mfma_f32_32x32x16_bf16(fv[0], a0, st.o0, 0, 0, 0); st.o1 = __builtin_amdgcn_mfma_f32_32x32x16_bf16(fv[4], a0, st.o1, 0, 0, 0); \
    st.o0 = __builtin_amdgcn_mfma_f32_32x32x16_bf16(fv[1], a1, st.o0, 0, 0, 0); st.o1 = __builtin_amdgcn_mfma_f32_32x32x16_bf16(fv[5], a1, st.o1, 0, 0, 0); \
    st.o0 = __builtin_amdgcn_mfma_f32_32x32x16_bf16(fv[2], b0, st.o0, 0, 0, 0); st.o1 = __builtin_amdgcn_mfma_f32_32x32x16_bf16(fv[6], b0, st.o1, 0, 0, 0); \
    st.o0 = __builtin_amdgcn_mfma_f32_32x32x16_bf16(fv[3], b1, st.o0, 0, 0, 0); st.o1 = __builtin_amdgcn_mfma_f32_32x32x16_bf16(fv[7], b1, st.o1, 0, 0, 0); } while (0)
    SP_(s0, pa0, pa1, sel0, lo0, hi0, true);
    __builtin_amdgcn_sched_barrier(0);
    SP_(s1, pb0, pb1, sel1, lo1, hi1, false);
#undef SP_
}
__device__ __forceinline__ float finish(QState& st) { const float lt = fa::xsum(st.l); return lt > 0.f ? 1.0f / lt : 0.f; }
}

template <int MODE, int W>
__device__ __forceinline__ void attn64_unit(unsigned char* ws, LAS unsigned char* lds, int b, int hkv, int c, int tid, int wave, int lane, const bf16* Q, const bf16* K, const bf16* VT, bf16* OUT, const float* sinks) {
    const int r32 = lane & 31, hi = lane >> 5, head = hkv * 8 + wave, q0 = c * 64;
    const bf16* Kbh = K + (size_t)(b * 4 + hkv) * SEQ * 64; const bf16* Vbh = VT + (size_t)(b * 4 + hkv) * 64 * SEQ;
    fb::QState st[2]; unsigned long long selm[2] = {~0ull, ~0ull};
    LAS unsigned char* qpark = lds + 2 * fb::BUF + wave * 8192 + lane * 16;
#pragma unroll
    for (int g = 0; g < 2; ++g) { const size_t row = (size_t)b * SEQ + q0 + 32 * g + r32;
        { fa::bf16x8 qr[4]; fa::load_q(qr, Q + row * DM + head * 64, hi);
#pragma unroll
          for (int d0 = 0; d0 < 4; ++d0) *(LAS fa::bf16x8*)(qpark + (g * 4 + d0) * 1024) = qr[d0]; }
        st[g].o0 = fa::f32x16{}; st[g].o1 = fa::f32x16{};
        if (MODE == 0) { st[g].m = sinks[head] * LOG2E; st[g].l = hi == 0 ? 1.0f : 0.0f; } else { st[g].m = fa::NEGBIG; st[g].l = 0.f; }
        if (MODE == 2) { const unsigned long long sm = ((const unsigned long long*)(ws + WS_SELM))[(size_t)(b * 4 + hkv) * SEQ + q0 + 32 * g + r32];
            unsigned lo_ = (unsigned)sm, hi_ = (unsigned)(sm >> 32), lo2, hi2;
            asm volatile("v_mov_b32 %0, %2\n\tv_mov_b32 %1, %3" : "=&v"(lo2), "=&v"(hi2) : "v"(lo_), "v"(hi_));
            selm[g] = ((unsigned long long)hi2 << 32) | lo2; } }
    const int jlo = (MODE == 2) ? 0 : (c - W / 64 > 0 ? c - W / 64 : 0);
    fb::Stage sg; fb::stage_load(sg, Kbh, Vbh, SEQ, jlo * 64, tid); fb::stage_store(sg, lds, 0, tid);
    LDS_WAIT(); __syncthreads();
    for (int j = jlo; j <= c; ++j) {
        const int buf = (j - jlo) & 1;
        const bool em = (j == c) || (MODE != 2 && j == c - W / 64);
        if (MODE == 0) {
          if (j < c) fb::stage_load(sg, Kbh, Vbh, SEQ, (j + 1) * 64, tid);
#pragma unroll
          for (int g = 0; g < 2; ++g) { const int t = q0 + 32 * g + r32;
              fb::block_step(st[g], lds, buf, r32, qpark + g * 4096, j * 64, hi, true, em, t - W + 1, t);
              __builtin_amdgcn_sched_barrier(0); }
        } else { const int t0 = q0 + r32, t1 = t0 + 32;
          const bool sel0 = (MODE == 2) ? (bool)((selm[0] >> j) & 1ull) : true, sel1 = (MODE == 2) ? (bool)((selm[1] >> j) & 1ull) : true;
          fa::f32x16 pa0, pa1, pb0, pb1;
          fb::qk2(pa0, pa1, pb0, pb1, lds, buf, r32, qpark, hi);
          __builtin_amdgcn_sched_barrier(0);
          if (j < c) fb::stage_load(sg, Kbh, Vbh, SEQ, (j + 1) * 64, tid);
          fb::sp2(st[0], st[1], pa0, pa1, pb0, pb1, lds, buf, r32, j * 64, hi, sel0, sel1, em, (MODE == 2) ? 0 : t0 - W + 1, t0, (MODE == 2) ? 0 : t1 - W + 1, t1);
          __builtin_amdgcn_sched_barrier(0); }
        if (j < c) fb::stage_store(sg, lds, buf ^ 1, tid);
        LDS_WAIT(); __syncthreads();
    }
#pragma unroll
    for (int g = 0; g < 2; ++g) { const size_t row = (size_t)b * SEQ + q0 + 32 * g + r32; const float inv = fb::finish(st[g]);
        if (MODE != 2) { fa::State so; so.o0 = st[g].o0; so.o1 = st[g].o1; fa::store_o(so, inv, OUT + row * DM + head * 64, hi); }
        else {
            const float* gates = (const float*)(ws + WS_GATES) + row * 96 + head * 3; const float g0 = gates[0], g1 = gates[1] * inv, g2 = gates[2];
            const bf16* oc = (const bf16*)(ws + WS_OCMP) + row * DM + head * 64; const bf16* ow = (const bf16*)(ws + WS_OWIN) + row * DM + head * 64; bf16* od = OUT + row * DM + head * 64;
#pragma unroll
            for (int gg = 0; gg < 4; ++gg)
#pragma unroll
                for (int db = 0; db < 2; ++db) { const int d = 32 * db + 8 * gg + 4 * hi; const u32x2g cc = *(const u32x2g*)(oc + d), w = *(const u32x2g*)(ow + d);
                    const fa::f32x16& oo = db ? st[g].o1 : st[g].o0;
                    const float v0 = g0 * fa::bflo(cc.x) + g1 * oo[4 * gg] + g2 * fa::bflo(w.x), v1 = g0 * fa::bfhi(cc.x) + g1 * oo[4 * gg + 1] + g2 * fa::bfhi(w.x);
                    const float v2 = g0 * fa::bflo(cc.y) + g1 * oo[4 * gg + 2] + g2 * fa::bflo(w.y), v3 = g0 * fa::bfhi(cc.y) + g1 * oo[4 * gg + 3] + g2 * fa::bfhi(w.y);
                    u32x2g o; o.x = fa::cvtpk(v0, v1); o.y = fa::cvtpk(v2, v3); *(u32x2g*)(od + d) = o; }
        }
    }
}
template <int MODE, int W>
__device__ __forceinline__ void phase_attn64(unsigned char* ws, LAS unsigned char* lds, int vcu, int tid, int wave, int lane, const bf16* Q, const bf16* K, const bf16* VT, bf16* OUT, const float* sinks) {
    const int bh = (vcu >> 5) & 7, x = vcu & 31;
#pragma unroll 1
    for (int i = 0; i < 2; ++i) attn64_unit<MODE, W>(ws, lds, bh >> 2, bh & 3, i ? 63 - x : x, tid, wave, lane, Q, K, VT, OUT, sinks);
}
__device__ __forceinline__ int mk_lane() { int l; asm volatile("v_mbcnt_lo_u32_b32 %0, -1, 0\n\tv_mbcnt_hi_u32_b32 %0, -1, %0" : "=v"(l)); return l; }
typedef const void* const __attribute__((address_space(4))) * karg_ptr_t;
__device__ __forceinline__ void load_in(In& I) {
    karg_ptr_t ap = (karg_ptr_t)__builtin_amdgcn_kernarg_segment_ptr(); asm volatile("" : "+s"(ap));
#define GP(T, k) ((const T*)(const GAS T*)(unsigned long long)ap[k])
    I.x = GP(float, 0); I.c = GP(float, 1); I.positions = GP(int, 2); I.w_ada = GP(float, 3); I.b_ada = GP(float, 4);
    I.swa_w_qkv = GP(float, 5); I.swa_b_qkv = GP(float, 6); I.swa_sinks = GP(float, 7); I.swa_w_o = GP(float, 8);
    I.nsa_w_in = GP(float, 9); I.nsa_pe_k = GP(float, 10); I.nsa_pe_v = GP(float, 11); I.nsa_phi_k1 = GP(float, 12); I.nsa_phi_k2 = GP(float, 13);
    I.nsa_phi_v1 = GP(float, 14); I.nsa_phi_v2 = GP(float, 15); I.nsa_w_o = GP(float, 16);
    I.moe_w_group = GP(float, 17); I.moe_b_group = GP(float, 18); I.moe_w_router = GP(float, 19); I.moe_b_router = GP(float, 20);
    I.moe_w1 = GP(float, 21); I.moe_w3 = GP(float, 22); I.moe_w2 = GP(float, 23);
    I.ln_t_g = GP(float, 24); I.ln_t_b = GP(float, 25); I.ln_c_g = GP(float, 26); I.ln_c_b = GP(float, 27);
#undef GP
}
struct Args { const void* in[28]; float* out; unsigned char* ws; int ph_lo, ph_hi, li, pad; };
__global__ void __launch_bounds__(NWAVES * 64, 2) hyb_fwd(Args args) {
    extern __shared__ __attribute__((aligned(16))) unsigned char lds_raw[];
    LAS unsigned char* lds = (LAS unsigned char*)lds_raw;
    volatile LAS unsigned* MISC = (volatile LAS unsigned*)(lds + MISC_OFF);
    const int wave_s = __builtin_amdgcn_readfirstlane((int)threadIdx.x >> 6);
#define MK_TID() (wave_s * 64 + mk_lane())
    const int G0 = gridDim.x, bx0 = blockIdx.x; const int vcu0 = (G0 % 8 == 0) ? (bx0 % 8) * (G0 / 8) + bx0 / 8 : bx0;
    unsigned char* const ws0 = args.ws; gu32* ctl = (gu32*)(ws0 + WS_CTL);
    for (int u = MK_TID(); u < (LDS_BYTES - LDSCTL_OFF) / 4; u += NWAVES * 64) ((LAS unsigned*)(lds + LDSCTL_OFF))[u] = 0u;
    __syncthreads();
    XcdBarrier bar; bar.bar = (unsigned*)(ctl + CW_BAR); bar.x = 0; bar.st = nullptr;
    if (N_LAUNCHES == 1) bar = xcd_barrier_post((unsigned*)(ctl + CW_BAR), MISC + 8, MK_TID());
#if MK_N_LAUNCHES == 1
    constexpr int lo = 0, hi = NPHASE;
#else
    const int lo = args.ph_lo, hi = args.ph_hi;
#endif
    float* const out0 = args.out;
    if (lo == 0) { In I; load_in(I); rope_table(I.positions, (float*)(ws0 + WS_ROPE), vcu0 * (NWAVES * 64) + MK_TID(), G0 * NWAVES * 64); }
#ifdef FULL_TWICE
#pragma unroll 1
    for (int pass_ = 0; pass_ < 2; ++pass_) {
    if (pass_) { XcdBarrier b3 = bar; asm volatile("" : "+s"(b3.bar)); xcd_barrier(b3, MK_TID()); }
#endif
#pragma unroll 1
    for (int ph = lo; ph < hi; ++ph) {
        if (ph == 6 || ph == 17) continue;
#ifdef DOUBLE_MASK
        const int nrep = ((DOUBLE_MASK >> ph) & 1) ? 2 : 1;
#else
        const int nrep = 1;
#endif
#pragma unroll 1
        for (int rep = 0; rep < nrep; ++rep) {
        if (rep) __syncthreads();
        unsigned long long wsi = (unsigned long long)ws0, outi = (unsigned long long)out0; int G = G0, bx = bx0, vcu = vcu0; int phx = ph;
        int tid = MK_TID();
        asm volatile("" : "+s"(wsi), "+s"(G), "+s"(bx), "+s"(vcu), "+s"(outi), "+s"(phx), "+v"(tid));
        unsigned char* ws = (unsigned char*)(GAS unsigned char*)wsi; float* outp = (float*)(GAS float*)outi;
#ifdef ONLYP
        phx = ONLYP;
#endif
        const int lane = tid & 63, wave = __builtin_amdgcn_readfirstlane(tid >> 6);
#if defined(FULL_TWICE) && defined(SKIP2_MASK)
        if (pass_ == 1 && ((SKIP2_MASK >> ph) & 1)) phx = 99;
#endif
#if defined(FULL_TWICE) && defined(ABLATE)
        const int ablate_ = pass_ == 1 ? ABLATE : 0;
#else
        const int ablate_ = 0;
#endif
        const int gw = vcu * NWAVES + wave, NGW = G * NWAVES;
        const int layer = phx >= 10 ? 1 : 0, cp = phx - (layer ? 15 : 4);
        switch (phx) {
        case 0: {
            In I; load_in(I); phase_mod_partial(I.c, I.w_ada, (float*)(ws + WS_MODP), (LAS float*)(lds + wave * 16384), gw, NGW, lane);
        } break;
        case 1: {
            In I; load_in(I); phase_prologue(I, ws, lds, tid, lane, wave, vcu, G);
        } break;
        case 2: {
            In I; load_in(I); pg8::Gemm g{(const bf16*)(ws + WS_H), (const bf16*)(ws + WS_WQKV), NTOK, 2560, DM}; pg8::StaticOrder S; S.init(NTOK, 2560, G, bx);
            pg8::EpiQKV E{(bf16*)(ws + WS_Q), (bf16*)(ws + WS_K0), (bf16*)(ws + WS_VT0), I.swa_b_qkv, (const float*)(ws + WS_ROPE), QSCALE};
            pg8::gemm_phase<pg8::EpiQKV, pg8::StaticOrder, true, true>(lds + RING_OFF, g, S, E, tid);
            conv_fill(I, ws, lds, 0, G, tid, wave, lane);
        } break;
        case 3: {
            In I; load_in(I); conv_drain(I, ws, lds, CV_B, tid, wave, lane); phase_attn64<0, 128>(ws, lds, vcu, tid, wave, lane, (const bf16*)(ws + WS_Q), (const bf16*)(ws + WS_K0), (const bf16*)(ws + WS_VT0), (bf16*)(ws + WS_ATT), I.swa_sinks);
        } break;
        case 10: {
            In I; load_in(I); pg8::Gemm g{(const bf16*)(ws + WS_H), (const bf16*)(ws + WS_WIN), NTOK, 3840, DM}; pg8::StaticOrder S; S.init(NTOK, 3840, G, bx);
            pg8::EpiNSA E{(bf16*)(ws + WS_QRAW), (bf16*)(ws + WS_Q), (bf16*)(ws + WS_KC), (bf16*)(ws + WS_VC), (bf16*)(ws + WS_KS), (bf16*)(ws + WS_VST), (bf16*)(ws + WS_KW), (bf16*)(ws + WS_VWT), (float*)(ws + WS_GATES), (const float*)(ws + WS_ROPE), QSCALE, ablate_};
            pg8::gemm_phase<pg8::EpiNSA, pg8::StaticOrder, true, true>(lds + RING_OFF, g, S, E, tid);
            conv_fill(I, ws, lds, 3, G, tid, wave, lane);
        } break;
        case 11: {
#pragma unroll 1
            for (int which = 0; which < 2; ++which) {
                pg8::Gemm g{(const bf16*)(ws + (which ? WS_VC : WS_KC)), (const bf16*)(ws + (which ? WS_PHIV : WS_PHIK)), 2048, 512, 1024}; pg8::StaticOrder S; S.init(2048, 512, G, which ? (bx + G - 16) % G : bx);
                pg8::EpiF32 E{(float*)(ws + (which ? WS_ULV : WS_ULK)), 512};
                pg8::gemm_phase<pg8::EpiF32, pg8::StaticOrder, false, true>(lds + RING_OFF, g, S, E, tid); }
            phase_attn64<1, 512>(ws, lds, vcu, tid, wave, lane, (const bf16*)(ws + WS_Q), (const bf16*)(ws + WS_KW), (const bf16*)(ws + WS_VWT), (bf16*)(ws + WS_OWIN), nullptr);
        } break;
        case 12: {
            In I; load_in(I); conv_drain(I, ws, lds, CV_D - 16 * 512, tid, wave, lane); phase_cmp2(I, ws, lds, gw, NGW, lane, tid, wave);
        } break;
        case 13: {
            { const int bh = (vcu >> 5) & 7;
              const bf16* kc = (const bf16*)(ws + WS_KCMP) + (size_t)bh * 256 * 64;
              for (int i = tid; i < 256 * 8; i += NWAVES * 64) { const int r = i >> 3, ch = i & 7; *(LAS v4u*)(lds + CMP_K + r * 144 + ch * 16) = *(const GAS v4u*)(kc + (size_t)r * 64 + ch * 8); }
              const bf16* vc = (const bf16*)(ws + WS_VCMPT) + (size_t)bh * 64 * 256;
              for (int i = tid; i < 64 * 32; i += NWAVES * 64) { const int r = i >> 5, ch = i & 31; *(LAS v4u*)(lds + CMP_V + r * CMP_VP + ch * 16) = *(const GAS v4u*)(vc + (size_t)r * 256 + ch * 8); }
              LDS_WAIT(); __syncthreads(); }
            for (int u = vcu; u < 1024; u += G) cmp_unit(ws, lds, (u >> 7) & 1, (u >> 5) & 3, ((u >> 8) << 5) | (u & 31), tid, wave, lane);
        } break;
        case 14: {
            phase_attn64<2, 0>(ws, lds, vcu, tid, wave, lane, (const bf16*)(ws + WS_Q), (const bf16*)(ws + WS_KS), (const bf16*)(ws + WS_VST), (bf16*)(ws + WS_ATT), nullptr);
        } break;
        default: switch (cp) {
        case 0: {
            In I; load_in(I); pg8::Gemm g{(const bf16*)(ws + WS_ATT), (const bf16*)(ws + (layer ? WS_WO1 : WS_WO0)), NTOK, DM, DM}; pg8::StaticOrder S; S.init(NTOK, DM, G, bx);
            pg8::EpiWoRes E{layer ? nullptr : I.x, (const bf16*)(ws + WS_XB), (const float*)(ws + WS_MOD) + (size_t)layer * 2 * 12288 + 4096, 12288, (bf16*)(ws + WS_Y), ALPHA_RES};
            pg8::gemm_phase<pg8::EpiWoRes, pg8::StaticOrder, true, true>(lds + RING_OFF, g, S, E, tid);
        } break;
        case 1: {
            In I; load_in(I); phase_lnt2(I, ws, lds, (LAS int*)(lds + 131072 + 1024), layer, (const bf16*)(ws + WS_Y), gw, lane, tid, wave, vcu);
        } break;
        case 2: {
        } break;
        case 3: {
            Seg sg; seg_load(sg, (const unsigned*)(ws + WS_CTL) + CW_CNT + layer * 16 * CW_CNT_STRIDE); pg8::GroupOrder S; build_units(S, sg, 4, G, bx);
            pg8::Gemm g{(const bf16*)(ws + WS_H), (const bf16*)(ws + WS_W13) + (size_t)layer * 16 * 1024 * 2048, NTOK, 0, DM, (const int*)(ws + WS_ROWSRC)}; pg8::EpiUp E{(bf16*)(ws + WS_HE)};
            pg8::gemm_phase<pg8::EpiUp, pg8::GroupOrder, true, true, true>(lds + RING_OFF, g, S, E, tid);
            { In I; load_in(I); conv_fill(I, ws, lds, 1 + 3 * layer, G, tid, wave, lane); if (layer) conv_drain(I, ws, lds, CV_D, tid, wave, lane); }
        } break;
        case 4: {
            Seg sg; seg_load(sg, (const unsigned*)(ws + WS_CTL) + CW_CNT + layer * 16 * CW_CNT_STRIDE); pg8::GroupOrder S; build_units(S, sg, 8, G, bx);
            pg8::Gemm g{(const bf16*)(ws + WS_HE), (const bf16*)(ws + WS_W2) + (size_t)layer * 16 * 2048 * 512, 0, 0, DEXP}; pg8::EpiDown E{(bf16*)(ws + WS_YS), (const int*)(ws + WS_ROWTOK), (const float*)(ws + WS_ROWW)};
            pg8::gemm_phase<pg8::EpiDown, pg8::GroupOrder, true, true>(lds + RING_OFF, g, S, E, tid);
            { In I; load_in(I); conv_fill(I, ws, lds, 2 + 3 * layer, G, tid, wave, lane); }
        } break;
        case 5: {
            In I; load_in(I); if (layer == 0) conv_drain(I, ws, lds, CV_C, tid, wave, lane);
            for (int rb = gw; rb < NTOK / 4; rb += NGW) phase_lnc(I, ws, layer, outp, (bf16*)(ws + WS_XB), layer == 0, rb, lane);
        } break;
        default: break; }
        break; }
        }
        if (ph + 1 < hi) { XcdBarrier b2 = bar; asm volatile("" : "+s"(b2.bar)); xcd_barrier(b2, MK_TID()); }
    }
#ifdef FULL_TWICE
    }
#endif
}

extern "C" void kernel_launch(void* const* d_in, const int* in_sizes, int n_in, void* d_out, int out_size, void* d_ws, size_t ws_size, hipStream_t stream) {
    static int grid = 0;
    if (grid == 0) {
        if (n_in != 28 || in_sizes[0] != NTOK * DM || out_size != NTOK * DM || ws_size < WS_END) { fprintf(stderr, "kernel_launch: built for 28 inputs, x/out of %d floats, >= %zu bytes of workspace; got n_in %d, in0 %d, out %d, ws %zu; nothing launched\n", NTOK * DM, (size_t)WS_END, n_in, n_in > 0 ? in_sizes[0] : -1, out_size, ws_size); grid = -1; return; }
        int dev = 0, cus = 0, per_cu = 0;
        if (hipGetDevice(&dev) != hipSuccess || hipDeviceGetAttribute(&cus, hipDeviceAttributeMultiprocessorCount, dev) != hipSuccess) { fprintf(stderr, "kernel_launch: device query failed\n"); grid = -1; return; }
        if (hipFuncSetAttribute((const void*)hyb_fwd, hipFuncAttributeMaxDynamicSharedMemorySize, LDS_BYTES) != hipSuccess) { fprintf(stderr, "kernel_launch: hipFuncSetAttribute failed\n"); grid = -1; return; }
        if (hipOccupancyMaxActiveBlocksPerMultiprocessor(&per_cu, (const void*)hyb_fwd, NWAVES * 64, LDS_BYTES) != hipSuccess || per_cu < 1) { fprintf(stderr, "kernel_launch: occupancy query reports %d workgroups per CU\n", per_cu); }
        (void)hipGetLastError();
        grid = cus;
        if (grid != 256) { fprintf(stderr, "kernel_launch: %d CUs; this kernel is built for exactly 256 workgroups; nothing launched\n", grid); grid = -1; return; }
    }
    if (grid < 0) return;
    if (hipMemsetAsync((char*)d_ws + WS_CTL, 0, CTL_ZERO_BYTES, stream) != hipSuccess) { fprintf(stderr, "kernel_launch: memset failed\n"); return; }
    Args a{};
    for (int i = 0; i < 28; ++i) a.in[i] = d_in[i];
    a.out = (float*)d_out; a.ws = (unsigned char*)d_ws;
    for (int li = 0; li < N_LAUNCHES; ++li) {
        if (N_LAUNCHES == 1) { a.ph_lo = 0; a.ph_hi = NPHASE; } else { a.ph_lo = li; a.ph_hi = li + 1; }
        a.li = li;
        hipLaunchKernelGGL(hyb_fwd, dim3(grid), dim3(NWAVES * 64), LDS_BYTES, stream, a);
        const hipError_t le = hipPeekAtLastError();
        if (le != hipSuccess) { fprintf(stderr, "kernel_launch: launch %d failed: %s\n", li, hipGetErrorName(le)); break; }
    }
}
```

```cpp
#include <hip/hip_runtime.h>
#include <hip/hip_bf16.h>
#include <cstdio>
#include <cstdint>
#include <cmath>
namespace pg8 {
#define PG8_LAS __attribute__((address_space(3)))
typedef unsigned short bf16_t;
typedef short bf16x8 __attribute__((ext_vector_type(8)));
typedef float f32x4 __attribute__((ext_vector_type(4)));
typedef unsigned u32x4 __attribute__((ext_vector_type(4)));
constexpr int BM = 256, BK = 64, HALF = 128, HTB = HALF * BK * 2  , STAGE_BYTES = 8 * HTB, NXCD = 8, WGM = 8;

__host__ __device__ __forceinline__ int lds_byte(int r, int c) { const int st = (r >> 4) * 2 + (c >> 5), rr = r & 15, cc = c & 31, ob = rr * 64 + cc * 2; return st * 1024 + (ob ^ (((ob >> 9) & 1) << 5)); }
__host__ __device__ __forceinline__ void stage_rc(int b, int& R, int& C) { const int st = b / 1024, sb = b % 1024, swz = sb ^ (((sb >> 9) & 1) << 5); R = (st >> 1) * 16 + swz / 64; C = (st & 1) * 32 + (swz % 64) / 2; }
__host__ __device__ __forceinline__ int perm32(int rho) { const int n = rho >> 4, i = rho & 15; return 8 * (i >> 2) + 4 * n + (i & 3); }

struct Unit { int pm, pn, pnl, nvalid, pmc; };
struct Gemm { const bf16_t* A; const bf16_t* Bt; int M, N, K; const int* rowmap; };

struct StaticOrder {
    int nM, nN, nwg, G, c;
    __host__ __device__ void init(int M, int N, int G_, int c_) { nM = M / BM; nN = N / BM; nwg = nM * nN; G = G_; c = c_; }
    __host__ __device__ bool next(int i, Unit& u) const {
        const long L = (long)i * G + c; if (L >= nwg) return false;
        int wgid = (int)L; { const int q = nwg / NXCD, r = nwg % NXCD, xcd = wgid % NXCD, off = wgid / NXCD; wgid = (xcd < r ? xcd * (q + 1) : r * (q + 1) + (xcd - r) * q) + off; }
        const int nig = WGM * nN, gid = wgid / nig, fm = gid * WGM, gsz = (nM - fm) < WGM ? (nM - fm) : WGM;
        u.pm = fm + ((wgid % nig) % gsz); u.pn = (wgid % nig) / gsz; return true;
    }
    __device__ __forceinline__ void a_ready(const Unit&) const {}
    __device__ __forceinline__ void done(const Unit&) const {}
};
__device__ __forceinline__ unsigned cvt_pk_bf16(float lo, float hi) { unsigned r; asm volatile("v_cvt_pk_bf16_f32 %0, %1, %2" : "=v"(r) : "v"(lo), "v"(hi)); return r; }
typedef float f32x2 __attribute__((ext_vector_type(2)));
typedef unsigned u32x2 __attribute__((ext_vector_type(2)));
__device__ __forceinline__ float silu_f(float a) { return a * __builtin_amdgcn_rcpf(1.0f + __builtin_amdgcn_exp2f(-1.4426950408889634f * a)); }
__device__ __forceinline__ float sigmoid_f(float a) { return __builtin_amdgcn_rcpf(1.0f + __builtin_amdgcn_exp2f(-1.4426950408889634f * a)); }
__device__ __forceinline__ u32x4 pack8(const f32x4& a, const f32x4& b) { u32x4 w; w.x = cvt_pk_bf16(a[0], a[1]); w.y = cvt_pk_bf16(a[2], a[3]); w.z = cvt_pk_bf16(b[0], b[1]); w.w = cvt_pk_bf16(b[2], b[3]); return w; }
__device__ __forceinline__ unsigned short bf1(float v) { return (unsigned short)(cvt_pk_bf16(v, 0.f) & 0xffffu); }

__device__ __forceinline__ void rope8(f32x4& v0, f32x4& v1, const f32x4 (&cs)[4], int fq) {
    f32x4 p0, p1;
#pragma unroll
    for (int i = 0; i < 4; ++i) { p0[i] = __shfl_xor(v0[i], 16); p1[i] = __shfl_xor(v1[i], 16); }
    if (fq < 2) { const float sg = fq == 0 ? -1.f : 1.f; v0 = v0 * cs[0] + (p0 * cs[2]) * sg; v1 = v1 * cs[1] + (p1 * cs[3]) * sg; }
}
__device__ __forceinline__ void rope_ld(f32x4 (&cs)[4], const float* ropeRow, bool want) {
    if (want) { cs[0] = *(const f32x4*)(ropeRow); cs[1] = *(const f32x4*)(ropeRow + 4); cs[2] = *(const f32x4*)(ropeRow + 8); cs[3] = *(const f32x4*)(ropeRow + 12); }
}
__device__ __forceinline__ void store_vt8(bf16_t* VT, int b, int hk, int d0, int s, const f32x4& v0, const f32x4& v1) {
    bf16_t* p = VT + ((size_t)((b * 4 + hk) * 64 + d0)) * 4096 + s;
#pragma unroll
    for (int i = 0; i < 4; ++i) { p[(size_t)i * 4096] = bf1(v0[i]); p[(size_t)(i + 4) * 4096] = bf1(v1[i]); }
}

struct EpiQKV {
    static constexpr bool PERM = true, AFTER_DRAIN = false;
    bf16_t* Q; bf16_t* K; bf16_t* VT; const float* bias; const float* rope; float qscale;
    __device__ __forceinline__ void operator()(const f32x4 (&acc)[2][2][4][2], const Unit& u, int wr, int wc, int fr, int fq) const {
        const int pn = u.pn; const bool rot = (pn <= 8) && ((wc & 1) == 0);
        f32x4 bv[2][2];
#pragma unroll
        for (int bj = 0; bj < 2; ++bj)
#pragma unroll
            for (int n = 0; n < 2; ++n) bv[bj][n] = *(const f32x4*)(bias + pn * BM + bj * HALF + wc * 32 + 8 * fq + 4 * n);
        const bool wantr = rot && fq < 2; const int rowb = u.pm * BM + wr * 64 + fr;
        f32x4 cs[4] = {}; rope_ld(cs, rope + (size_t)rowb * 16, wantr);
#pragma unroll
        for (int ai = 0; ai < 2; ++ai)
#pragma unroll
            for (int m = 0; m < 4; ++m) {
                const int row = rowb + ai * HALF + m * 16, b = row >> 12, s = row & 4095;
                f32x4 w0[2], w1[2];
#pragma unroll
                for (int bj = 0; bj < 2; ++bj) { w0[bj] = acc[ai][bj][m][0] + bv[bj][0]; w1[bj] = acc[ai][bj][m][1] + bv[bj][1]; if (rot) rope8(w0[bj], w1[bj], cs, fq); }
                if (ai * 4 + m < 7) { const int nx = ai * 4 + m + 1; rope_ld(cs, rope + (size_t)(rowb + (nx >> 2) * HALF + (nx & 3) * 16) * 16, wantr); }
#pragma unroll
                for (int bj = 0; bj < 2; ++bj) {
                    const int col = bj * HALF + wc * 32 + 8 * fq;
                    f32x4 v0 = w0[bj], v1 = w1[bj];
                    if (pn < 8) { v0 = v0 * qscale; v1 = v1 * qscale; *(u32x4*)(Q + (size_t)row * 2048 + pn * BM + col) = pack8(v0, v1); }
                    else if (pn == 8) { *(u32x4*)(K + ((size_t)((b * 4 + (col >> 6)) * 4096 + s)) * 64 + (col & 63)) = pack8(v0, v1); }
                    else store_vt8(VT, b, col >> 6, col & 63, s, v0, v1);
                }
            }
    }
};
struct EpiNSA {
    static constexpr bool PERM = true, AFTER_DRAIN = false;
    bf16_t *QRAW, *QROT, *KC, *VC, *KS, *VST, *KW, *VWT; float* GATES; const float* rope; float qscale; int ablate;
    __device__ __forceinline__ void operator()(const f32x4 (&acc)[2][2][4][2], const Unit& u, int wr, int wc, int fr, int fq) const {
        if (ablate & 2) return;
        const int pn = u.pn; const bool rot = (pn < 8 || pn == 10 || pn == 12) && ((wc & 1) == 0);
        const bool wantr = rot && fq < 2; const int rowb = u.pm * BM + wr * 64 + fr;
        f32x4 cs[4] = {}; rope_ld(cs, rope + (size_t)rowb * 16, wantr);
#pragma unroll
        for (int ai = 0; ai < 2; ++ai)
#pragma unroll
            for (int m = 0; m < 4; ++m) {
                const int row = rowb + ai * HALF + m * 16, b = row >> 12, s = row & 4095;
                f32x4 w0[2], w1[2];
#pragma unroll
                for (int bj = 0; bj < 2; ++bj) { w0[bj] = acc[ai][bj][m][0]; w1[bj] = acc[ai][bj][m][1]; if (rot) rope8(w0[bj], w1[bj], cs, fq); }
                if (ai * 4 + m < 7) { const int nx = ai * 4 + m + 1; rope_ld(cs, rope + (size_t)(rowb + (nx >> 2) * HALF + (nx & 3) * 16) * 16, wantr); }
#pragma unroll
                for (int bj = 0; bj < 2; ++bj) {
                    const int col = bj * HALF + wc * 32 + 8 * fq;
                    f32x4 v0 = w0[bj], v1 = w1[bj];
                    if (pn < 8) { *(u32x4*)(QROT + (size_t)row * 2048 + pn * BM + col) = pack8(v0 * qscale, v1 * qscale); }
                    else if (pn == 8 || pn == 9 || pn == 10 || pn == 12) {
                        bf16_t* dst = pn == 8 ? KC : pn == 9 ? VC : pn == 10 ? KS : KW;
                        *(u32x4*)(dst + ((size_t)((b * 4 + (col >> 6)) * 4096 + s)) * 64 + (col & 63)) = pack8(v0, v1); }
                    else if ((pn == 11 || pn == 13) && (ablate & 1)) {}
                    else if (pn == 11 || pn == 13) store_vt8(pn == 11 ? VST : VWT, b, col >> 6, col & 63, s, v0, v1);
                    else if (col < 96) {
                        f32x4 g0, g1;
#pragma unroll
                        for (int i = 0; i < 4; ++i) { g0[i] = sigmoid_f(v0[i]); g1[i] = sigmoid_f(v1[i]); }
                        *(f32x4*)(GATES + (size_t)row * 96 + col) = g0; *(f32x4*)(GATES + (size_t)row * 96 + col + 4) = g1; }
                }
            }
    }
};
__device__ __forceinline__ float bf_lo(unsigned w) { return __uint_as_float(w << 16); }
__device__ __forceinline__ float bf_hi(unsigned w) { return __uint_as_float(w & 0xffff0000u); }
struct EpiWoRes {
    static constexpr bool PERM = true, AFTER_DRAIN = false;
    const float* x32; const bf16_t* x16; const float* gate; int gstride; bf16_t* Y; float alpha;
    __device__ __forceinline__ void operator()(const f32x4 (&acc)[2][2][4][2], const Unit& u, int wr, int wc, int fr, int fq) const {
        const int b = (u.pm * BM) >> 12; const int col0 = u.pn * BM + wc * 32 + 8 * fq;
        f32x4 gv[2][2];
#pragma unroll
        for (int bj = 0; bj < 2; ++bj)
#pragma unroll
            for (int n = 0; n < 2; ++n) gv[bj][n] = *(const f32x4*)(gate + (size_t)b * gstride + col0 + bj * HALF + n * 4);
#pragma unroll
        for (int ai = 0; ai < 2; ++ai)
#pragma unroll
            for (int m = 0; m < 4; ++m) { const size_t off = (size_t)(u.pm * BM + ai * HALF + wr * 64 + m * 16 + fr) * 2048 + col0;
#pragma unroll
                for (int bj = 0; bj < 2; ++bj) { f32x4 x0, x1;
                    if (x32) { x0 = *(const f32x4*)(x32 + off + bj * HALF); x1 = *(const f32x4*)(x32 + off + bj * HALF + 4); }
                    else { const u32x4 w = *(const u32x4*)(x16 + off + bj * HALF); x0 = (f32x4){bf_lo(w.x), bf_hi(w.x), bf_lo(w.y), bf_hi(w.y)}; x1 = (f32x4){bf_lo(w.z), bf_hi(w.z), bf_lo(w.w), bf_hi(w.w)}; }
                    *(u32x4*)(Y + off + bj * HALF) = pack8(x0 * alpha + gv[bj][0] * acc[ai][bj][m][0], x1 * alpha + gv[bj][1] * acc[ai][bj][m][1]); }
                if (m & 1) asm volatile("" ::: "memory"); }
    }
};
struct EpiF32 {
    static constexpr bool PERM = false, AFTER_DRAIN = false;
    float* O; int ldc; bool wt;
    __device__ __forceinline__ void operator()(const f32x4 (&acc)[2][2][4][2], const Unit& u, int wr, int wc, int fr, int fq) const {
        const int col0 = u.pn * BM + wc * 32 + 4 * fq;
        if (wt) asm volatile("s_nop 15\n\ts_nop 15" ::: "memory");
#pragma unroll
        for (int ai = 0; ai < 2; ++ai)
#pragma unroll
            for (int m = 0; m < 4; ++m) { const size_t off = (size_t)(u.pm * BM + ai * HALF + wr * 64 + m * 16 + fr) * ldc + col0;
#pragma unroll
                for (int bj = 0; bj < 2; ++bj)
#pragma unroll
                    for (int n = 0; n < 2; ++n) { float* dst = O + off + bj * HALF + n * 16;
                        if (wt) asm volatile("global_store_dwordx4 %0, %1, off sc1\n\ts_nop 2" :: "v"((__attribute__((address_space(1))) f32x4*)dst), "v"(acc[ai][bj][m][n]) : "memory"); else *(f32x4*)dst = acc[ai][bj][m][n]; } }
    }
};
struct EpiUp {
    static constexpr bool PERM = true, AFTER_DRAIN = false;
    bf16_t* HE; bool wt;
    __device__ __forceinline__ void operator()(const f32x4 (&acc)[2][2][4][2], const Unit& u, int wr, int wc, int fr, int fq) const {
#pragma unroll
        for (int ai = 0; ai < 2; ++ai)
#pragma unroll
            for (int m = 0; m < 4; ++m) { const int row = u.pm * BM + ai * HALF + wr * 64 + m * 16 + fr; f32x4 h[2];
#pragma unroll
                for (int n = 0; n < 2; ++n)
#pragma unroll
                    for (int i = 0; i < 4; ++i) h[n][i] = silu_f(acc[ai][0][m][n][i]) * acc[ai][1][m][n][i];
                bf16_t* dst = HE + (size_t)row * 512 + u.pnl * HALF + wc * 32 + 8 * fq; const u32x4 pk = pack8(h[0], h[1]);
                if (wt) asm volatile("global_store_dwordx4 %0, %1, off sc1\n\ts_nop 2" :: "v"((__attribute__((address_space(1))) u32x4*)dst), "v"(pk) : "memory"); else *(u32x4*)dst = pk; }
    }
};
struct EpiDown {
    static constexpr bool PERM = true, AFTER_DRAIN = false;
    bf16_t* YS; const int* rowtok; const float* roww;
    __device__ __forceinline__ void operator()(const f32x4 (&acc)[2][2][4][2], const Unit& u, int wr, int wc, int fr, int fq) const {
#pragma unroll
        for (int ai = 0; ai < 2; ++ai)
#pragma unroll
            for (int m = 0; m < 4; ++m) { const int lrow = ai * HALF + wr * 64 + m * 16 + fr;
                if (lrow < u.nvalid) { const int grow = u.pm * BM + lrow; const int tk = rowtok[grow]; const float w = roww[grow];
#pragma unroll
                    for (int bj = 0; bj < 2; ++bj)
                        *(u32x4*)(YS + (size_t)tk * 2048 + u.pnl * BM + bj * HALF + wc * 32 + 8 * fq) = pack8(acc[ai][bj][m][0] * w, acc[ai][bj][m][1] * w); } }
    }
};
constexpr int SEG_TILES = 32;
struct GroupOrder {
    unsigned cnt[16]; int nT, nN, G, c;
    __device__ __forceinline__ bool next(int i, Unit& u) const { return unit_of(i * G + c, u); }
    __device__ __forceinline__ bool unit_of(int L, Unit& u) const {
        const int nwg = nT * nN; if (L >= nwg) return false;
        const int q = nwg / 8, r = nwg % 8, xcd = L % 8, off = L / 8; const int wgid = (xcd < r ? xcd * (q + 1) : r * (q + 1) + (xcd - r) * q) + off;
        const int pm = wgid / nN, pnl = wgid % nN; int run = 0, ee = 0, nv = 0;
        int loc = 0;
#pragma unroll
        for (int e = 0; e < 16; ++e) { const int te = (int)((cnt[e] + 255u) >> 8); if (pm >= run && pm < run + te) { ee = e; loc = pm - run; const int left = (int)cnt[e] - (pm - run) * 256; nv = left < 256 ? left : 256; } run += te; }
        u.pm = ee * SEG_TILES + loc; u.pn = ee * nN + pnl; u.pnl = pnl; u.nvalid = nv; u.pmc = pm; return true;
    }
    __device__ __forceinline__ void a_ready(const Unit&) const {}
    __device__ __forceinline__ void done(const Unit&) const {}
};
struct GroupOrderSub : GroupOrder {
    int base, limit;
    __device__ __forceinline__ bool next(int i, Unit& u) const { const int L = base + i * G + c; return L < limit && unit_of(L, u); }
};
struct StaticOrderPub : StaticOrder {
    unsigned* counter; int wave;
    __device__ __forceinline__ void done(const Unit&) const {
        asm volatile("s_waitcnt vmcnt(0)" ::: "memory");
        if (__builtin_amdgcn_mbcnt_hi(~0u, __builtin_amdgcn_mbcnt_lo(~0u, 0u)) == 0u) __hip_atomic_fetch_add(counter, 1u, __ATOMIC_RELAXED, __HIP_MEMORY_SCOPE_AGENT);
    }
};
struct GroupOrderPub : GroupOrder {
    unsigned* flags; int wave;
    __device__ __forceinline__ void done(const Unit& u) const {
        asm volatile("s_waitcnt vmcnt(0)" ::: "memory");
        __builtin_amdgcn_s_barrier();
        if (wave == 0) { if (__builtin_amdgcn_mbcnt_hi(~0u, __builtin_amdgcn_mbcnt_lo(~0u, 0u)) == 0u)
            __hip_atomic_fetch_add(flags + 64 * u.pmc, 1u, __ATOMIC_RELAXED, __HIP_MEMORY_SCOPE_AGENT); }
    }
};
template <class Epi, class Sched, bool ALIGN_EPI = false, bool SP2 = false, bool GATHER = false>
__device__ __forceinline__ void gemm_phase(PG8_LAS unsigned char* lds, const Gemm g, const Sched& S, const Epi& E, int tid_in) {
    int tid_ = tid_in; asm volatile("" : "+v"(tid_)); const int tid = tid_, wid = __builtin_amdgcn_readfirstlane(tid >> 6), lane = tid & 63, wr = wid >> 2, wc = wid & 3, fr = lane & 15, fq = lane >> 4;
    const int K = g.K, nt = K / BK;
    unsigned voffA[2], voffB[2];
#pragma unroll
    for (int i = 0; i < 2; ++i) { int R, C; stage_rc(tid * 16 + i * 8192, R, C); const int Rb = Epi::PERM ? ((R & ~31) + perm32(R & 31)) : R;
        voffA[i] = (unsigned)(R * K + C) * 2u; voffB[i] = (unsigned)(Rb * K + C) * 2u; }
    static_assert(!GATHER || SP2, "GATHER is wired into the SP2 loop only");
    unsigned gc0[2] = {0u, 0u}, gc1[2] = {0u, 0u}, gn0[2] = {0u, 0u}, gn1[2] = {0u, 0u};
#define PG8_GOFF(pm_, o0, o1) do { _Pragma("unroll") for (int _i = 0; _i < 2; ++_i) { int R_, C_; stage_rc(tid * 16 + _i * 8192, R_, C_); \
        int r0_ = g.rowmap[(pm_) * BM + R_], r1_ = g.rowmap[(pm_) * BM + HALF + R_]; r0_ = (unsigned)r0_ < (unsigned)g.M ? r0_ : 0; r1_ = (unsigned)r1_ < (unsigned)g.M ? r1_ : 0;     \
        o0[_i] = (unsigned)(r0_ * K + C_) * 2u; o1[_i] = (unsigned)(r1_ * K + C_) * 2u; } } while (0)
#define PG8_STAGE_A(bufoff, base, half, nx) do { if constexpr (GATHER) { unsigned vo_[2]; \
        vo_[0] = (nx) ? ((half) ? gn1[0] : gn0[0]) : ((half) ? gc1[0] : gc0[0]); vo_[1] = (nx) ? ((half) ? gn1[1] : gn0[1]) : ((half) ? gc1[1] : gc0[1]); PG8_STAGE(bufoff, base, vo_); } \
        else { PG8_STAGE(bufoff, (base) + ((half) ? hstep : (size_t)0), voffA); } } while (0)
    const size_t kstep = (size_t)(BK * 2);
    const size_t hstep = (size_t)HALF * K * 2;
    const size_t tstep = 2 * hstep;
    const unsigned ldsw = (unsigned)wid * 1024u;
    const int aoff = lds_byte(wr * 64 + fr, fq * 8), boff = lds_byte(wc * 32 + fr, fq * 8);
#define PG8_SA(b, h) (((b) * 2 + (h)) * HTB)
#define PG8_SB(b, h) ((4 + (b) * 2 + (h)) * HTB)
#define PG8_STAGE(bufoff, gbase, voff) do { _Pragma("unroll") for (int _i = 0; _i < 2; ++_i) \
        __builtin_amdgcn_global_load_lds((const unsigned*)((const char*)(gbase) + (voff)[_i]), (PG8_LAS unsigned*)(lds + (bufoff) + ldsw + _i * 8192), 16, 0, 0); } while (0)
#define PG8_LDA(dst, b, h) do { _Pragma("unroll") for (int m = 0; m < 4; ++m) _Pragma("unroll") for (int k = 0; k < 2; ++k) dst[m][k] = *(const PG8_LAS bf16x8*)(lds + PG8_SA(b, h) + aoff + m * 2048 + k * 1024); } while (0)
#define PG8_LDB(dst, b, h) do { _Pragma("unroll") for (int n = 0; n < 2; ++n) _Pragma("unroll") for (int k = 0; k < 2; ++k) dst[n][k] = *(const PG8_LAS bf16x8*)(lds + PG8_SB(b, h) + boff + n * 2048 + k * 1024); } while (0)
#define PG8_MMA(ai, bj, At, Bt) do { __builtin_amdgcn_s_setprio(1); _Pragma("unroll") for (int m = 0; m < 4; ++m) _Pragma("unroll") for (int n = 0; n < 2; ++n) _Pragma("unroll") for (int k = 0; k < 2; ++k) \
        acc[ai][bj][m][n] = __builtin_amdgcn_mfma_f32_16x16x32_bf16(Bt[n][k], At[m][k], acc[ai][bj][m][n], 0, 0, 0); __builtin_amdgcn_s_setprio(0); } while (0)
#define PG8_WAIT_V(n) asm volatile("s_waitcnt vmcnt(" #n ")" ::: "memory")
#define PG8_WAIT_L(n) asm volatile("s_waitcnt lgkmcnt(" #n ")" ::: "memory")
#define PG8_BAR __builtin_amdgcn_s_barrier()
#define PG8_SCHED __builtin_amdgcn_sched_barrier(0)
    Unit cur, nxt; int ui = 0;
    if (!S.next(0, cur)) return;
    f32x4 acc[2][2][4][2];
#pragma unroll
    for (int a = 0; a < 2; ++a)
#pragma unroll
        for (int b = 0; b < 2; ++b)
#pragma unroll
            for (int m = 0; m < 4; ++m)
#pragma unroll
                for (int n = 0; n < 2; ++n) acc[a][b][m][n] = (f32x4){0.f, 0.f, 0.f, 0.f};
    bf16x8 At[4][2], B0[2][2], B1[2][2];
    const char* cA = (const char*)g.A + (GATHER ? (size_t)0 : (size_t)cur.pm * tstep); const char* cB = (const char*)g.Bt + (size_t)cur.pn * tstep;
    S.a_ready(cur);
    if constexpr (SP2) {
        if constexpr (GATHER) PG8_GOFF(cur.pm, gc0, gc1);
        PG8_STAGE(PG8_SB(0, 0), cB, voffB); PG8_STAGE(PG8_SB(0, 1), cB + hstep, voffB); PG8_STAGE_A(PG8_SA(0, 0), cA, 0, false); PG8_STAGE_A(PG8_SA(0, 1), cA, 1, false);
        if (wr == 1) PG8_BAR;
        PG8_WAIT_V(2); PG8_BAR;
        PG8_STAGE(PG8_SB(1, 0), cB + kstep, voffB); PG8_STAGE_A(PG8_SA(1, 0), cA + kstep, 0, false); PG8_STAGE(PG8_SB(1, 1), cB + hstep + kstep, voffB);
        PG8_WAIT_V(6); PG8_BAR;
    } else {
        PG8_STAGE(PG8_SB(0, 0), cB, voffB); PG8_STAGE(PG8_SA(0, 0), cA, voffA); PG8_STAGE(PG8_SB(0, 1), cB + hstep, voffB); PG8_STAGE(PG8_SA(0, 1), cA + hstep, voffA);
        if (wr == 1) PG8_BAR;
        PG8_WAIT_V(4); PG8_BAR;
        PG8_STAGE(PG8_SB(1, 0), cB + kstep, voffB); PG8_STAGE(PG8_SA(1, 0), cA + kstep, voffA); PG8_STAGE(PG8_SB(1, 1), cB + hstep + kstep, voffB);
        PG8_WAIT_V(6); PG8_BAR;
    }
    for (;;) {
        const bool has_next = S.next(ui + 1, nxt);
        if constexpr (GATHER) { if (has_next) PG8_GOFF(nxt.pm, gn0, gn1); else { gn0[0] = gc0[0]; gn0[1] = gc0[1]; gn1[0] = gc1[0]; gn1[1] = gc1[1]; } }
        const char* nA = GATHER ? (const char*)g.A : (has_next ? (const char*)g.A + (size_t)nxt.pm * tstep : cA); const char* nB = has_next ? (const char*)g.Bt + (size_t)nxt.pn * tstep : cB;
        for (int t = 0; t < nt; t += 2) {
            const bool last = (t == nt - 2);
            const char* a1 = cA + (size_t)(t + 1) * kstep;
            const char* a2 = last ? nA : cA + (size_t)(t + 2) * kstep; const char* b2 = last ? nB : cB + (size_t)(t + 2) * kstep;
            const char* a3 = a2 + kstep; const char* b3 = b2 + kstep;
            if (last && has_next) S.a_ready(nxt);
            if constexpr (SP2) {
            PG8_LDB(B0, 0, 0); PG8_LDB(B1, 0, 1); PG8_SCHED; PG8_LDA(At, 0, 0); PG8_STAGE_A(PG8_SA(1, 1), a1, 1, false);
            PG8_WAIT_V(8); PG8_WAIT_L(0); PG8_BAR; PG8_MMA(0, 0, At, B0); PG8_MMA(0, 1, At, B1); PG8_BAR; PG8_SCHED;
            PG8_LDA(At, 0, 1); PG8_STAGE(PG8_SB(0, 0), b2, voffB); PG8_STAGE(PG8_SB(0, 1), b2 + hstep, voffB); PG8_STAGE_A(PG8_SA(0, 0), a2, 0, last);
            PG8_WAIT_V(8); PG8_WAIT_L(0); PG8_BAR; PG8_MMA(1, 0, At, B0); PG8_MMA(1, 1, At, B1); PG8_BAR; PG8_SCHED;
            PG8_LDB(B0, 1, 0); PG8_LDB(B1, 1, 1); PG8_SCHED; PG8_LDA(At, 1, 0); PG8_STAGE_A(PG8_SA(0, 1), a2, 1, last);
            PG8_WAIT_V(8); PG8_WAIT_L(0); PG8_BAR; PG8_MMA(0, 0, At, B0); PG8_MMA(0, 1, At, B1); PG8_BAR; PG8_SCHED;
            PG8_LDA(At, 1, 1); PG8_STAGE(PG8_SB(1, 0), b3, voffB); PG8_STAGE(PG8_SB(1, 1), b3 + hstep, voffB); PG8_STAGE_A(PG8_SA(1, 0), a3, 0, last);
            PG8_WAIT_V(8); PG8_WAIT_L(0); PG8_BAR; PG8_MMA(1, 0, At, B0); PG8_MMA(1, 1, At, B1); PG8_BAR; PG8_SCHED;
            } else {
            PG8_LDB(B0, 0, 0); PG8_SCHED; PG8_LDA(At, 0, 0); PG8_STAGE(PG8_SA(1, 1), a1 + hstep, voffA);
            PG8_WAIT_L(8); PG8_BAR; PG8_WAIT_L(0); PG8_MMA(0, 0, At, B0); PG8_BAR; PG8_SCHED;
            PG8_LDB(B1, 0, 1); PG8_STAGE(PG8_SB(0, 0), b2, voffB);
            PG8_BAR; PG8_WAIT_L(0); PG8_MMA(0, 1, At, B1); PG8_BAR;
            PG8_LDA(At, 0, 1); PG8_STAGE(PG8_SA(0, 0), a2, voffA);
            PG8_BAR; PG8_WAIT_L(0); PG8_MMA(1, 0, At, B0); PG8_BAR; PG8_SCHED;
            PG8_STAGE(PG8_SB(0, 1), b2 + hstep, voffB);
            PG8_WAIT_V(6); PG8_BAR; PG8_MMA(1, 1, At, B1); PG8_BAR;
            PG8_LDB(B0, 1, 0); PG8_SCHED; PG8_LDA(At, 1, 0); PG8_STAGE(PG8_SA(0, 1), a2 + hstep, voffA);
            PG8_WAIT_L(8); PG8_BAR; PG8_WAIT_L(0); PG8_MMA(0, 0, At, B0); PG8_BAR; PG8_SCHED;
            PG8_LDB(B1, 1, 1); PG8_STAGE(PG8_SB(1, 0), b3, voffB);
            PG8_BAR; PG8_WAIT_L(0); PG8_MMA(0, 1, At, B1); PG8_BAR;
            PG8_LDA(At, 1, 1); PG8_STAGE(PG8_SA(1, 0), a3, voffA);
            PG8_BAR; PG8_WAIT_L(0); PG8_MMA(1, 0, At, B0); PG8_BAR; PG8_SCHED;
            PG8_STAGE(PG8_SB(1, 1), b3 + hstep, voffB);
            PG8_WAIT_V(6); PG8_BAR; PG8_MMA(1, 1, At, B1); PG8_BAR;
            }
        }
        if constexpr (ALIGN_EPI) { if (wr == 0) PG8_BAR; }
        if constexpr (!Epi::AFTER_DRAIN) { E(acc, cur, wr, wc, fr, fq); S.done(cur); }
        if (!has_next) break;
#pragma unroll
        for (int a = 0; a < 2; ++a)
#pragma unroll
            for (int b = 0; b < 2; ++b)
#pragma unroll
                for (int m = 0; m < 4; ++m)
#pragma unroll
                    for (int n = 0; n < 2; ++n) acc[a][b][m][n] = (f32x4){0.f, 0.f, 0.f, 0.f};
        cur = nxt; cA = nA; cB = nB; ++ui;
        if constexpr (GATHER) { gc0[0] = gn0[0]; gc0[1] = gn0[1]; gc1[0] = gn1[0]; gc1[1] = gn1[1]; }
        if constexpr (ALIGN_EPI) { if (wr == 1) PG8_BAR; }
    }
    PG8_WAIT_V(0);
    if constexpr (!ALIGN_EPI) { if (wr == 0) PG8_BAR; }
    PG8_BAR;
    if constexpr (Epi::AFTER_DRAIN) { E.fused(acc, cur, wr, wc, fr, fq, lds, wid, lane); S.done(cur); }
#undef PG8_SA
#undef PG8_SB
#undef PG8_STAGE
#undef PG8_STAGE_A
#undef PG8_GOFF
#undef PG8_LDA
#undef PG8_LDB
#undef PG8_MMA
#undef PG8_WAIT_V
#undef PG8_WAIT_L
#undef PG8_BAR
#undef PG8_SCHED
}
}
#define GAS __attribute__((address_space(1)))
#define LAS __attribute__((address_space(3)))
typedef unsigned short bf16;
typedef unsigned v4u __attribute__((ext_vector_type(4)));
typedef float f32x4 __attribute__((ext_vector_type(4)));
typedef short bf16x8 __attribute__((ext_vector_type(8)));
typedef GAS unsigned gu32;
typedef GAS unsigned long long gu64;
#define RLX_AGENT __ATOMIC_RELAXED, __HIP_MEMORY_SCOPE_AGENT
#define LDS_WAIT() asm volatile("s_waitcnt lgkmcnt(0)" ::: "memory")
#define VM_WAIT() asm volatile("s_waitcnt vmcnt(0)" ::: "memory")
__device__ __forceinline__ unsigned long long rt() { return __builtin_amdgcn_s_memrealtime(); }
__device__ __forceinline__ unsigned f2bf(float f) { unsigned u = __builtin_bit_cast(unsigned, f); return (u + 0x7fffu + ((u >> 16) & 1u)) >> 16; }
__device__ __forceinline__ unsigned pk2(float lo, float hi) { return f2bf(lo) | (f2bf(hi) << 16); }
#define XB_TMO      128
#define XB_XCNT(j)  (256  + 64 * (j))
#define XB_XSUB(j)  (1280 + 64 * (j))
#define XB_XGEN(j)  (2304 + 64 * (j))
#define XB_TOP      3328
#define XB_TOPGEN   3392
#define XCD_BAR_WORDS 3456
#define XB_SPIN_CAP (1u << 18)

__device__ __forceinline__ unsigned xb_ld(unsigned* p)              { return __hip_atomic_load(p, __ATOMIC_RELAXED, __HIP_MEMORY_SCOPE_AGENT); }
__device__ __forceinline__ unsigned xb_add(unsigned* p, unsigned v) { return __hip_atomic_fetch_add(p, v, __ATOMIC_RELAXED, __HIP_MEMORY_SCOPE_AGENT); }
__device__ __forceinline__ unsigned xb_xcc_id() { return (unsigned)__builtin_amdgcn_s_getreg((3 << 11) | 20) & 0xFu; }
#define XB_SPIN(cond, bar) do { unsigned _sp = 0; while (cond) { __builtin_amdgcn_s_sleep(1); \
    if ((++_sp & 255u) == 0u) { if (xb_ld(&(bar)[XB_TMO])) break; if (_sp > XB_SPIN_CAP) { atomicAdd(&(bar)[XB_TMO], 1u); break; } } } } while (0)

struct XcdBarrier {
    unsigned* bar; unsigned x;
    volatile LAS unsigned* st;
};

__device__ __forceinline__ XcdBarrier xcd_barrier_post(unsigned* bar, volatile LAS unsigned* st, int tid) {
    XcdBarrier b; b.bar = bar; b.x = xb_xcc_id(); b.st = st;
    if (tid == 0) (void)xb_add(&bar[XB_XCNT(b.x)], 1u);
    return b;
}
__device__ __forceinline__ void xcd_barrier_complete(unsigned* bar, unsigned x, unsigned& nloc, unsigned& nx) {
    const unsigned G = gridDim.x * gridDim.y * gridDim.z;
    unsigned sum, cnt, mine, sp = 0u;
    for (;;) {
        sum = 0u; cnt = 0u; mine = 0u;
#pragma unroll
        for (unsigned j = 0; j < 16; ++j) { const unsigned c = xb_ld(&bar[XB_XCNT(j)]); sum += c; cnt += (c > 0u) ? 1u : 0u; mine = (j == x) ? c : mine; }
        if (sum == G) break;
        __builtin_amdgcn_s_sleep(1);
        if ((++sp & 255u) == 0u) { if (xb_ld(&bar[XB_TMO])) break; if (sp > XB_SPIN_CAP) { atomicAdd(&bar[XB_TMO], 1u); break; } }
    }
    nloc = mine > 0u ? mine : 1u; nx = cnt > 0u ? cnt : 1u;
}

__device__ __forceinline__ void xcd_barrier(const XcdBarrier& b, int tid) {
    asm volatile("s_waitcnt vmcnt(0)" ::: "memory");
    __syncthreads();
    if (tid == 0) {
        unsigned* bar = b.bar;
        __builtin_amdgcn_s_waitcnt(0);
        unsigned nloc = b.st[0], nx = b.st[1];
        if (nloc == 0u) { xcd_barrier_complete(bar, b.x, nloc, nx); b.st[0] = nloc; b.st[1] = nx; }
        const unsigned old = xb_add(&bar[XB_XSUB(b.x)], 1u);
        const unsigned gen = old / nloc;
        if (old + 1u == (gen + 1u) * nloc) {
            __builtin_amdgcn_fence(__ATOMIC_RELEASE, "agent");
            asm volatile("s_waitcnt vmcnt(0)" ::: "memory");
            const unsigned og = xb_add(&bar[XB_TOP], 1u);
            const unsigned tg = og / nx;
            if (og + 1u == (tg + 1u) * nx) xb_add(&bar[XB_TOPGEN], 1u);
            else XB_SPIN(xb_ld(&bar[XB_TOPGEN]) == tg, bar);
            __builtin_amdgcn_fence(__ATOMIC_ACQUIRE, "agent");
            xb_add(&bar[XB_XGEN(b.x)], 1u);
            asm volatile("s_waitcnt vmcnt(0)" ::: "memory");
        } else {
            XB_SPIN(xb_ld(&bar[XB_XGEN(b.x)]) == gen, bar);
            __builtin_amdgcn_fence(__ATOMIC_ACQUIRE, "agent");
            asm volatile("s_waitcnt vmcnt(0)" ::: "memory");
        }
    }
    __syncthreads();
}
namespace fa {
typedef short bf16x8 __attribute__((ext_vector_type(8)));
typedef float f32x16 __attribute__((ext_vector_type(16)));
typedef float f32x2_t __attribute__((ext_vector_type(2))); typedef __bf16 bf16x2_t __attribute__((ext_vector_type(2)));
typedef unsigned u32x4 __attribute__((ext_vector_type(4)));
typedef unsigned u32x2 __attribute__((ext_vector_type(2)));
__device__ __forceinline__ unsigned cvtpk(float lo, float hi) { f32x2_t v = {lo, hi}; bf16x2_t b = __builtin_convertvector(v, bf16x2_t); return __builtin_bit_cast(unsigned, b); }
__device__ __forceinline__ int kap(int r32) { return (r32 & ~12) | ((r32 & 4) << 1) | ((r32 & 8) >> 1); }
__device__ __forceinline__ float xmax(float v) { auto rr = __builtin_amdgcn_permlane32_swap(__float_as_uint(v), __float_as_uint(v), false, false); return fmaxf(__uint_as_float(rr[0]), __uint_as_float(rr[1])); }
__device__ __forceinline__ float xsum(float v) { auto rr = __builtin_amdgcn_permlane32_swap(__float_as_uint(v), __float_as_uint(v), false, false); return __uint_as_float(rr[0]) + __uint_as_float(rr[1]); }
constexpr float NEGBIG = -1e30f;

struct Frag { bf16x8 k[4]; bf16x8 v[4]; };
struct State { f32x16 o0, o1; float m, l; };

__device__ __forceinline__ void load_tile(Frag& f, const bf16* Kbh, const bf16* Vbh, int VP, int key0, int r32, int hi) {
    const bf16* kp = Kbh + (size_t)(key0 + kap(r32)) * 64 + hi * 8;
#pragma unroll
    for (int d0 = 0; d0 < 4; ++d0) f.k[d0] = *(const bf16x8*)(kp + d0 * 16);
    const bf16* vp = Vbh + (size_t)r32 * VP + key0 + hi * 8;
#pragma unroll
    for (int db = 0; db < 2; ++db)
#pragma unroll
        for (int s = 0; s < 2; ++s) f.v[db * 2 + s] = *(const bf16x8*)(vp + (size_t)db * 32 * VP + s * 16);
}
__device__ __forceinline__ void load_v(Frag& f, const bf16* Vbh, int VP, int key0, int r32, int hi) {
    const bf16* vp = Vbh + (size_t)r32 * VP + key0 + hi * 8;
#pragma unroll
    for (int db = 0; db < 2; ++db)
#pragma unroll
        for (int s = 0; s < 2; ++s) f.v[db * 2 + s] = *(const bf16x8*)(vp + (size_t)db * 32 * VP + s * 16);
}
__device__ __forceinline__ void load_k(Frag& f, const bf16* Kbh, int key0, int r32, int hi) {
    const bf16* kp = Kbh + (size_t)(key0 + kap(r32)) * 64 + hi * 8;
#pragma unroll
    for (int d0 = 0; d0 < 4; ++d0) f.k[d0] = *(const bf16x8*)(kp + d0 * 16);
}
__device__ __forceinline__ void scores(f32x16& p, const Frag& f, const bf16x8 (&qr)[4]) {
    p = f32x16{};
#pragma unroll
    for (int d0 = 0; d0 < 4; ++d0) p = __builtin_amdgcn_mfma_f32_32x32x16_bf16(f.k[d0], qr[d0], p, 0, 0, 0);
}
__device__ __forceinline__ void mask_range(f32x16& p, int key0, int hi, int lo, int hi_) {
#pragma unroll
    for (int r = 0; r < 16; ++r) { const int kpos = key0 + 16 * (r >> 3) + 8 * hi + (r & 7); p[r] = (kpos >= lo && kpos <= hi_) ? p[r] : -INFINITY; }
}
__device__ __forceinline__ void step(State& st, const Frag& f, const bf16x8 (&qr)[4], int key0, int hi, bool need_mask, int lo, int hi_) {
    f32x16 p; scores(p, f, qr);
    if (need_mask) mask_range(p, key0, hi, lo, hi_);
    float tm = fmaxf(p[0], p[1]);
#pragma unroll
    for (int r = 2; r < 16; ++r) tm = fmaxf(tm, p[r]);
    tm = xmax(tm);
    const float mn = fmaxf(st.m, tm); const float alpha = __builtin_amdgcn_exp2f(st.m - mn); st.m = mn;
    float rs = 0.f;
#pragma unroll
    for (int r = 0; r < 16; ++r) { p[r] = __builtin_amdgcn_exp2f(p[r] - mn); rs += p[r]; }
    st.l = st.l * alpha + rs;
    if (!__all(alpha == 1.0f)) { st.o0 = st.o0 * alpha; st.o1 = st.o1 * alpha; }
    u32x4 w0, w1;
    w0.x = cvtpk(p[0], p[1]); w0.y = cvtpk(p[2], p[3]); w0.z = cvtpk(p[4], p[5]); w0.w = cvtpk(p[6], p[7]);
    w1.x = cvtpk(p[8], p[9]); w1.y = cvtpk(p[10], p[11]); w1.z = cvtpk(p[12], p[13]); w1.w = cvtpk(p[14], p[15]);
    const bf16x8 pb0 = __builtin_bit_cast(bf16x8, w0), pb1 = __builtin_bit_cast(bf16x8, w1);
    st.o0 = __builtin_amdgcn_mfma_f32_32x32x16_bf16(f.v[0], pb0, st.o0, 0, 0, 0);
    st.o0 = __builtin_amdgcn_mfma_f32_32x32x16_bf16(f.v[1], pb1, st.o0, 0, 0, 0);
    st.o1 = __builtin_amdgcn_mfma_f32_32x32x16_bf16(f.v[2], pb0, st.o1, 0, 0, 0);
    st.o1 = __builtin_amdgcn_mfma_f32_32x32x16_bf16(f.v[3], pb1, st.o1, 0, 0, 0);
}
__device__ __forceinline__ void load_q(bf16x8 (&qr)[4], const bf16* Qrow  , int hi) {
#pragma unroll
    for (int d0 = 0; d0 < 4; ++d0) qr[d0] = *(const bf16x8*)(Qrow + d0 * 16 + hi * 8);
}
__device__ __forceinline__ float finish(State& st) { const float lt = xsum(st.l); return lt > 0.f ? 1.0f / lt : 0.f; }
__device__ __forceinline__ void store_o(const State& st, float inv, bf16* Orow  , int hi) {
#pragma unroll
    for (int gp = 0; gp < 2; ++gp)
#pragma unroll
        for (int db = 0; db < 2; ++db) { const f32x16& o = db ? st.o1 : st.o0; const int g = 2 * gp;
            const unsigned g0x = cvtpk(o[4 * g] * inv, o[4 * g + 1] * inv), g0y = cvtpk(o[4 * g + 2] * inv, o[4 * g + 3] * inv);
            const unsigned g1x = cvtpk(o[4 * g + 4] * inv, o[4 * g + 5] * inv), g1y = cvtpk(o[4 * g + 6] * inv, o[4 * g + 7] * inv);
            const auto r0 = __builtin_amdgcn_permlane32_swap(g0x, g1x, false, false), r1 = __builtin_amdgcn_permlane32_swap(g0y, g1y, false, false);
            u32x4 w; w.x = r0[0]; w.y = r1[0]; w.z = r0[1]; w.w = r1[1];
            *(u32x4*)(Orow + 32 * db + 8 * g + 8 * hi) = w; }
}
__device__ __forceinline__ float bflo(unsigned w) { return __uint_as_float(w << 16); }
__device__ __forceinline__ float bfhi(unsigned w) { return __uint_as_float(w & 0xffff0000u); }
}
constexpr int NWAVES = 8;
constexpr int NB = 2, SEQ = 4096, DM = 2048, NTOK = NB * SEQ, NEXP = 16, DEXP = 512;
constexpr float ALPHA_RES = 1.4142135623730951f;
constexpr float LN_EPS = 1e-5f;
constexpr float QSCALE = 0.125f * 1.4426950408889634f;
constexpr float LOG2E = 1.4426950408889634f;
constexpr int NPHASE = 21;
#ifndef MK_N_LAUNCHES
#define MK_N_LAUNCHES 1
#endif
constexpr int N_LAUNCHES = MK_N_LAUNCHES;

constexpr size_t MiB = 1u << 20, KiB = 1u << 10;
constexpr size_t WS_CTL = 0, CTL_ZERO_BYTES = 64 * KiB;
constexpr size_t WS_MODP = 1 * MiB;
constexpr size_t WS_MOD = 4 * MiB;
constexpr size_t WS_ROPE = 4 * MiB + 512 * KiB;
constexpr size_t WS_CMPB = 5 * MiB;
constexpr size_t WS_TOKE = 5 * MiB + 256 * KiB;
constexpr size_t WS_TOKW = WS_TOKE + 64 * KiB;
constexpr size_t WS_TOKS = WS_TOKW + 64 * KiB;
constexpr int SEG_CAP = 8192;
constexpr size_t WS_ROWTOK = 10 * MiB;
constexpr size_t WS_ROWW = WS_ROWTOK + 512 * KiB;
constexpr size_t WS_BCNT = 5 * MiB + 768 * KiB;
constexpr size_t WS_ROWSRC = WS_ROWW + 512 * KiB;
constexpr size_t WS_SELM = 6 * MiB;
constexpr size_t WS_KCMP = 6 * MiB + 256 * KiB;
constexpr size_t WS_VCMPT = 6 * MiB + 512 * KiB;
constexpr size_t WS_GATES = 7 * MiB;
constexpr size_t WS_ULK = 10 * MiB, WS_ULV = 14 * MiB;
constexpr size_t WS_WQKV = 18 * MiB, WS_WO0 = 28 * MiB, WS_WIN = 36 * MiB, WS_WO1 = 51 * MiB, WS_PHIK = 59 * MiB, WS_PHIV = 60 * MiB;
constexpr size_t WS_W13 = 64 * MiB;
constexpr size_t WS_W2 = 192 * MiB;
constexpr size_t WS_H = 256 * MiB;
constexpr size_t WS_XA = 288 * MiB, WS_Y = 320 * MiB, WS_XB = 352 * MiB;
constexpr size_t WS_Q = 416 * MiB, WS_QRAW = 448 * MiB, WS_ATT = 480 * MiB;
constexpr size_t WS_HPERM = 416 * MiB;
constexpr size_t WS_OCMP = 512 * MiB, WS_OWIN = 544 * MiB;
constexpr size_t WS_K0 = 576 * MiB, WS_VT0 = 580 * MiB, WS_KC = 584 * MiB, WS_VC = 588 * MiB, WS_KS = 592 * MiB, WS_VST = 596 * MiB, WS_KW = 600 * MiB, WS_VWT = 604 * MiB;
constexpr size_t WS_HE = 416 * MiB;
constexpr size_t WS_YS = 628 * MiB;
constexpr size_t WS_END = 692 * MiB;
constexpr int CW_TMO = 0, CW_CODE = 1;
constexpr int CW_DONE = 512;
constexpr int CW_FQ = 128;
constexpr int CW_CNT = 1024, CW_CNT_STRIDE = 64;
constexpr int CW_BAR = 4096;
constexpr int CW_MT = 8192;
constexpr int CW_W2 = 14400;
constexpr int CW_TMO2 = 14464;
constexpr int CW_UL = 14528;

constexpr int RING_OFF = 0, RING_BYTES = 131072;
constexpr int LDSCTL_OFF = RING_BYTES, MISC_OFF = LDSCTL_OFF + 320;
constexpr int LDS_BYTES = 147456;
typedef float f32x16g __attribute__((ext_vector_type(16)));
typedef unsigned u32x2g __attribute__((ext_vector_type(2)));
__device__ __forceinline__ float wave_sum(float v) {
#pragma unroll
    for (int o = 1; o < 64; o <<= 1) v += __shfl_xor(v, o);
    return v;
}
__device__ __forceinline__ unsigned ld_u32_agent(const unsigned* p) { return __hip_atomic_load(p, __ATOMIC_RELAXED, __HIP_MEMORY_SCOPE_AGENT); }

__device__ __forceinline__ void st_wt16(void* p, v4u v) { asm volatile("global_store_dwordx4 %0, %1, off sc1\n\ts_nop 2" :: "v"((GAS v4u*)p), "v"(v) : "memory"); }
__device__ __forceinline__ void transpose_item(const float* W, int ldw, bf16* WT, int ldt, int k0, int n0, int drow0, LAS float* scr, int lane, bool wt = false) {
    f32x4 t[8]; const float* wp = W + (size_t)(k0 + (lane >> 3)) * ldw + n0 + 4 * (lane & 7);
#pragma unroll
    for (int i = 0; i < 8; ++i) t[i] = __builtin_nontemporal_load((const f32x4*)(wp + (size_t)(8 * i) * ldw));
#pragma unroll
    for (int i = 0; i < 8; ++i) { LAS float* d = scr + (8 * i + (lane >> 3)) * 33 + 4 * (lane & 7); d[0] = t[i].x; d[1] = t[i].y; d[2] = t[i].z; d[3] = t[i].w; }
    LDS_WAIT(); asm volatile("" ::: "memory");
    const int c = lane & 7;
#pragma unroll
    for (int j = 0; j < 4; ++j) { const int n = (lane >> 3) + 8 * j; const LAS float* s = scr + (8 * c) * 33 + n;
        v4u o; o.x = pk2(s[0 * 33], s[1 * 33]); o.y = pk2(s[2 * 33], s[3 * 33]); o.z = pk2(s[4 * 33], s[5 * 33]); o.w = pk2(s[6 * 33], s[7 * 33]);
        if (wt) st_wt16(WT + (size_t)(drow0 + n) * ldt + k0 + 8 * c, o); else *(GAS v4u*)(WT + (size_t)(drow0 + n) * ldt + k0 + 8 * c) = o; }
    LDS_WAIT(); asm volatile("" ::: "memory");
}

__device__ __forceinline__ void phase_mod_partial(const float* c, const float* w_ada, float* modp, LAS float* scr, int gw, int NGW, int lane) {
    typedef float f32x3 __attribute__((ext_vector_type(3)));
    for (int task = gw; task < 2048; task += NGW) {
        const int ks = task & 15, chunk = (task >> 4) & 63, layer = task >> 10, k0 = ks * 128;
        for (int i = lane; i < 256; i += 64) { const float v = c[(i >> 7) * DM + k0 + (i & 127)]; scr[i] = v / (1.0f + __expf(-v)); }
        LDS_WAIT(); asm volatile("" ::: "memory");
        const float* wp = w_ada + ((size_t)layer * DM + k0) * 12288 + chunk * 192 + lane * 3;
        f32x3 a0 = {0.f, 0.f, 0.f}, a1 = {0.f, 0.f, 0.f};
#pragma unroll 16
        for (int k = 0; k < 128; ++k) { const f32x3 w = __builtin_nontemporal_load((const f32x3*)(wp + (size_t)k * 12288)); const float s0 = scr[k], s1 = scr[128 + k]; a0 += w * s0; a1 += w * s1; }
        float* o = modp + ((size_t)((ks * 2 + layer) * 2) * 12288) + chunk * 192 + lane * 3;
        *(f32x3*)o = a0; *(f32x3*)(o + 12288) = a1;
        LDS_WAIT(); asm volatile("" ::: "memory");
    }
}
__device__ __forceinline__ void rope_table(const int* positions, float* rope, int gtid, int nthr) {
    for (int idx = gtid; idx < NTOK * 8; idx += nthr) {
        const int tok = idx >> 3, i = idx & 7;
        const double invf = i == 0 ? 1.0 : i == 1 ? 0.19392274474868576 : i == 2 ? 0.03760603093086393 : i == 3 ? 0.007292664737217109 : i == 4 ? 0.001414213562373095 : i == 5 ? 0.0002742481756762073 : i == 6 ? 5.318295896944988e-05 : 1.031338537721246e-05;
        const double a = (double)positions[tok] * invf;
        const double kq = __builtin_rint(a * 0.6366197723675814);
        double r = __builtin_fma(-kq, 1.5707963267948966, a); r = __builtin_fma(-kq, 6.123233995736766e-17, r);
        const double r2 = r * r;
        double sn = 1.0 / 6227020800.0; sn = sn * r2 - 1.0 / 39916800.0; sn = sn * r2 + 1.0 / 362880.0; sn = sn * r2 - 1.0 / 5040.0; sn = sn * r2 + 1.0 / 120.0; sn = sn * r2 - 1.0 / 6.0; sn = sn * r2 + 1.0; sn *= r;
        double cs = -1.0 / 87178291200.0; cs = cs * r2 + 1.0 / 479001600.0; cs = cs * r2 - 1.0 / 3628800.0; cs = cs * r2 + 1.0 / 40320.0; cs = cs * r2 - 1.0 / 720.0; cs = cs * r2 + 1.0 / 24.0; cs = cs * r2 - 0.5; cs = cs * r2 + 1.0;
        const int q = ((int)(long long)kq) & 3;
        const double co = q == 0 ? cs : q == 1 ? -sn : q == 2 ? -cs : sn, si = q == 0 ? sn : q == 1 ? cs : q == 2 ? -sn : -cs;
        rope[(size_t)tok * 16 + i] = (float)co; rope[(size_t)tok * 16 + 8 + i] = (float)si;
    }
}

__device__ __forceinline__ void modulate_row_lds(const float* xrow, const LAS float* sh, const LAS float* sc, bf16* orow, int lane) {
    const GAS f32x4* xr = (const GAS f32x4*)xrow + lane; GAS unsigned long long* o8 = (GAS unsigned long long*)orow + lane;
#pragma unroll
    for (int j = 0; j < 8; ++j) { const f32x4 v = xr[64 * j]; const f32x4 s = *(const LAS f32x4*)(sc + 256 * j + 4 * lane), h = *(const LAS f32x4*)(sh + 256 * j + 4 * lane);
        const f32x4 o = v * (s + 1.0f) + h; o8[64 * j] = (unsigned long long)pk2(o.x, o.y) | ((unsigned long long)pk2(o.z, o.w) << 32); }
}

struct In {
    const float *x, *c; const int* positions; const float *w_ada, *b_ada, *swa_w_qkv, *swa_b_qkv, *swa_sinks, *swa_w_o, *nsa_w_in, *nsa_pe_k, *nsa_pe_v, *nsa_phi_k1, *nsa_phi_k2, *nsa_phi_v1, *nsa_phi_v2, *nsa_w_o,
        *moe_w_group, *moe_b_group, *moe_w_router, *moe_b_router, *moe_w1, *moe_w3, *moe_w2, *ln_t_g, *ln_t_b, *ln_c_g, *ln_c_b;
};

constexpr int CV_QKV = 32 * 80, CV_WO = 32 * 64, CV_WIN = 32 * 115, CV_PHI = 16 * 8, CV_MOE = 16 * 3 * 512;
constexpr int CV_A = CV_QKV + CV_WO;
constexpr int CV_B = CV_A + CV_MOE;
constexpr int CV_C = CV_B + CV_WIN + CV_WO + 4 * CV_PHI;
constexpr int CV_D = CV_C + CV_MOE;
__device__ __forceinline__ void conv_moe_item(const In& I, unsigned char* ws, int layer, int r, LAS float* scr, int lane) {
    if (r < 16 * 2 * 512) { const int mat = r / 512, q = r % 512, le = layer * 16 + (mat >> 1), which = mat & 1;
        const int n0 = 32 * (q % 16);
        transpose_item((which ? I.moe_w3 : I.moe_w1) + (size_t)le * 2048 * 512, 512, (bf16*)(ws + WS_W13) + (size_t)le * 1024 * 2048, 2048, 64 * (q / 16), n0, (n0 >> 7) * 256 + which * 128 + (n0 & 127), scr, lane); return; }
    r -= 16 * 2 * 512;
    { const int le = layer * 16 + r / 512, q = r % 512;
      transpose_item(I.moe_w2 + (size_t)le * 512 * 2048, 2048, (bf16*)(ws + WS_W2) + (size_t)le * 2048 * 512, 512, 64 * (q / 64), 32 * (q % 64), 32 * (q % 64), scr, lane, layer == 1); }
}
__device__ __forceinline__ void conv_item(const In& I, unsigned char* ws, int it, LAS float* scr, int lane) {
    int r = it;
    if (r < CV_QKV) { transpose_item(I.swa_w_qkv, 2560, (bf16*)(ws + WS_WQKV), 2048, 64 * (r / 80), 32 * (r % 80), 32 * (r % 80), scr, lane); return; } r -= CV_QKV;
    if (r < CV_WO) { transpose_item(I.swa_w_o, 2048, (bf16*)(ws + WS_WO0), 2048, 64 * (r / 64), 32 * (r % 64), 32 * (r % 64), scr, lane); return; } r -= CV_WO;
    if (r < CV_MOE) { conv_moe_item(I, ws, 0, r, scr, lane); return; } r -= CV_MOE;
    if (r < CV_WIN) { transpose_item(I.nsa_w_in, 3680, (bf16*)(ws + WS_WIN), 2048, 64 * (r / 115), 32 * (r % 115), 32 * (r % 115), scr, lane); return; } r -= CV_WIN;
    if (r < CV_WO) { transpose_item(I.nsa_w_o, 2048, (bf16*)(ws + WS_WO1), 2048, 64 * (r / 64), 32 * (r % 64), 32 * (r % 64), scr, lane); return; } r -= CV_WO;
    if (r < 4 * CV_PHI) { const int j = r / CV_PHI, q = r % CV_PHI, which = j >> 1, half = j & 1;
        transpose_item((which ? I.nsa_phi_v1 : I.nsa_phi_k1) + (size_t)half * 1024 * 256, 256, (bf16*)(ws + (which ? WS_PHIV : WS_PHIK)), 1024, 64 * (q / 8), 32 * (q % 8), half * 256 + 32 * (q % 8), scr, lane); return; }
    r -= 4 * CV_PHI;
    if (r < CV_MOE) conv_moe_item(I, ws, 1, r, scr, lane);
}
__device__ __forceinline__ bool conv_batch(const In& I, unsigned char* ws, LAS unsigned char* lds, int limit, const unsigned* donew, unsigned done_target, int tid, int wave, int lane, int& w2cnt) {
    volatile LAS int* sb = (volatile LAS int*)(lds + 131072 + 2048);
    if (tid == 0) { const bool stop = donew && ld_u32_agent(donew) >= done_target;
        sb[0] = stop ? 0x7fffffff : (int)atomicAdd((unsigned*)(ws + WS_CTL) + CW_FQ, 8u); }
    LDS_WAIT(); __syncthreads();
    const int sv = sb[0];
    __syncthreads();
    if (sv == 0x7fffffff) return false;
    const int base = CV_A + sv, it = base + wave;
    if (it < CV_D) conv_item(I, ws, it, (LAS float*)(lds + wave * 16384), lane);
    { const int lo_ = base > CV_D - 16 * 512 ? base : CV_D - 16 * 512, hi_ = base + 8 < CV_D ? base + 8 : CV_D; w2cnt += hi_ > lo_ ? hi_ - lo_ : 0; }
    return base < limit;
}
__device__ __forceinline__ void conv_publish(unsigned char* ws, int w2cnt, int tid) {
    if (w2cnt) {
        asm volatile("s_waitcnt vmcnt(0)" ::: "memory"); __syncthreads();
        if (tid == 0) __hip_atomic_fetch_add((unsigned*)(ws + WS_CTL) + CW_W2, (unsigned)w2cnt, __ATOMIC_RELAXED, __HIP_MEMORY_SCOPE_AGENT); }
}
__device__ __forceinline__ void conv_fill(const In& I, unsigned char* ws, LAS unsigned char* lds, int slot, int G, int tid, int wave, int lane) {
    unsigned* donew = (unsigned*)(ws + WS_CTL) + CW_DONE + 64 * slot;
    if (tid == 0) atomicAdd(donew, 1u);
    int w2cnt = 0;
    for (int n = 0; n < 64; ++n) if (!conv_batch(I, ws, lds, CV_D, donew, (unsigned)G, tid, wave, lane, w2cnt)) break;
    conv_publish(ws, w2cnt, tid);
    __syncthreads();
}
__device__ __forceinline__ void conv_drain(const In& I, unsigned char* ws, LAS unsigned char* lds, int limit, int tid, int wave, int lane) {
    int w2cnt = 0;
    while (conv_batch(I, ws, lds, limit, nullptr, 0u, tid, wave, lane, w2cnt)) {}
    conv_publish(ws, w2cnt, tid);
    __syncthreads();
}

__device__ __forceinline__ void phase_prologue(const In& I, unsigned char* ws, LAS unsigned char* lds, int tid, int lane, int wave, int vcu, int G) {
    const float* modp = (const float*)(ws + WS_MODP); float* mod = (float*)(ws + WS_MOD);
    LAS float* msm = (LAS float*)(lds + 65536);
#pragma unroll 1
    for (int it = 0; it < 2; ++it) {
        f32x4 pv[2][16];
#pragma unroll
        for (int u = 0; u < 2; ++u) { const int i4 = tid + (NWAVES * 64) * (2 * it + u), b = i4 >> 10, col = (i4 & 1023) * 4;
#pragma unroll
            for (int ks = 0; ks < 16; ++ks) pv[u][ks] = *(const f32x4*)(modp + (size_t)((ks * 2 + 0) * 2 + b) * 12288 + col); }
#pragma unroll
        for (int u = 0; u < 2; ++u) { const int i4 = tid + (NWAVES * 64) * (2 * it + u), col = (i4 & 1023) * 4; f32x4 sacc = *(const f32x4*)(I.b_ada + col);
#pragma unroll
            for (int ks = 0; ks < 16; ++ks) sacc += pv[u][ks];
            *(LAS f32x4*)(msm + 4 * i4) = sacc; } }
    { const int gidx = vcu * 192 + tid;
      if (tid < 192 && gidx < 2 * 2 * 12288) { const int layer = gidx / 24576, rem = gidx % 24576, b = rem / 12288, col = rem % 12288; float s = I.b_ada[layer * 12288 + col];
#pragma unroll
          for (int ks = 0; ks < 16; ++ks) s += modp[(size_t)((ks * 2 + layer) * 2 + b) * 12288 + col];
          mod[gidx] = s; } }
    __syncthreads();
    const int gw = vcu * NWAVES + wave, NGW = G * NWAVES;
    bf16* H = (bf16*)(ws + WS_H);
    for (int m0 = gw; m0 < NTOK; m0 += 4 * NGW) {
        f32x4 xv[4][8];
#pragma unroll
        for (int r = 0; r < 4; ++r) { const int m = m0 + r * NGW; if (m < NTOK) { const GAS f32x4* xr = (const GAS f32x4*)(I.x + (size_t)m * DM) + lane;
#pragma unroll
            for (int j = 0; j < 8; ++j) xv[r][j] = __builtin_nontemporal_load(xr + 64 * j); } }
#pragma unroll
        for (int r = 0; r < 4; ++r) { const int m = m0 + r * NGW; if (m < NTOK) { const int b = m >> 12; const LAS float* sh = msm + b * 4096; const LAS float* sc = sh + 2048;
            GAS unsigned long long* o8 = (GAS unsigned long long*)(H + (size_t)m * DM) + lane;
#pragma unroll
            for (int j = 0; j < 8; ++j) { const f32x4 sv = *(const LAS f32x4*)(sc + 256 * j + 4 * lane), hv = *(const LAS f32x4*)(sh + 256 * j + 4 * lane);
                const f32x4 o = xv[r][j] * (sv + 1.0f) + hv; o8[64 * j] = (unsigned long long)pk2(o.x, o.y) | ((unsigned long long)pk2(o.z, o.w) << 32); } } }
    }
    { const int T = gw >> 2, part = gw & 3, which = T >> 8, cc = T & 255; const float* pe = which ? I.nsa_pe_v : I.nsa_pe_k; const float* phi = which ? I.nsa_phi_v1 : I.nsa_phi_k1;
      float pv_[8], qv_[8]; float s = 0.f;
#pragma unroll
      for (int i = 0; i < 8; ++i) { const int k = 512 * part + lane + 64 * i; pv_[i] = pe[k]; qv_[i] = phi[(size_t)k * 256 + cc]; }
#pragma unroll
      for (int i = 0; i < 8; ++i) s += pv_[i] * qv_[i];
      s = wave_sum(s); if (lane == 0) ((LAS float*)(lds + 131072 + 1024))[wave] = s; }
    LDS_WAIT(); __syncthreads();
    if ((wave & 3) == 0 && lane == 0) { const LAS float* q4 = (const LAS float*)(lds + 131072 + 1024) + wave; const int T = gw >> 2; ((float*)(ws + WS_CMPB))[T] = (q4[0] + q4[1]) + (q4[2] + q4[3]); }
    LAS float* scr = (LAS float*)(lds + wave * 16384);
    for (int it = gw; it < CV_A; it += NGW) conv_item(I, ws, it, scr, lane);
}

template <int W, bool SINK>
__device__ __forceinline__ void banded_unit(int b, int hkv, int tb, int g, int lane, const bf16* Q, const bf16* K, const bf16* VT, bf16* OUT, const float* sinks) {
    const int r32 = lane & 31, hi = lane >> 5, head = hkv * 8 + g, q0 = tb * 32, t = q0 + r32;
    const size_t row = (size_t)b * SEQ + t;
    fa::bf16x8 qr[4]; fa::load_q(qr, Q + row * DM + head * 64, hi);
    const bf16* Kbh = K + (size_t)(b * 4 + hkv) * SEQ * 64; const bf16* Vbh = VT + (size_t)(b * 4 + hkv) * 64 * SEQ;
    fa::State st; st.o0 = fa::f32x16{}; st.o1 = fa::f32x16{};
    if (SINK) { st.m = sinks[head] * LOG2E; st.l = hi == 0 ? 1.0f : 0.0f; } else { st.m = fa::NEGBIG; st.l = 0.f; }
    const int ktA = tb - W / 32 > 0 ? tb - W / 32 : 0;
    fa::Frag fc, fn; fa::load_tile(fc, Kbh, Vbh, SEQ, ktA * 32, r32, hi);
    for (int kt = ktA; kt <= tb; ++kt) {
        if (kt < tb) fa::load_tile(fn, Kbh, Vbh, SEQ, (kt + 1) * 32, r32, hi);
        const bool nm = (kt == tb) || (kt == tb - W / 32);
        fa::step(st, fc, qr, kt * 32, hi, nm, t - W + 1, t);
        fc = fn;
    }
    const float inv = fa::finish(st);
    fa::store_o(st, inv, OUT + row * DM + head * 64, hi);
}
template <int W, bool SINK>
__device__ __forceinline__ void phase_banded(int vcu, int G, int wave, int lane, const bf16* Q, const bf16* K, const bf16* VT, bf16* OUT, const float* sinks) {
    for (int u = vcu; u < 1024; u += G) { const int bh = (u >> 5) & 7, tb = ((u >> 8) << 5) | (u & 31); banded_unit<W, SINK>(bh >> 2, bh & 3, tb, wave, lane, Q, K, VT, OUT, sinks); }
}

__device__ __forceinline__ void phase_lnt(const In& I, unsigned char* ws, LAS unsigned char* wsm  , LAS int* esm  , int layer, const bf16* Y, int gw, int lane_in, int tid, int vcu) {
    const float* mod = (const float*)(ws + WS_MOD); bf16* XA = (bf16*)(ws + WS_XA); bf16* H = (bf16*)(ws + WS_H);
    const float* lng = I.ln_t_g + layer * DM; const float* lnb = I.ln_t_b + layer * DM;
    const float* wg = I.moe_w_group + (size_t)layer * DM * 4; const float* wr = I.moe_w_router + (size_t)layer * DM * 16;
    int* tokE = (int*)(ws + WS_TOKE); float* tokW = (float*)(ws + WS_TOKW); int* tokS = (int*)(ws + WS_TOKS);
    constexpr int WCH = 64 * 272 + 64 * 80;
    f32x4 sr0, sr1, sgp = {0.f, 0.f, 0.f, 0.f};
    const int sk0 = tid >> 2, sk1 = (tid + 512) >> 2, sq = tid & 3;
    const float* srp0 = wr + (size_t)sk0 * 16 + 4 * sq; const float* srp1 = wr + (size_t)sk1 * 16 + 4 * sq; const float* sgpp = wg + (size_t)tid * 4;
    const int so0 = (sk0 >> 2) * 272 + (sk0 & 3) * 64 + sq * 16, so1 = (sk1 >> 2) * 272 + (sk1 & 3) * 64 + sq * 16, sog = 64 * 272 + (tid >> 2) * 80 + (tid & 3) * 16;
#define STAGE_LD(ch) do { sr0 = *(const f32x4*)(srp0 + (size_t)(ch) * 4096); sr1 = *(const f32x4*)(srp1 + (size_t)(ch) * 4096); if (tid < 256) sgp = *(const f32x4*)(sgpp + (size_t)(ch) * 1024); } while (0)
#define STAGE_ST(buf) do { LAS unsigned char* base_ = wsm + (buf) * WCH; *(LAS f32x4*)(base_ + so0) = sr0; *(LAS f32x4*)(base_ + so1) = sr1; if (tid < 256) *(LAS f32x4*)(base_ + sog) = sgp; } while (0)
    STAGE_LD(0); STAGE_ST(0); LDS_WAIT(); __syncthreads();
#pragma unroll 1
    for (int it = 0; it < 2; ++it) {
        int lane_o = lane_in; asm volatile("" : "+v"(lane_o)); const int lane = lane_o;
        const int rA = gw * 4 + it * 2, b = rA >> 12;
        const float* shc = mod + (size_t)(layer * 2 + b) * 12288 + 6144; const float* scc = shc + 2048;
        f32x4 v[2][8]; float rstd[2];
#pragma unroll
        for (int r = 0; r < 2; ++r) {
            const GAS u32x2g* yr = (const GAS u32x2g*)(Y + (size_t)(rA + r) * DM) + lane; float s = 0.f;
#pragma unroll
            for (int j = 0; j < 8; ++j) { const u32x2g w = yr[64 * j]; v[r][j] = (f32x4){fa::bflo(w.x), fa::bfhi(w.x), fa::bflo(w.y), fa::bfhi(w.y)}; s += (v[r][j].x + v[r][j].y) + (v[r][j].z + v[r][j].w); }
            const float mean = wave_sum(s) * (1.f / DM); float s2 = 0.f;
#pragma unroll
            for (int j = 0; j < 8; ++j) { v[r][j] = v[r][j] - mean; s2 += (v[r][j].x * v[r][j].x + v[r][j].y * v[r][j].y) + (v[r][j].z * v[r][j].z + v[r][j].w * v[r][j].w); }
            rstd[r] = 1.f / sqrtf(wave_sum(s2) * (1.f / DM) + LN_EPS);
        }
        float acc[2][20];
#pragma unroll
        for (int r = 0; r < 2; ++r)
#pragma unroll
            for (int e = 0; e < 20; ++e) acc[r][e] = 0.f;
#pragma unroll
        for (int j = 0; j < 8; ++j) { const int col = 256 * j + 4 * lane; const int step = it * 8 + j;
            const f32x4 gg = *(const f32x4*)(lng + col), bb = *(const f32x4*)(lnb + col), sc = *(const f32x4*)(scc + col), sh = *(const f32x4*)(shc + col);
            f32x4 h[2];
#pragma unroll
            for (int r = 0; r < 2; ++r) { const f32x4 x1 = v[r][j] * rstd[r] * gg + bb; ((GAS unsigned long long*)(XA + (size_t)(rA + r) * DM) + lane)[64 * j] = (unsigned long long)pk2(x1.x, x1.y) | ((unsigned long long)pk2(x1.z, x1.w) << 32);
                h[r] = x1 * (sc + 1.0f) + sh;
                ((GAS unsigned long long*)(H + (size_t)(rA + r) * DM) + lane)[64 * j] = (unsigned long long)pk2(h[r].x, h[r].y) | ((unsigned long long)pk2(h[r].z, h[r].w) << 32); }
            if (step < 15) STAGE_LD((j + 1) & 7);
            const LAS unsigned char* cb = wsm + (step & 1) * WCH;
#pragma unroll 1
            for (int i = 0; i < 4; ++i) {
                const float hA = i == 0 ? h[0][0] : i == 1 ? h[0][1] : i == 2 ? h[0][2] : h[0][3], hB = i == 0 ? h[1][0] : i == 1 ? h[1][1] : i == 2 ? h[1][2] : h[1][3];
#pragma unroll
                for (int q = 0; q < 4; ++q) { const f32x4 w = *(const LAS f32x4*)(cb + lane * 272 + i * 64 + q * 16);
#pragma unroll
                    for (int e = 0; e < 4; ++e) { acc[0][4 * q + e] += hA * w[e]; acc[1][4 * q + e] += hB * w[e]; } }
                const f32x4 w = *(const LAS f32x4*)(cb + 64 * 272 + lane * 80 + i * 16);
#pragma unroll
                for (int e = 0; e < 4; ++e) { acc[0][16 + e] += hA * w[e]; acc[1][16 + e] += hB * w[e]; }
            }
            if (step < 15) STAGE_ST((step + 1) & 1);
            LDS_WAIT(); __syncthreads(); __builtin_amdgcn_sched_barrier(0);
        }
#pragma unroll
        for (int r = 0; r < 2; ++r)
#pragma unroll
            for (int e = 0; e < 20; ++e) acc[r][e] = wave_sum(acc[r][e]);
        if (lane < 2) {
            float a[20];
#pragma unroll
            for (int e = 0; e < 20; ++e) a[e] = lane == 0 ? acc[0][e] : acc[1][e];
            const int row = rA + lane;
            float gl[4];
#pragma unroll
            for (int e = 0; e < 4; ++e) gl[e] = a[16 + e] + I.moe_b_group[layer * 4 + e];
            int gi = 0; float gm = gl[0];
#pragma unroll
            for (int e = 1; e < 4; ++e) if (gl[e] > gm) { gm = gl[e]; gi = e; }
            float gs = 0.f;
#pragma unroll
            for (int e = 0; e < 4; ++e) gs += __expf(gl[e] - gm);
            const float gprob = 1.0f / gs;
            float le[4];
#pragma unroll
            for (int e = 0; e < 4; ++e) le[e] = (gi == 0 ? a[e] : gi == 1 ? a[4 + e] : gi == 2 ? a[8 + e] : a[12 + e]) + I.moe_b_router[layer * 16 + gi * 4 + e];
            int i1 = 0; float m1 = le[0];
#pragma unroll
            for (int e = 1; e < 4; ++e) if (le[e] > m1) { m1 = le[e]; i1 = e; }
            int i2 = -1; float m2 = -INFINITY;
#pragma unroll
            for (int e = 0; e < 4; ++e) if (e != i1 && le[e] > m2) { m2 = le[e]; i2 = e; }
            const float p2 = __expf(m2 - m1), den = 1.0f / (1.0f + p2);
            const int e1 = gi * 4 + i1, e2 = gi * 4 + i2; const float w1 = gprob * den, w2 = gprob * p2 * den;
            tokE[row * 2] = e1; tokE[row * 2 + 1] = e2; tokW[row * 2] = w1; tokW[row * 2 + 1] = w2;
            esm[(row & 31) * 2] = e1; esm[(row & 31) * 2 + 1] = e2;
        }
    }
    LDS_WAIT(); __syncthreads();
    {
        int* tokS = (int*)(ws + WS_TOKS); int* bcnt = (int*)(ws + WS_BCNT) + (layer * 256 + vcu) * 16;
        if (tid < 64) { const int my = esm[tid]; int rk = 0;
            for (int j = 0; j < 64; ++j) rk += (j < tid && esm[j] == my) ? 1 : 0;
            tokS[(size_t)(vcu * 32) * 2 + tid] = rk; }
        else if (tid < 80) { const int e = tid - 64; int c = 0;
            for (int j = 0; j < 64; ++j) c += (esm[j] == e) ? 1 : 0;
            bcnt[e] = c; }
    }
    __syncthreads();
}

__device__ __forceinline__ void phase_lnt2(const In& I, unsigned char* ws, LAS unsigned char* lds, LAS int* esm  , int layer, const bf16* Y, int gw, int lane, int tid, int wave, int vcu) {
    typedef float f32x16r __attribute__((ext_vector_type(16)));
    const float* mod = (const float*)(ws + WS_MOD); bf16* XA = (bf16*)(ws + WS_XA); bf16* H = (bf16*)(ws + WS_H);
    const float* lng = I.ln_t_g + layer * DM; const float* lnb = I.ln_t_b + layer * DM;
    const float* wg = I.moe_w_group + (size_t)layer * DM * 4; const float* wr = I.moe_w_router + (size_t)layer * DM * 16;
    constexpr int APITCH = 129, ABYTES = 16640  , RBUF = ABYTES + 128 * 32 * 4;
    const int r0 = gw * 4, b = r0 >> 12;
    const float* shc = mod + (size_t)(layer * 2 + b) * 12288 + 6144; const float* scc = shc + 2048;
    for (int i = tid; i < 2 * 128 * 12; i += NWAVES * 64) { const int bf = i / (128 * 12), rem = i % (128 * 12); ((LAS float*)(lds + bf * RBUF + ABYTES))[(rem / 12) * 32 + 20 + rem % 12] = 0.f; }
    f32x4 v[4][8]; float rstd[4];
#pragma unroll
    for (int r = 0; r < 4; ++r) {
        const GAS u32x2g* yr = (const GAS u32x2g*)(Y + (size_t)(r0 + r) * DM) + lane; float s = 0.f;
#pragma unroll
        for (int j = 0; j < 8; ++j) { const u32x2g w = yr[64 * j]; v[r][j] = (f32x4){fa::bflo(w.x), fa::bfhi(w.x), fa::bflo(w.y), fa::bfhi(w.y)}; s += (v[r][j].x + v[r][j].y) + (v[r][j].z + v[r][j].w); }
        const float mean = wave_sum(s) * (1.f / DM); float s2 = 0.f;
#pragma unroll
        for (int j = 0; j < 8; ++j) { v[r][j] = v[r][j] - mean; s2 += (v[r][j].x * v[r][j].x + v[r][j].y * v[r][j].y) + (v[r][j].z * v[r][j].z + v[r][j].w * v[r][j].w); }
        rstd[r] = 1.f / sqrtf(wave_sum(s2) * (1.f / DM) + LN_EPS);
    }
    const int wk = tid >> 2, wq = tid & 3;
    f32x4 swr = *(const f32x4*)(wr + (size_t)wk * 16 + 4 * wq), swg = {0.f, 0.f, 0.f, 0.f};
    if (tid < 128) swg = *(const f32x4*)(wg + (size_t)tid * 4);
    f32x16r acc = f32x16r{};
    f32x4 h[4];
#pragma unroll
    for (int st = 0; st < 16; ++st) { const int j = st >> 1, hf = st & 1; LAS float* Ab = (LAS float*)(lds + (st & 1) * RBUF); LAS float* Wb = (LAS float*)(lds + (st & 1) * RBUF + ABYTES);
        if (hf == 0) { const int col = 256 * j + 4 * lane;
            const f32x4 gg = *(const f32x4*)(lng + col), bb = *(const f32x4*)(lnb + col), sc = *(const f32x4*)(scc + col), sh = *(const f32x4*)(shc + col);
#pragma unroll
            for (int r = 0; r < 4; ++r) { const f32x4 x1 = v[r][j] * rstd[r] * gg + bb;
                ((GAS unsigned long long*)(XA + (size_t)(r0 + r) * DM) + lane)[64 * j] = (unsigned long long)pk2(x1.x, x1.y) | ((unsigned long long)pk2(x1.z, x1.w) << 32);
                h[r] = x1 * (sc + 1.0f) + sh;
                ((GAS unsigned long long*)(H + (size_t)(r0 + r) * DM) + lane)[64 * j] = (unsigned long long)pk2(h[r].x, h[r].y) | ((unsigned long long)pk2(h[r].z, h[r].w) << 32); } }
        if ((lane >> 5) == hf) {
#pragma unroll
            for (int r = 0; r < 4; ++r) { LAS float* ap = Ab + (wave * 4 + r) * APITCH + 4 * (lane & 31); ap[0] = h[r].x; ap[1] = h[r].y; ap[2] = h[r].z; ap[3] = h[r].w; } }
        *(LAS f32x4*)(Wb + wk * 32 + 4 * wq) = swr; if (tid < 128) *(LAS f32x4*)(Wb + tid * 32 + 16) = swg;
        LDS_WAIT(); __syncthreads();
        if (st < 15) { swr = *(const f32x4*)(wr + (size_t)(128 * (st + 1) + wk) * 16 + 4 * wq); if (tid < 128) swg = *(const f32x4*)(wg + (size_t)(128 * (st + 1) + tid) * 4); }
#pragma unroll
        for (int m = 0; m < 8; ++m) { const int kk = 16 * wave + 2 * m + (lane >> 5);
            acc = __builtin_amdgcn_mfma_f32_32x32x2f32(Ab[(lane & 31) * APITCH + kk], Wb[kk * 32 + (lane & 31)], acc, 0, 0, 0); }
        __builtin_amdgcn_sched_barrier(0);
    }
    __syncthreads();
    { LAS float* red = (LAS float*)lds;
#pragma unroll
      for (int r = 0; r < 16; ++r) red[(wave * 16 + r) * 64 + lane] = acc[r]; }
    LDS_WAIT(); __syncthreads();
    LAS float* lg = (LAS float*)(lds + 40960);
    for (int i = tid; i < 32 * 20; i += NWAVES * 64) { const int row = i / 20, col = i % 20, ln = col + 32 * ((row >> 2) & 1), rg = (row & 3) + 4 * (row >> 3); float s = 0.f;
#pragma unroll
        for (int w = 0; w < 8; ++w) s += ((LAS float*)lds)[(w * 16 + rg) * 64 + ln];
        lg[i] = s; }
    LDS_WAIT(); __syncthreads();
    if (tid < 32) {
        float l2e = 1.4426950408889634f; asm volatile("" : "+v"(l2e));
        float a[20];
#pragma unroll
        for (int e = 0; e < 20; ++e) a[e] = lg[tid * 20 + e];
        const int row = vcu * 32 + tid;
        float gl[4];
#pragma unroll
        for (int e = 0; e < 4; ++e) gl[e] = a[16 + e] + I.moe_b_group[layer * 4 + e];
        int gi = 0; float gm = gl[0];
#pragma unroll
        for (int e = 1; e < 4; ++e) if (gl[e] > gm) { gm = gl[e]; gi = e; }
        float gs = 0.f;
#pragma unroll
        for (int e = 0; e < 4; ++e) gs += __builtin_amdgcn_exp2f((gl[e] - gm) * l2e);
        const float gprob = __builtin_amdgcn_rcpf(gs);
        float le[4];
#pragma unroll
        for (int e = 0; e < 4; ++e) le[e] = (gi == 0 ? a[e] : gi == 1 ? a[4 + e] : gi == 2 ? a[8 + e] : a[12 + e]) + I.moe_b_router[layer * 16 + gi * 4 + e];
        int i1 = 0; float m1 = le[0];
#pragma unroll
        for (int e = 1; e < 4; ++e) if (le[e] > m1) { m1 = le[e]; i1 = e; }
        int i2 = -1; float m2 = -INFINITY;
#pragma unroll
        for (int e = 0; e < 4; ++e) if (e != i1 && le[e] > m2) { m2 = le[e]; i2 = e; }
        const float p2 = __builtin_amdgcn_exp2f((m2 - m1) * l2e), den = __builtin_amdgcn_rcpf(1.0f + p2);
        const int e1 = gi * 4 + i1, e2 = gi * 4 + i2; const float w1 = gprob * den, w2 = gprob * p2 * den;
        esm[tid * 2] = e1; esm[tid * 2 + 1] = e2; ((LAS float*)esm)[64 + tid * 2] = w1; ((LAS float*)esm)[64 + tid * 2 + 1] = w2;
    }
    LDS_WAIT(); __syncthreads();
    {
        int rk = 0, my = 0;
        if (tid < 64) { my = esm[tid];
            for (int jj = 0; jj < 64; ++jj) rk += (jj < tid && esm[jj] == my) ? 1 : 0; }
        else if (tid < 80) { const int e = tid - 64; int c = 0;
            for (int jj = 0; jj < 64; ++jj) c += (esm[jj] == e) ? 1 : 0;
            esm[128 + e] = c ? (int)atomicAdd((unsigned*)(ws + WS_CTL) + CW_CNT + (layer * 16 + e) * CW_CNT_STRIDE, (unsigned)c) : 0; }
        LDS_WAIT(); __syncthreads();
        if (tid < 64) { const int row = vcu * 32 + (tid >> 1), dst = my * SEG_CAP + esm[128 + my] + rk;
            ((int*)(ws + WS_ROWTOK))[dst] = row * 2 + (tid & 1); ((float*)(ws + WS_ROWW))[dst] = ((LAS float*)esm)[64 + tid]; ((int*)(ws + WS_ROWSRC))[dst] = row; }
    }
    __syncthreads();
}

struct Seg { unsigned cnt[16]; };
__device__ __forceinline__ void seg_load(Seg& s, const unsigned* cnt) {
#pragma unroll
    for (int e = 0; e < 16; ++e) s.cnt[e] = ld_u32_agent(cnt + e * CW_CNT_STRIDE);
}
__device__ __forceinline__ int seg_row_base(const Seg& s, int e) {
    int run = 0, base = 0;
#pragma unroll
    for (int k = 0; k < 16; ++k) { if (k == e) base = run; run += (int)((s.cnt[k] + 255u) >> 8); }
    return base * 256;
}
__device__ __forceinline__ void phase_permute(unsigned char* ws, LAS int* psm  , int layer, int gw, int lane, int tid, int vcu) {
    const int* bc = (const int*)(ws + WS_BCNT) + layer * 256 * 16;
    { const int e = tid & 15, part = tid >> 4; int s = 0, pre = 0;
#pragma unroll
      for (int i = 0; i < 8; ++i) { const int v = part * 8 + i; const int c = bc[v * 16 + e]; s += c; pre += (v < vcu) ? c : 0; }
      psm[part * 16 + e] = s; if (part == (vcu >> 3)) psm[512 + 16 + e] = pre; }
    LDS_WAIT(); __syncthreads();
    if (tid < 16) { int tot = 0, bef = 0;
        for (int p = 0; p < 32; ++p) { const int c = psm[p * 16 + tid]; tot += c; bef += (p < (vcu >> 3)) ? c : 0; }
        psm[512 + tid] = tot; psm[512 + 16 + tid] += bef;
        if (vcu == 0) ((unsigned*)(ws + WS_CTL))[CW_CNT + (layer * 16 + tid) * CW_CNT_STRIDE] = (unsigned)tot; }
    LDS_WAIT(); __syncthreads();
    Seg sg;
#pragma unroll
    for (int e = 0; e < 16; ++e) sg.cnt[e] = (unsigned)psm[512 + e];
    const int* tokE = (const int*)(ws + WS_TOKE); const float* tokW = (const float*)(ws + WS_TOKW); const int* tokS = (const int*)(ws + WS_TOKS);
    int* rowtok = (int*)(ws + WS_ROWTOK); float* roww = (float*)(ws + WS_ROWW); int* rowsrc = (int*)(ws + WS_ROWSRC);
    if (tid < 64) { const int row = vcu * 32 + (tid >> 1), k = tid & 1; const int e = tokE[row * 2 + k], dst = seg_row_base(sg, e) + psm[512 + 16 + e] + tokS[row * 2 + k];
        rowtok[dst] = row * 2 + k; roww[dst] = tokW[row * 2 + k]; rowsrc[dst] = row; }
    if (vcu < 16) { const int e = vcu, c = psm[512 + e], b0 = seg_row_base(sg, e) + c, npad = ((c + 255) & ~255) - c;
        if (tid < npad) rowsrc[b0 + tid] = 0; }
    __syncthreads();
}
__device__ __forceinline__ void build_units(pg8::GroupOrder& S, const Seg& sg, int nN, int G, int c) {
    int nT = 0;
#pragma unroll
    for (int e = 0; e < 16; ++e) { S.cnt[e] = (unsigned)__builtin_amdgcn_readfirstlane((int)sg.cnt[e]); nT += (int)((S.cnt[e] + 255u) >> 8); }
    S.nT = nT; S.nN = nN; S.G = G; S.c = c;
}

__device__ __forceinline__ void lnc_stage(const In& I, unsigned char* ws, LAS float* P, int layer, int b, int tid) {
    const float* mod = (const float*)(ws + WS_MOD);
    const float* src[5] = {mod + (size_t)(layer * 2 + b) * 12288 + 10240, I.ln_c_g + layer * DM, I.ln_c_b + layer * DM, mod + (size_t)(2 + b) * 12288 + 2048, mod + (size_t)(2 + b) * 12288};
#pragma unroll
    for (int a = 0; a < 5; ++a) *(LAS f32x4*)(P + a * 2048 + 4 * tid) = *(const f32x4*)(src[a] + 4 * tid);
    LDS_WAIT(); __syncthreads();
}
__device__ __forceinline__ void phase_lnc(const In& I, unsigned char* ws, int layer, float* xout32  , bf16* xout16  , bool write_h, int gw, int lane, const LAS float* P) {
    const float* mod = (const float*)(ws + WS_MOD); const bf16* XA = (const bf16*)(ws + WS_XA); const bf16* YS = (const bf16*)(ws + WS_YS); bf16* H = (bf16*)(ws + WS_H);
    const float* lng = I.ln_c_g + layer * DM; const float* lnb = I.ln_c_b + layer * DM;
    const int row0 = gw * 4, b = row0 >> 12;
    const float* gc = mod + (size_t)(layer * 2 + b) * 12288 + 10240;
    const float* shn = mod + (size_t)(2 + b) * 12288; const float* scn = shn + 2048;
    u32x2g rx[2][8], ra[2][8], rc[2][8];
#define LNC_LOAD(pp) do { _Pragma("unroll") for (int r = 0; r < 2; ++r) { const int row = row0 + 2 * (pp) + r; \
        const GAS u32x2g* xr = (const GAS u32x2g*)(XA + (size_t)row * DM) + lane; const GAS u32x2g* s0 = (const GAS u32x2g*)(YS + (size_t)(row * 2) * DM) + lane; const GAS u32x2g* s1 = (const GAS u32x2g*)(YS + (size_t)(row * 2 + 1) * DM) + lane; \
        _Pragma("unroll") for (int j = 0; j < 8; ++j) { rx[r][j] = xr[64 * j]; ra[r][j] = s0[64 * j]; rc[r][j] = s1[64 * j]; } } } while (0)
#pragma unroll 1
    for (int pp = 0; pp < 2; ++pp) {
        LNC_LOAD(pp);
        f32x4 v[2][8]; float s[2] = {0.f, 0.f};
#pragma unroll
        for (int r = 0; r < 2; ++r)
#pragma unroll
            for (int j = 0; j < 8; ++j) { const u32x2g xw = rx[r][j], a = ra[r][j], c = rc[r][j]; const f32x4 g = *(const LAS f32x4*)(P + 256 * j + 4 * lane);
                const f32x4 x1 = {fa::bflo(xw.x), fa::bfhi(xw.x), fa::bflo(xw.y), fa::bfhi(xw.y)};
                f32x4 m; m.x = fa::bflo(a.x) + fa::bflo(c.x); m.y = fa::bfhi(a.x) + fa::bfhi(c.x); m.z = fa::bflo(a.y) + fa::bflo(c.y); m.w = fa::bfhi(a.y) + fa::bfhi(c.y);
                v[r][j] = x1 * ALPHA_RES + g * m; s[r] += (v[r][j].x + v[r][j].y) + (v[r][j].z + v[r][j].w); }
#pragma unroll
        for (int r = 0; r < 2; ++r) { const int row = row0 + 2 * pp + r;
            const float mean = wave_sum(s[r]) * (1.f / DM); float s2 = 0.f;
#pragma unroll
            for (int j = 0; j < 8; ++j) { v[r][j] = v[r][j] - mean; s2 += (v[r][j].x * v[r][j].x + v[r][j].y * v[r][j].y) + (v[r][j].z * v[r][j].z + v[r][j].w * v[r][j].w); }
            const float rstd = 1.f / sqrtf(wave_sum(s2) * (1.f / DM) + LN_EPS);
            GAS f32x4* xo = (GAS f32x4*)(xout32 + (size_t)row * DM) + lane; GAS unsigned long long* xo16 = (GAS unsigned long long*)(xout16 + (size_t)row * DM) + lane; GAS unsigned long long* ho = (GAS unsigned long long*)(H + (size_t)row * DM) + lane;
#pragma unroll
            for (int j = 0; j < 8; ++j) { const int col = 256 * j + 4 * lane; const f32x4 gg = *(const LAS f32x4*)(P + 2048 + col), bb = *(const LAS f32x4*)(P + 4096 + col);
                const f32x4 x2 = v[r][j] * rstd * gg + bb; if (write_h) xo16[64 * j] = (unsigned long long)pk2(x2.x, x2.y) | ((unsigned long long)pk2(x2.z, x2.w) << 32); else xo[64 * j] = x2;
                if (write_h) { const f32x4 sc = *(const LAS f32x4*)(P + 6144 + col), sh = *(const LAS f32x4*)(P + 8192 + col); const f32x4 h = x2 * (sc + 1.0f) + sh;
                    ho[64 * j] = (unsigned long long)pk2(h.x, h.y) | ((unsigned long long)pk2(h.z, h.w) << 32); } } }
    }
#undef LNC_LOAD
}

__device__ __forceinline__ void phase_cmp2(const In& I, unsigned char* ws, LAS unsigned char* lds, int gw, int NGW, int lane, int tid, int wave) {
    LAS float* phl = (LAS float*)lds;
    LAS float* hid = (LAS float*)(lds + 131072 + 4096 + wave * 1024);
    __syncthreads();
    { f32x4 t[16];
#pragma unroll
      for (int j = 0; j < 16; ++j) { const int i = tid + j * NWAVES * 64; t[j] = *(const f32x4*)((i < 4096 ? I.nsa_phi_k2 : I.nsa_phi_v2) + 4 * (i & 4095)); }
#pragma unroll
      for (int j = 0; j < 16; ++j) *(LAS f32x4*)(phl + 4 * (tid + j * NWAVES * 64)) = t[j]; }
    LDS_WAIT(); __syncthreads();
    bf16* kc = (bf16*)(ws + WS_KCMP); bf16* vct = (bf16*)(ws + WS_VCMPT);
#pragma unroll 1
    for (int task = gw; task < 4096; task += NGW) { const int which = task >> 11, bh = (task >> 8) & 7, n = task & 255; float o = 0.f;
        if (n < 255) { const float* UL = (const float*)(ws + (which ? WS_ULV : WS_ULK)); const float* cb = (const float*)(ws + WS_CMPB) + which * 256;
            const f32x4 u = *(const f32x4*)(UL + (size_t)(bh * 256 + n) * 512 + 4 * lane), l = *(const f32x4*)(UL + (size_t)(bh * 256 + n + 1) * 512 + 256 + 4 * lane), bb = *(const f32x4*)(cb + 4 * lane);
            f32x4 h = u + l + bb;
#pragma unroll
            for (int i = 0; i < 4; ++i) h[i] = h[i] / (1.0f + __expf(-h[i]));
            *(LAS f32x4*)(hid + 4 * lane) = h; LDS_WAIT(); asm volatile("" ::: "memory");
            const LAS float* ph = phl + which * 16384;
            float o0 = 0.f, o1 = 0.f, o2 = 0.f, o3 = 0.f;
#pragma unroll 4
            for (int cidx = 0; cidx < 256; cidx += 4) { const f32x4 hv = *(const LAS f32x4*)(hid + cidx);
                o0 += hv.x * ph[cidx * 64 + lane]; o1 += hv.y * ph[(cidx + 1) * 64 + lane]; o2 += hv.z * ph[(cidx + 2) * 64 + lane]; o3 += hv.w * ph[(cidx + 3) * 64 + lane]; }
            o = (o0 + o1) + (o2 + o3);
            LDS_WAIT(); asm volatile("" ::: "memory"); }
        if (which == 0) kc[(size_t)(bh * 256 + n) * 64 + lane] = (bf16)f2bf(o); else vct[(size_t)(bh * 64 + lane) * 256 + n] = (bf16)f2bf(o);
    }
    __syncthreads();
}

constexpr int CMP_XS = 0, CMP_TOT = 34816, CMP_K = 45056, CMP_V = 81920, CMP_VP = 528;
__device__ __forceinline__ fa::bf16x8 ov_frag(int d, bool spill_only) {
    fa::u32x4 w = {0u, 0u, 0u, 0u};
    if (!spill_only) {
        if (d == 0) { w.x = 0x3F803F80u; w.y = 0x3F003F80u; }
        else if (d == 1) { w.y = 0x3F000000u; w.z = 0x3F803F80u; w.w = 0x3F003F80u; }
        else if (d == 2) { w.w = 0x3F000000u; } }
    else if (d == 2) w.w = 0x3F000000u;
    return __builtin_bit_cast(fa::bf16x8, w);
}
__device__ __forceinline__ void cmp_unit(unsigned char* ws, LAS unsigned char* lds, int b, int hkv, int tb, int tid, int wave, int lane) {
    const int r32 = lane & 31, hi = lane >> 5, head = hkv * 8 + wave, q0 = tb * 32, t = q0 + r32; const size_t row = (size_t)b * SEQ + t;
    const bf16* Q = (const bf16*)(ws + WS_Q); bf16* OUT = (bf16*)(ws + WS_OCMP);
    LAS float* tot = (LAS float*)(lds + CMP_TOT);
    fa::bf16x8 qr[4]; fa::load_q(qr, Q + row * DM + head * 64, hi);
    {
        const fa::u32x4 mine = __builtin_bit_cast(fa::u32x4, qr[0]); fa::u32x4 oth;
#pragma unroll
        for (int i = 0; i < 4; ++i) { const auto rr = __builtin_amdgcn_permlane32_swap(mine[i], mine[i], false, false); oth[i] = hi ? rr[0] : rr[1]; }
        const float* rp = (const float*)(ws + WS_ROPE) + row * 16; const f32x4 c0 = *(const f32x4*)rp, c1 = *(const f32x4*)(rp + 4), s0 = *(const f32x4*)(rp + 8), s1 = *(const f32x4*)(rp + 12);
        const float sg = hi ? -1.f : 1.f; fa::u32x4 o;
        o.x = fa::cvtpk(fa::bflo(mine.x) * c0.x + sg * fa::bflo(oth.x) * s0.x, fa::bfhi(mine.x) * c0.y + sg * fa::bfhi(oth.x) * s0.y);
        o.y = fa::cvtpk(fa::bflo(mine.y) * c0.z + sg * fa::bflo(oth.y) * s0.z, fa::bfhi(mine.y) * c0.w + sg * fa::bfhi(oth.y) * s0.w);
        o.z = fa::cvtpk(fa::bflo(mine.z) * c1.x + sg * fa::bflo(oth.z) * s1.x, fa::bfhi(mine.z) * c1.y + sg * fa::bfhi(oth.z) * s1.y);
        o.w = fa::cvtpk(fa::bflo(mine.w) * c1.z + sg * fa::bflo(oth.w) * s1.z, fa::bfhi(mine.w) * c1.w + sg * fa::bfhi(oth.w) * s1.w);
        qr[0] = __builtin_bit_cast(fa::bf16x8, o); }
    fa::State st; st.o0 = fa::f32x16{}; st.o1 = fa::f32x16{}; st.m = fa::NEGBIG; st.l = 0.f;
    fa::f32x16 impA = fa::f32x16{}, impB = fa::f32x16{};
    const int nhi = (t - 31) >> 4;
    const int nhi_min = (q0 - 31) >> 4;
    const int ntile = ((2 * tb) >> 5) + 1;
    const LAS unsigned char* kl = lds + CMP_K + fa::kap(r32) * 144 + hi * 16;
    const LAS unsigned char* vl = lds + CMP_V + r32 * CMP_VP + hi * 16;
    for (int kt = 0; kt < ntile; ++kt) {
        fa::Frag f;
#pragma unroll
        for (int d0 = 0; d0 < 4; ++d0) f.k[d0] = *(const LAS fa::bf16x8*)(kl + kt * 32 * 144 + d0 * 32);
#pragma unroll
        for (int db = 0; db < 2; ++db)
#pragma unroll
            for (int sx = 0; sx < 2; ++sx) f.v[db * 2 + sx] = *(const LAS fa::bf16x8*)(vl + db * 32 * CMP_VP + kt * 64 + sx * 32);
        fa::f32x16 p; fa::scores(p, f, qr);
        if (kt * 32 + 31 > nhi_min) fa::mask_range(p, kt * 32, hi, 0, nhi);
        float tm = fmaxf(p[0], p[1]);
#pragma unroll
        for (int r = 2; r < 16; ++r) tm = fmaxf(tm, p[r]);
        tm = fa::xmax(tm);
        const float mn = fmaxf(st.m, tm); const float alpha = __builtin_amdgcn_exp2f(st.m - mn); st.m = mn;
        float rs = 0.f;
#pragma unroll
        for (int r = 0; r < 16; ++r) { p[r] = __builtin_amdgcn_exp2f(p[r] - mn); rs += p[r]; }
        st.l = st.l * alpha + rs;
        if (!__all(alpha == 1.0f)) { st.o0 = st.o0 * alpha; st.o1 = st.o1 * alpha; impA = impA * alpha; impB = impB * alpha; }
        fa::u32x4 w0, w1;
        w0.x = fa::cvtpk(p[0], p[1]); w0.y = fa::cvtpk(p[2], p[3]); w0.z = fa::cvtpk(p[4], p[5]); w0.w = fa::cvtpk(p[6], p[7]);
        w1.x = fa::cvtpk(p[8], p[9]); w1.y = fa::cvtpk(p[10], p[11]); w1.z = fa::cvtpk(p[12], p[13]); w1.w = fa::cvtpk(p[14], p[15]);
        const fa::bf16x8 pb0 = __builtin_bit_cast(fa::bf16x8, w0), pb1 = __builtin_bit_cast(fa::bf16x8, w1);
        st.o0 = __builtin_amdgcn_mfma_f32_32x32x16_bf16(f.v[0], pb0, st.o0, 0, 0, 0);
        st.o0 = __builtin_amdgcn_mfma_f32_32x32x16_bf16(f.v[1], pb1, st.o0, 0, 0, 0);
        st.o1 = __builtin_amdgcn_mfma_f32_32x32x16_bf16(f.v[2], pb0, st.o1, 0, 0, 0);
        st.o1 = __builtin_amdgcn_mfma_f32_32x32x16_bf16(f.v[3], pb1, st.o1, 0, 0, 0);
        { const int T = kt >> 2, S = 32 * T + r32;
          const fa::bf16x8 o0f = ov_frag(S - (8 * kt + 2 * hi), false), o1f = ov_frag(S - (8 * kt + 4 + 2 * hi), false);
          if (T == 0) { impA = __builtin_amdgcn_mfma_f32_32x32x16_bf16(o0f, pb0, impA, 0, 0, 0); impA = __builtin_amdgcn_mfma_f32_32x32x16_bf16(o1f, pb1, impA, 0, 0, 0); }
          else        { impB = __builtin_amdgcn_mfma_f32_32x32x16_bf16(o0f, pb0, impB, 0, 0, 0); impB = __builtin_amdgcn_mfma_f32_32x32x16_bf16(o1f, pb1, impB, 0, 0, 0); }
          if (kt == 3) {
              const fa::bf16x8 sp = ov_frag((r32 == 0 && hi == 1) ? 2 : 9, true);
              impB = __builtin_amdgcn_mfma_f32_32x32x16_bf16(sp, pb1, impB, 0, 0, 0); } }
    }
    const float inv = fa::finish(st);
    fa::store_o(st, inv, OUT + row * DM + head * 64, hi);
    LAS float* xs = (LAS float*)(lds + CMP_XS) + (wave & 3) * (32 * 66) + r32 * 66 + 4 * hi;
#define CMP_XW(EXPR_A, EXPR_B) do { _Pragma("unroll") for (int r = 0; r < 16; ++r) { const int sl = (r & 3) + 8 * (r >> 2); xs[sl] = (EXPR_A); xs[32 + sl] = (EXPR_B); } } while (0)
    if (wave >= 4) CMP_XW(impA[r] * inv, impB[r] * inv);
    LDS_WAIT(); __syncthreads();
    if (wave < 4) CMP_XW(impA[r] * inv + xs[sl], impB[r] * inv + xs[32 + sl]);
#undef CMP_XW
    LDS_WAIT(); __syncthreads();
    for (int i = tid; i < 32 * 64; i += NWAVES * 64) { const int q = i >> 6, j = i & 63; float s = 0.f;
#pragma unroll
        for (int w = 0; w < 4; ++w) s += ((LAS float*)(lds + CMP_XS))[w * (32 * 66) + q * 66 + j];
        const int tq = q0 + q, cur = tq >> 6; const bool causal = j * 64 <= tq, forced = (j == 0) || (j == cur) || (j == cur - 1);
        const float sc_ = causal ? s + (forced ? 1e4f : 0.f) : -1e30f;
        const unsigned ub = __float_as_uint(sc_); ((LAS unsigned*)tot)[q * 68 + j] = ub ^ ((unsigned)((int)ub >> 31) | 0x80000000u); }
    LDS_WAIT(); __syncthreads();
    {
        const int q = tid >> 4, part = tid & 15, tq = q0 + q;
        const LAS unsigned* tk = (const LAS unsigned*)tot + q * 68;
        const fa::u32x4 mine = *(const LAS fa::u32x4*)(tk + 4 * part);
        const unsigned key[4] = {mine.x, mine.y, mine.z, mine.w};
        int rk[4] = {0, 0, 0, 0};
#pragma unroll 4
        for (int c = 0; c < 16; ++c) { const fa::u32x4 kv = *(const LAS fa::u32x4*)(tk + 4 * c); const unsigned dec = c < part ? 1u : 0u;
#pragma unroll
            for (int i = 0; i < 4; ++i) { const unsigned thr = key[i] - dec; rk[i] += (kv.x > thr ? 1 : 0) + (kv.y > thr ? 1 : 0) + (kv.z > thr ? 1 : 0) + (kv.w > thr ? 1 : 0); } }
        rk[1] += (key[0] == key[1]) ? 1 : 0;
        rk[2] += ((key[0] == key[2]) ? 1 : 0) + ((key[1] == key[2]) ? 1 : 0);
        rk[3] += ((key[0] == key[3]) ? 1 : 0) + ((key[1] == key[3]) ? 1 : 0) + ((key[2] == key[3]) ? 1 : 0);
        unsigned lo = 0u, hi32 = 0u;
#pragma unroll
        for (int i = 0; i < 4; ++i) { const int j = 4 * part + i; if (rk[i] < 16) { if (j < 32) lo |= 1u << j; else hi32 |= 1u << (j - 32); } }
#pragma unroll
        for (int o = 1; o < 16; o <<= 1) { lo |= __shfl_xor(lo, o); hi32 |= __shfl_xor(hi32, o); }
        if (part == 0) ((unsigned long long*)(ws + WS_SELM))[(size_t)(b * 4 + hkv) * SEQ + tq] = ((unsigned long long)hi32 << 32) | lo;
    }
    __syncthreads();
}

__device__ __forceinline__ void sel_unit(unsigned char* ws, int b, int hkv, int tb, int wave, int lane) {
    const int r32 = lane & 31, hi = lane >> 5, head = hkv * 8 + wave, q0 = tb * 32, t = q0 + r32; const size_t row = (size_t)b * SEQ + t;
    const bf16* Q = (const bf16*)(ws + WS_Q); bf16* OUT = (bf16*)(ws + WS_ATT);
    const bf16* Kbh = (const bf16*)(ws + WS_KS) + (size_t)(b * 4 + hkv) * SEQ * 64; const bf16* Vbh = (const bf16*)(ws + WS_VST) + (size_t)(b * 4 + hkv) * 64 * SEQ;
    const unsigned long long selm = ((const unsigned long long*)(ws + WS_SELM))[(size_t)(b * 4 + hkv) * SEQ + t];
    unsigned ulo = (unsigned)selm, uhi = (unsigned)(selm >> 32);
#pragma unroll
    for (int o = 1; o < 64; o <<= 1) { ulo |= __shfl_xor(ulo, o); uhi |= __shfl_xor(uhi, o); }
    const unsigned long long U = ((unsigned long long)(unsigned)__builtin_amdgcn_readfirstlane((int)uhi) << 32) | (unsigned)__builtin_amdgcn_readfirstlane((int)ulo);
    fa::bf16x8 qr[4]; fa::load_q(qr, Q + row * DM + head * 64, hi);
    fa::State st; st.o0 = fa::f32x16{}; st.o1 = fa::f32x16{}; st.m = fa::NEGBIG; st.l = 0.f;
    int kt = 0; while (kt <= tb && !((U >> (kt >> 1)) & 1ull)) ++kt;
    fa::Frag fc, fn; if (kt <= tb) fa::load_tile(fc, Kbh, Vbh, SEQ, kt * 32, r32, hi);
    while (kt <= tb) {
        int kn = kt + 1; while (kn <= tb && !((U >> (kn >> 1)) & 1ull)) ++kn;
        if (kn <= tb) fa::load_tile(fn, Kbh, Vbh, SEQ, kn * 32, r32, hi);
        const bool mine = (selm >> (kt >> 1)) & 1ull;
        const bool nm = (kt == tb) || !__all(mine);
        fa::step(st, fc, qr, kt * 32, hi, nm, 0, mine ? t : -1);
        fc = fn; kt = kn;
    }
    const float inv = fa::finish(st);
    const float* gates = (const float*)(ws + WS_GATES) + row * 96 + head * 3; const float g0 = gates[0], g1 = gates[1] * inv, g2 = gates[2];
    const bf16* oc = (const bf16*)(ws + WS_OCMP) + row * DM + head * 64; const bf16* ow = (const bf16*)(ws + WS_OWIN) + row * DM + head * 64; bf16* od = OUT + row * DM + head * 64;
#pragma unroll
    for (int g = 0; g < 4; ++g)
#pragma unroll
        for (int db = 0; db < 2; ++db) { const int d = 32 * db + 8 * g + 4 * hi; const u32x2g c = *(const u32x2g*)(oc + d), w = *(const u32x2g*)(ow + d);
            const fa::f32x16& oo = db ? st.o1 : st.o0;
            const float v0 = g0 * fa::bflo(c.x) + g1 * oo[4 * g] + g2 * fa::bflo(w.x), v1 = g0 * fa::bfhi(c.x) + g1 * oo[4 * g + 1] + g2 * fa::bfhi(w.x);
            const float v2 = g0 * fa::bflo(c.y) + g1 * oo[4 * g + 2] + g2 * fa::bflo(w.y), v3 = g0 * fa::bfhi(c.y) + g1 * oo[4 * g + 3] + g2 * fa::bfhi(w.y);
            u32x2g o; o.x = fa::cvtpk(v0, v1); o.y = fa::cvtpk(v2, v3); *(u32x2g*)(od + d) = o; }
}
namespace fb {
using fa::bf16x8; using fa::f32x16; using fa::u32x4;
constexpr int PITCH = 144, TILE = 64 * PITCH, BUF = 2 * TILE;
constexpr float RESC_THR = 8.0f;
struct Stage { v4u k, v; };
__device__ __forceinline__ void stage_load(Stage& s, const bf16* Kbh, const bf16* Vbh, int VP, int key0, int tid) {
    const int row = tid >> 3, ch = tid & 7;
    s.k = *(const GAS v4u*)(Kbh + (size_t)(key0 + row) * 64 + ch * 8);
    s.v = *(const GAS v4u*)(Vbh + (size_t)row * VP + key0 + ch * 8);
}
__device__ __forceinline__ void stage_store(const Stage& s, LAS unsigned char* lds, int buf, int tid) {
    const int row = tid >> 3, ch = tid & 7; LAS unsigned char* p = lds + buf * BUF + row * PITCH + ch * 16;
    *(LAS v4u*)p = s.k; *(LAS v4u*)(p + TILE) = s.v;
}
__device__ __forceinline__ void stage_load2(Stage& s, const bf16* Kbh, const bf16* Vbh, int VP, int keyK, int keyV, int tid) {
    const int row = tid >> 3, ch = tid & 7;
    s.k = *(const GAS v4u*)(Kbh + (size_t)(keyK + row) * 64 + ch * 8);
    s.v = *(const GAS v4u*)(Vbh + (size_t)row * VP + keyV + ch * 8);
}
__device__ __forceinline__ void stage_store2(const Stage& s, LAS unsigned char* kdst, LAS unsigned char* vdst, int tid) {
    const int row = tid >> 3, ch = tid & 7; *(LAS v4u*)(kdst + row * PITCH + ch * 16) = s.k; *(LAS v4u*)(vdst + row * PITCH + ch * 16) = s.v;
}
__device__ __forceinline__ void frag_load_k(bf16x8 (&k)[8], const LAS unsigned char* lds, int buf, int r32, int hi) {
    const LAS unsigned char* kb = lds + buf * BUF + fa::kap(r32) * PITCH + hi * 16;
#pragma unroll
    for (int h = 0; h < 2; ++h)
#pragma unroll
        for (int d0 = 0; d0 < 4; ++d0) k[h * 4 + d0] = *(const LAS bf16x8*)(kb + h * 32 * PITCH + d0 * 32);
}
__device__ __forceinline__ void frag_load_v(bf16x8 (&v)[8], const LAS unsigned char* lds, int buf, int r32, int hi) {
    const LAS unsigned char* vb = lds + buf * BUF + TILE + r32 * PITCH + hi * 16;
#pragma unroll
    for (int db = 0; db < 2; ++db)
#pragma unroll
        for (int h = 0; h < 2; ++h)
#pragma unroll
            for (int s = 0; s < 2; ++s) v[(db * 2 + h) * 2 + s] = *(const LAS bf16x8*)(vb + db * 32 * PITCH + h * 64 + s * 32);
}
struct QState { f32x16 o0, o1; float m, l; };
__device__ __forceinline__ void block_step(QState& st, const LAS unsigned char* lds, int buf, int r32, const LAS unsigned char* qlds  , int key0, int hi, bool sel, bool emask, int lo, int hi_) {
    f32x16 p0 = f32x16{}, p1 = f32x16{};
    { bf16x8 fk[8], qr[4]; frag_load_k(fk, lds, buf, r32, hi);
#pragma unroll
      for (int d0 = 0; d0 < 4; ++d0) qr[d0] = *(const LAS bf16x8*)(qlds + d0 * 1024);
#pragma unroll
    for (int d0 = 0; d0 < 4; ++d0) { p0 = __builtin_amdgcn_mfma_f32_32x32x16_bf16(fk[d0], qr[d0], p0, 0, 0, 0); p1 = __builtin_amdgcn_mfma_f32_32x32x16_bf16(fk[4 + d0], qr[d0], p1, 0, 0, 0); } }
    if (emask) { fa::mask_range(p0, key0, hi, lo, hi_); fa::mask_range(p1, key0 + 32, hi, lo, hi_); }
    float ta = fmaxf(p0[0], p0[1]), tb = fmaxf(p1[0], p1[1]);
#pragma unroll
    for (int r = 2; r < 16; ++r) { ta = fmaxf(ta, p0[r]); tb = fmaxf(tb, p1[r]); }
    const float tm = fa::xmax(fmaxf(ta, tb));
    const float mn = (sel && tm - st.m > RESC_THR) ? tm : st.m; const float alpha = __builtin_amdgcn_exp2f(st.m - mn); st.m = mn;
    const float me = sel ? mn : INFINITY;
    float rs0 = 0.f, rs1 = 0.f;
#pragma unroll
    for (int r = 0; r < 16; ++r) { p0[r] = __builtin_amdgcn_exp2f(p0[r] - me); p1[r] = __builtin_amdgcn_exp2f(p1[r] - me); rs0 += p0[r]; rs1 += p1[r]; }
#if defined(ATT_PROBE) && ATT_PROBE == 1
    {
#pragma unroll
      for (int r = 0; r < 32; ++r) { float d_; asm volatile("v_exp_f32 %0, %1" : "=v"(d_) : "v"(p0[r & 15])); } }
#endif
    st.l = st.l * alpha + (rs0 + rs1);
    if (!__all(alpha == 1.0f)) { st.o0 = st.o0 * alpha; st.o1 = st.o1 * alpha; }
    u32x4 w;
    w.x = fa::cvtpk(p0[0], p0[1]); w.y = fa::cvtpk(p0[2], p0[3]); w.z = fa::cvtpk(p0[4], p0[5]); w.w = fa::cvtpk(p0[6], p0[7]); const bf16x8 a0 = __builtin_bit_cast(bf16x8, w);
    w.x = fa::cvtpk(p0[8], p0[9]); w.y = fa::cvtpk(p0[10], p0[11]); w.z = fa::cvtpk(p0[12], p0[13]); w.w = fa::cvtpk(p0[14], p0[15]); const bf16x8 a1 = __builtin_bit_cast(bf16x8, w);
    w.x = fa::cvtpk(p1[0], p1[1]); w.y = fa::cvtpk(p1[2], p1[3]); w.z = fa::cvtpk(p1[4], p1[5]); w.w = fa::cvtpk(p1[6], p1[7]); const bf16x8 b0 = __builtin_bit_cast(bf16x8, w);
    w.x = fa::cvtpk(p1[8], p1[9]); w.y = fa::cvtpk(p1[10], p1[11]); w.z = fa::cvtpk(p1[12], p1[13]); w.w = fa::cvtpk(p1[14], p1[15]); const bf16x8 b1 = __builtin_bit_cast(bf16x8, w);
    bf16x8 fv[8]; frag_load_v(fv, lds, buf, r32, hi);
#if defined(ATT_PROBE) && ATT_PROBE == 2
    { f32x16 dm = f32x16{};
#pragma unroll
      for (int r = 0; r < 8; ++r) dm = __builtin_amdgcn_mfma_f32_32x32x16_bf16(fv[r], a0, dm, 0, 0, 0);
      asm volatile("" :: "v"(dm)); }
#endif
#if defined(ATT_PROBE) && ATT_PROBE == 3
    { bf16x8 fx[8]; frag_load_k(fx, lds, buf, r32 ^ 1, hi);
#pragma unroll
      for (int r = 0; r < 8; ++r) asm volatile("" :: "v"(fx[r])); }
#endif
    st.o0 = __builtin_amdgcn_mfma_f32_32x32x16_bf16(fv[0], a0, st.o0, 0, 0, 0); st.o1 = __builtin_amdgcn_mfma_f32_32x32x16_bf16(fv[4], a0, st.o1, 0, 0, 0);
    st.o0 = __builtin_amdgcn_mfma_f32_32x32x16_bf16(fv[1], a1, st.o0, 0, 0, 0); st.o1 = __builtin_amdgcn_mfma_f32_32x32x16_bf16(fv[5], a1, st.o1, 0, 0, 0);
    st.o0 = __builtin_amdgcn_mfma_f32_32x32x16_bf16(fv[2], b0, st.o0, 0, 0, 0); st.o1 = __builtin_amdgcn_mfma_f32_32x32x16_bf16(fv[6], b0, st.o1, 0, 0, 0);
    st.o0 = __builtin_amdgcn_mfma_f32_32x32x16_bf16(fv[3], b1, st.o0, 0, 0, 0); st.o1 = __builtin_amdgcn_mfma_f32_32x32x16_bf16(fv[7], b1, st.o1, 0, 0, 0);
}
__device__ __forceinline__ void qk2(f32x16& pa0, f32x16& pa1, f32x16& pb0, f32x16& pb1, const LAS unsigned char* lds, int buf, int r32, const LAS unsigned char* qpark, int hi) {
    pa0 = f32x16{}; pa1 = f32x16{}; pb0 = f32x16{}; pb1 = f32x16{};
    { bf16x8 fk[8]; frag_load_k(fk, lds, buf, r32, hi);
#pragma unroll
      for (int d0 = 0; d0 < 4; ++d0) { const bf16x8 qa = *(const LAS bf16x8*)(qpark + d0 * 1024);
          pa0 = __builtin_amdgcn_mfma_f32_32x32x16_bf16(fk[d0], qa, pa0, 0, 0, 0); pa1 = __builtin_amdgcn_mfma_f32_32x32x16_bf16(fk[4 + d0], qa, pa1, 0, 0, 0); }
#pragma unroll
      for (int d0 = 0; d0 < 4; ++d0) { const bf16x8 qb = *(const LAS bf16x8*)(qpark + 4096 + d0 * 1024);
          pb0 = __builtin_amdgcn_mfma_f32_32x32x16_bf16(fk[d0], qb, pb0, 0, 0, 0); pb1 = __builtin_amdgcn_mfma_f32_32x32x16_bf16(fk[4 + d0], qb, pb1, 0, 0, 0); } }
}
__device__ __forceinline__ void sp2(QState& s0, QState& s1, f32x16& pa0, f32x16& pa1, f32x16& pb0, f32x16& pb1, const LAS unsigned char* lds, int buf, int r32, int key0, int hi,
                                    bool sel0, bool sel1, bool emask, int lo0, int hi0, int lo1, int hi1) {
    bf16x8 fv[8];
#define SP_(st, p0, p1, sel, lo, hi_, LOADV) do { \
    if (emask) { fa::mask_range(p0, key0, hi, lo, hi_); fa::mask_range(p1, key0 + 32, hi, lo, hi_); } \
    float ta = fmaxf(p0[0], p0[1]), tb = fmaxf(p1[0], p1[1]); \
    _Pragma("unroll") for (int r = 2; r < 16; ++r) { ta = fmaxf(ta, p0[r]); tb = fmaxf(tb, p1[r]); } \
    const float tm = fa::xmax(fmaxf(ta, tb)); \
    const float mn = (sel && tm - st.m > RESC_THR) ? tm : st.m; const float alpha = __builtin_amdgcn_exp2f(st.m - mn); st.m = mn; \
    const float me = sel ? mn : INFINITY; \
    float rs0 = 0.f, rs1 = 0.f; \
    _Pragma("unroll") for (int r = 0; r < 16; ++r) { p0[r] = __builtin_amdgcn_exp2f(p0[r] - me); p1[r] = __builtin_amdgcn_exp2f(p1[r] - me); rs0 += p0[r]; rs1 += p1[r]; } \
    st.l = st.l * alpha + (rs0 + rs1); \
    if (!__all(alpha == 1.0f)) { st.o0 = st.o0 * alpha; st.o1 = st.o1 * alpha; } \
    u32x4 w; \
    w.x = fa::cvtpk(p0[0], p0[1]); w.y = fa::cvtpk(p0[2], p0[3]); w.z = fa::cvtpk(p0[4], p0[5]); w.w = fa::cvtpk(p0[6], p0[7]); const bf16x8 a0 = __builtin_bit_cast(bf16x8, w); \
    w.x = fa::cvtpk(p0[8], p0[9]); w.y = fa::cvtpk(p0[10], p0[11]); w.z = fa::cvtpk(p0[12], p0[13]); w.w = fa::cvtpk(p0[14], p0[15]); const bf16x8 a1 = __builtin_bit_cast(bf16x8, w); \
    w.x = fa::cvtpk(p1[0], p1[1]); w.y = fa::cvtpk(p1[2], p1[3]); w.z = fa::cvtpk(p1[4], p1[5]); w.w = fa::cvtpk(p1[6], p1[7]); const bf16x8 b0 = __builtin_bit_cast(bf16x8, w); \
    w.x = fa::cvtpk(p1[8], p1[9]); w.y = fa::cvtpk(p1[10], p1[11]); w.z = fa::cvtpk(p1[12], p1[13]); w.w = fa::cvtpk(p1[14], p1[15]); const bf16x8 b1 = __builtin_bit_cast(bf16x8, w); \
    if (LOADV) { __builtin_amdgcn_sched_barrier(0); frag_load_v(fv, lds, buf, r32, hi); } \
    st.o0 = __builtin_amdgcn_mfma_f32_32x32x16_bf16(fv[0], a0, st.o0, 0, 0, 0); st.o1 = __builtin_amdgcn_mfma_f32_32x32x16_bf16(fv[4], a0, st.o1, 0, 0, 0); \
    st.o0 = __builtin_amdgcn_mfma_f32_32x32x16_bf16(fv[1], a1, st.o0, 0, 0, 0); st.o1 = __builtin_amdgcn_mfma_f32_32x32x16_bf16(fv[5], a1, st.o1, 0, 0, 0); \
    st.o0 = __builtin_amdgcn_mfma_f32_32x32x16_bf16(fv[2], b0, st.o0, 0, 0, 0); st.o1 = __builtin_amdgcn_mfma_f32_32x32x16_bf16(fv[6], b0, st.o1, 0, 0, 0); \
    st.o0 = __builtin_amdgcn_mfma_f32_32x32x16_bf16(fv[3], b1, st.o0, 0, 0, 0); st.o1 = __builtin_amdgcn_mfma_f32_32x32x16_bf16(fv[7], b1, st.o1, 0, 0, 0); } while (0)
    SP_(s0, pa0, pa1, sel0, lo0, hi0, true);
    __builtin_amdgcn_sched_barrier(0);
    SP_(s1, pb0, pb1, sel1, lo1, hi1, false);
#undef SP_
}
#define FB_SBAR() __builtin_amdgcn_sched_barrier(0)
#define FB_PIN(x) asm volatile("" : "+v"(x))
#define FB_MFMA(a, b, c) __builtin_amdgcn_mfma_f32_32x32x16_bf16(a, b, c, 0, 0, 0)
__device__ __forceinline__ void blk2(QState& s0, QState& s1, const LAS unsigned char* lds, int buf, int r32, const LAS unsigned char* qpark, int key0, int hi,
                                     bool sel0, bool sel1, bool emask, int lo0, int hi0, int lo1, int hi1, Stage& sg, bool more, const bf16* Kbh, const bf16* Vbh, int tid) {
    bf16x8 fk[8], fv[8], qa[4], qb[4];
    frag_load_k(fk, lds, buf, r32, hi);
#pragma unroll
    for (int d0 = 0; d0 < 4; ++d0) qa[d0] = *(const LAS bf16x8*)(qpark + d0 * 1024);
#pragma unroll
    for (int d0 = 0; d0 < 4; ++d0) qb[d0] = *(const LAS bf16x8*)(qpark + 4096 + d0 * 1024);
    f32x16 pa0 = f32x16{}, pa1 = f32x16{}, pb0 = f32x16{}, pb1 = f32x16{};
#pragma unroll
    for (int d0 = 0; d0 < 4; ++d0) { pa0 = FB_MFMA(fk[d0], qa[d0], pa0); pa1 = FB_MFMA(fk[4 + d0], qa[d0], pa1); }
    FB_SBAR();
    if (more) stage_load(sg, Kbh, Vbh, SEQ, key0 + 64, tid);
    const LAS unsigned char* vb = lds + buf * BUF + TILE + r32 * PITCH + hi * 16;
#define FB_VLD(i) fv[i] = *(const LAS bf16x8*)(vb + ((i) >> 2) * 32 * PITCH + (((i) >> 1) & 1) * 64 + ((i) & 1) * 32)
    u32x4 wa0, wa1, wb0, wb1; float ta, tb, me, alpha, rs0, rs1;
#define FB_MAX1(p0, p1) do { ta = fmaxf(p0[0], p0[1]); tb = fmaxf(p1[0], p1[1]); _Pragma("unroll") for (int r = 2; r < 8; ++r) { ta = fmaxf(ta, p0[r]); tb = fmaxf(tb, p1[r]); } FB_PIN(ta); FB_PIN(tb); } while (0)
#define FB_MAX2(st, p0, p1, sel) do { _Pragma("unroll") for (int r = 8; r < 16; ++r) { ta = fmaxf(ta, p0[r]); tb = fmaxf(tb, p1[r]); } \
        const float tm = fa::xmax(fmaxf(ta, tb)); const float mn = (sel && tm - st.m > RESC_THR) ? tm : st.m; alpha = __builtin_amdgcn_exp2f(st.m - mn); st.m = mn; me = sel ? mn : INFINITY; \
        rs0 = 0.f; rs1 = 0.f; FB_PIN(me); FB_PIN(alpha); } while (0)
#define FB_EXP(p0, p1, i, W0, W1) do { p0[2 * (i)] = __builtin_amdgcn_exp2f(p0[2 * (i)] - me); p0[2 * (i) + 1] = __builtin_amdgcn_exp2f(p0[2 * (i) + 1] - me); \
        p1[2 * (i)] = __builtin_amdgcn_exp2f(p1[2 * (i)] - me); p1[2 * (i) + 1] = __builtin_amdgcn_exp2f(p1[2 * (i) + 1] - me); \
        rs0 += p0[2 * (i)]; rs1 += p1[2 * (i)]; rs0 += p0[2 * (i) + 1]; rs1 += p1[2 * (i) + 1]; \
        W0[(i) & 3] = fa::cvtpk(p0[2 * (i)], p0[2 * (i) + 1]); W1[(i) & 3] = fa::cvtpk(p1[2 * (i)], p1[2 * (i) + 1]); } while (0)
#if defined(ATT_PROBE) && ATT_PROBE == 11
#define FB_XTRA() do { float d0_, d1_, d2_; asm volatile("v_exp_f32 %0, %3\n\tv_exp_f32 %1, %3\n\tv_exp_f32 %2, %3" : "=&v"(d0_), "=&v"(d1_), "=&v"(d2_) : "v"(me)); } while (0)
#elif defined(ATT_PROBE) && ATT_PROBE == 12
#define FB_XTRA() do { float d0_, d1_, d2_; asm volatile("v_add_f32 %0, %3, %3\n\tv_add_f32 %1, %3, %3\n\tv_add_f32 %2, %3, %3\n\tv_add_f32 %0, %3, %3\n\tv_add_f32 %1, %3, %3\n\tv_add_f32 %2, %3, %3" : "=&v"(d0_), "=&v"(d1_), "=&v"(d2_) : "v"(me)); } while (0)
#else
#define FB_XTRA() do { } while (0)
#endif
#define FB_ENDGAP(W0, W1) do { FB_XTRA(); FB_PIN(W0); FB_PIN(W1); FB_PIN(rs0); FB_PIN(rs1); FB_SBAR(); } while (0)
    if (emask) { fa::mask_range(pa0, key0, hi, lo0, hi0); fa::mask_range(pa1, key0 + 32, hi, lo0, hi0); }
    pb0 = FB_MFMA(fk[0], qb[0], pb0); FB_MAX1(pa0, pa1); FB_SBAR();
    pb1 = FB_MFMA(fk[4], qb[0], pb1); FB_MAX2(s0, pa0, pa1, sel0); FB_SBAR();
    pb0 = FB_MFMA(fk[1], qb[1], pb0); FB_EXP(pa0, pa1, 0, wa0, wb0); FB_EXP(pa0, pa1, 1, wa0, wb0); FB_ENDGAP(wa0, wb0);
    pb1 = FB_MFMA(fk[5], qb[1], pb1); FB_EXP(pa0, pa1, 2, wa0, wb0); FB_ENDGAP(wa0, wb0);
    pb0 = FB_MFMA(fk[2], qb[2], pb0); FB_VLD(0); FB_VLD(4); FB_EXP(pa0, pa1, 3, wa0, wb0); FB_ENDGAP(wa0, wb0);
    pb1 = FB_MFMA(fk[6], qb[2], pb1); FB_VLD(1); FB_VLD(5); FB_EXP(pa0, pa1, 4, wa1, wb1); FB_EXP(pa0, pa1, 5, wa1, wb1); FB_ENDGAP(wa1, wb1);
    pb0 = FB_MFMA(fk[3], qb[3], pb0); FB_VLD(2); FB_VLD(6); FB_EXP(pa0, pa1, 6, wa1, wb1); FB_ENDGAP(wa1, wb1);
    pb1 = FB_MFMA(fk[7], qb[3], pb1); FB_VLD(3); FB_VLD(7); FB_EXP(pa0, pa1, 7, wa1, wb1); FB_ENDGAP(wa1, wb1);
    s0.l = s0.l * alpha + (rs0 + rs1);
    if (!__all(alpha == 1.0f)) { s0.o0 = s0.o0 * alpha; s0.o1 = s0.o1 * alpha; }
    if (emask) { fa::mask_range(pb0, key0, hi, lo1, hi1); fa::mask_range(pb1, key0 + 32, hi, lo1, hi1); }
    const bf16x8 a0 = __builtin_bit_cast(bf16x8, wa0), a1 = __builtin_bit_cast(bf16x8, wa1), b0 = __builtin_bit_cast(bf16x8, wb0), b1 = __builtin_bit_cast(bf16x8, wb1);
    u32x4 xa0, xa1, xb0, xb1;
    FB_SBAR();
    s0.o0 = FB_MFMA(fv[0], a0, s0.o0); FB_MAX1(pb0, pb1); FB_SBAR();
    s0.o1 = FB_MFMA(fv[4], a0, s0.o1); FB_MAX2(s1, pb0, pb1, sel1); FB_SBAR();
    s0.o0 = FB_MFMA(fv[1], a1, s0.o0); FB_EXP(pb0, pb1, 0, xa0, xb0); FB_EXP(pb0, pb1, 1, xa0, xb0); FB_ENDGAP(xa0, xb0);
    s0.o1 = FB_MFMA(fv[5], a1, s0.o1); FB_EXP(pb0, pb1, 2, xa0, xb0); FB_ENDGAP(xa0, xb0);
    s0.o0 = FB_MFMA(fv[2], b0, s0.o0); FB_EXP(pb0, pb1, 3, xa0, xb0); FB_ENDGAP(xa0, xb0);
    s0.o1 = FB_MFMA(fv[6], b0, s0.o1); FB_EXP(pb0, pb1, 4, xa1, xb1); FB_EXP(pb0, pb1, 5, xa1, xb1); FB_ENDGAP(xa1, xb1);
    s0.o0 = FB_MFMA(fv[3], b1, s0.o0); FB_EXP(pb0, pb1, 6, xa1, xb1); FB_ENDGAP(xa1, xb1);
    s0.o1 = FB_MFMA(fv[7], b1, s0.o1); FB_EXP(pb0, pb1, 7, xa1, xb1); FB_ENDGAP(xa1, xb1);
    s1.l = s1.l * alpha + (rs0 + rs1);
    if (!__all(alpha == 1.0f)) { s1.o0 = s1.o0 * alpha; s1.o1 = s1.o1 * alpha; }
    { const bf16x8 c0 = __builtin_bit_cast(bf16x8, xa0), c1 = __builtin_bit_cast(bf16x8, xa1), e0 = __builtin_bit_cast(bf16x8, xb0), e1 = __builtin_bit_cast(bf16x8, xb1);
      s1.o0 = FB_MFMA(fv[0], c0, s1.o0); s1.o1 = FB_MFMA(fv[4], c0, s1.o1); s1.o0 = FB_MFMA(fv[1], c1, s1.o0); s1.o1 = FB_MFMA(fv[5], c1, s1.o1);
      s1.o0 = FB_MFMA(fv[2], e0, s1.o0); s1.o1 = FB_MFMA(fv[6], e0, s1.o1); s1.o0 = FB_MFMA(fv[3], e1, s1.o0); s1.o1 = FB_MFMA(fv[7], e1, s1.o1); }
#undef FB_VLD
#undef FB_MAX1
#undef FB_MAX2
#undef FB_EXP
#undef FB_ENDGAP
}
__device__ __forceinline__ void blk3(QState& s0, QState& s1, const LAS unsigned char* vslot, const LAS unsigned char* knext, int r32, const LAS unsigned char* qpark, int key0, int hi,
                                     bool sel0, bool sel1, bool emask, int lo0, int hi0, int lo1, int hi1, Stage& sg, int keyK, int keyV, const bf16* Kbh, const bf16* Vbh, int tid,
                                     bf16x8 (&fk)[8], bf16x8 (&qa)[4]) {
    bf16x8 fv[8], qb[4];
    qb[0] = *(const LAS bf16x8*)(qpark + 4096); qb[1] = *(const LAS bf16x8*)(qpark + 4096 + 1024);
    f32x16 pa0 = f32x16{}, pa1 = f32x16{}, pb0 = f32x16{}, pb1 = f32x16{};
#pragma unroll
    for (int d0 = 0; d0 < 4; ++d0) { pa0 = FB_MFMA(fk[d0], qa[d0], pa0); pa1 = FB_MFMA(fk[4 + d0], qa[d0], pa1); }
    FB_SBAR();
    { const int row_ = tid >> 3, ch_ = tid & 7; sg.v = *(const GAS v4u*)(Vbh + (size_t)row_ * SEQ + keyV + ch_ * 8); }
    FB_SBAR();
    const LAS unsigned char* vb = vslot + r32 * PITCH + hi * 16;
#define FB_VLD(i) fv[i] = *(const LAS bf16x8*)(vb + ((i) >> 2) * 32 * PITCH + (((i) >> 1) & 1) * 64 + ((i) & 1) * 32)
    u32x4 wa0, wa1, wb0, wb1; float ta, tb, me, alpha, rs0, rs1;
#define FB_MAX1(p0, p1) do { ta = fmaxf(p0[0], p0[1]); tb = fmaxf(p1[0], p1[1]); _Pragma("unroll") for (int r = 2; r < 8; ++r) { ta = fmaxf(ta, p0[r]); tb = fmaxf(tb, p1[r]); } FB_PIN(ta); FB_PIN(tb); } while (0)
#define FB_MAX2(st, p0, p1, sel) do { _Pragma("unroll") for (int r = 8; r < 16; ++r) { ta = fmaxf(ta, p0[r]); tb = fmaxf(tb, p1[r]); } \
        const float tm = fa::xmax(fmaxf(ta, tb)); const float mn = (sel && tm - st.m > RESC_THR) ? tm : st.m; alpha = __builtin_amdgcn_exp2f(st.m - mn); st.m = mn; me = sel ? mn : INFINITY; \
        rs0 = 0.f; rs1 = 0.f; FB_PIN(me); FB_PIN(alpha); } while (0)
#define FB_EXP(p0, p1, i, W0, W1) do { p0[2 * (i)] = __builtin_amdgcn_exp2f(p0[2 * (i)] - me); p0[2 * (i) + 1] = __builtin_amdgcn_exp2f(p0[2 * (i) + 1] - me); \
        p1[2 * (i)] = __builtin_amdgcn_exp2f(p1[2 * (i)] - me); p1[2 * (i) + 1] = __builtin_amdgcn_exp2f(p1[2 * (i) + 1] - me); \
        rs0 += p0[2 * (i)]; rs1 += p1[2 * (i)]; rs0 += p0[2 * (i) + 1]; rs1 += p1[2 * (i) + 1]; \
        W0[(i) & 3] = fa::cvtpk(p0[2 * (i)], p0[2 * (i) + 1]); W1[(i) & 3] = fa::cvtpk(p1[2 * (i)], p1[2 * (i) + 1]); } while (0)
#if defined(ATT_PROBE) && ATT_PROBE == 11
#define FB_XTRA() do { float d0_, d1_, d2_; asm volatile("v_exp_f32 %0, %3\n\tv_exp_f32 %1, %3\n\tv_exp_f32 %2, %3" : "=&v"(d0_), "=&v"(d1_), "=&v"(d2_) : "v"(me)); } while (0)
#elif defined(ATT_PROBE) && ATT_PROBE == 12
#define FB_XTRA() do { float d0_, d1_, d2_; asm volatile("v_add_f32 %0, %3, %3\n\tv_add_f32 %1, %3, %3\n\tv_add_f32 %2, %3, %3\n\tv_add_f32 %0, %3, %3\n\tv_add_f32 %1, %3, %3\n\tv_add_f32 %2, %3, %3" : "=&v"(d0_), "=&v"(d1_), "=&v"(d2_) : "v"(me)); } while (0)
#else
#define FB_XTRA() do { } while (0)
#endif
#define FB_ENDGAP(W0, W1) do { FB_XTRA(); FB_PIN(W0); FB_PIN(W1); FB_PIN(rs0); FB_PIN(rs1); FB_SBAR(); } while (0)
    if (emask) { fa::mask_range(pa0, key0, hi, lo0, hi0); fa::mask_range(pa1, key0 + 32, hi, lo0, hi0); }
    pb0 = FB_MFMA(fk[0], qb[0], pb0); FB_MAX1(pa0, pa1); FB_SBAR();
    pb1 = FB_MFMA(fk[4], qb[0], pb1); qb[2] = *(const LAS bf16x8*)(qpark + 4096 + 2048); qb[3] = *(const LAS bf16x8*)(qpark + 4096 + 3072); FB_MAX2(s0, pa0, pa1, sel0); FB_SBAR();
    pb0 = FB_MFMA(fk[1], qb[1], pb0); FB_EXP(pa0, pa1, 0, wa0, wb0); FB_EXP(pa0, pa1, 1, wa0, wb0); FB_ENDGAP(wa0, wb0);
    pb1 = FB_MFMA(fk[5], qb[1], pb1); FB_EXP(pa0, pa1, 2, wa0, wb0); FB_ENDGAP(wa0, wb0);
    pb0 = FB_MFMA(fk[2], qb[2], pb0); FB_VLD(0); FB_VLD(4); FB_EXP(pa0, pa1, 3, wa0, wb0); FB_ENDGAP(wa0, wb0);
    pb1 = FB_MFMA(fk[6], qb[2], pb1); FB_VLD(1); FB_VLD(5); FB_EXP(pa0, pa1, 4, wa1, wb1); FB_EXP(pa0, pa1, 5, wa1, wb1); FB_ENDGAP(wa1, wb1);
    pb0 = FB_MFMA(fk[3], qb[3], pb0); FB_VLD(2); FB_VLD(6); FB_EXP(pa0, pa1, 6, wa1, wb1); FB_ENDGAP(wa1, wb1);
    pb1 = FB_MFMA(fk[7], qb[3], pb1); FB_VLD(3); FB_VLD(7); FB_EXP(pa0, pa1, 7, wa1, wb1); FB_ENDGAP(wa1, wb1);
    s0.l = s0.l * alpha + (rs0 + rs1);
    if (!__all(alpha == 1.0f)) { s0.o0 = s0.o0 * alpha; s0.o1 = s0.o1 * alpha; }
    if (emask) { fa::mask_range(pb0, key0, hi, lo1, hi1); fa::mask_range(pb1, key0 + 32, hi, lo1, hi1); }
    const bf16x8 a0 = __builtin_bit_cast(bf16x8, wa0), a1 = __builtin_bit_cast(bf16x8, wa1), b0 = __builtin_bit_cast(bf16x8, wb0), b1 = __builtin_bit_cast(bf16x8, wb1);
    u32x4 xa0, xa1, xb0, xb1;
    FB_SBAR();
    { const int row_ = tid >> 3, ch_ = tid & 7; sg.k = *(const GAS v4u*)(Kbh + (size_t)(keyK + row_) * 64 + ch_ * 8); }
    FB_SBAR();
    s0.o0 = FB_MFMA(fv[0], a0, s0.o0); FB_MAX1(pb0, pb1); FB_SBAR();
    s0.o1 = FB_MFMA(fv[4], a0, s0.o1); FB_MAX2(s1, pb0, pb1, sel1); FB_SBAR();
    s0.o0 = FB_MFMA(fv[1], a1, s0.o0); FB_EXP(pb0, pb1, 0, xa0, xb0); FB_EXP(pb0, pb1, 1, xa0, xb0); FB_ENDGAP(xa0, xb0);
    s0.o1 = FB_MFMA(fv[5], a1, s0.o1); FB_EXP(pb0, pb1, 2, xa0, xb0); FB_ENDGAP(xa0, xb0);
    s0.o0 = FB_MFMA(fv[2], b0, s0.o0); FB_EXP(pb0, pb1, 3, xa0, xb0); FB_ENDGAP(xa0, xb0);
    s0.o1 = FB_MFMA(fv[6], b0, s0.o1); FB_EXP(pb0, pb1, 4, xa1, xb1); FB_EXP(pb0, pb1, 5, xa1, xb1); FB_ENDGAP(xa1, xb1);
    s0.o0 = FB_MFMA(fv[3], b1, s0.o0); FB_EXP(pb0, pb1, 6, xa1, xb1); FB_ENDGAP(xa1, xb1);
    s0.o1 = FB_MFMA(fv[7], b1, s0.o1); FB_EXP(pb0, pb1, 7, xa1, xb1); FB_ENDGAP(xa1, xb1);
    s1.l = s1.l * alpha + (rs0 + rs1);
    if (!__all(alpha == 1.0f)) { s1.o0 = s1.o0 * alpha; s1.o1 = s1.o1 * alpha; }
    { const bf16x8 c0 = __builtin_bit_cast(bf16x8, xa0), c1 = __builtin_bit_cast(bf16x8, xa1), e0 = __builtin_bit_cast(bf16x8, xb0), e1 = __builtin_bit_cast(bf16x8, xb1);
      const LAS unsigned char* kb = knext + fa::kap(r32) * PITCH + hi * 16;
#define FB_KLD(i) fk[i] = *(const LAS bf16x8*)(kb + ((i) >> 2) * 32 * PITCH + ((i) & 3) * 32)
      FB_SBAR();
      s1.o0 = FB_MFMA(fv[0], c0, s1.o0); FB_KLD(0); FB_KLD(4); FB_SBAR();
      s1.o1 = FB_MFMA(fv[4], c0, s1.o1); FB_KLD(1); FB_KLD(5); FB_SBAR();
      s1.o0 = FB_MFMA(fv[1], c1, s1.o0); FB_KLD(2); FB_KLD(6); FB_SBAR();
      s1.o1 = FB_MFMA(fv[5], c1, s1.o1); FB_KLD(3); FB_KLD(7); FB_SBAR();
      s1.o0 = FB_MFMA(fv[2], e0, s1.o0); qa[0] = *(const LAS bf16x8*)(qpark); qa[1] = *(const LAS bf16x8*)(qpark + 1024); FB_SBAR();
      s1.o1 = FB_MFMA(fv[6], e0, s1.o1); qa[2] = *(const LAS bf16x8*)(qpark + 2048); qa[3] = *(const LAS bf16x8*)(qpark + 3072); FB_SBAR();
      s1.o0 = FB_MFMA(fv[3], e1, s1.o0); s1.o1 = FB_MFMA(fv[7], e1, s1.o1); }
#undef FB_KLD
#undef FB_VLD
#undef FB_MAX1
#undef FB_MAX2
#undef FB_EXP
#undef FB_ENDGAP
}
__device__ __forceinline__ float finish(QState& st) { const float lt = fa::xsum(st.l); return lt > 0.f ? 1.0f / lt : 0.f; }
}

template <int MODE, int W>
__device__ __forceinline__ void attn64_unit(unsigned char* ws, LAS unsigned char* lds, int b, int hkv, int c, int tid, int wave, int lane, const bf16* Q, const bf16* K, const bf16* VT, bf16* OUT, const float* sinks) {
    const int r32 = lane & 31, hi = lane >> 5, head = hkv * 8 + wave, q0 = c * 64;
    const bf16* Kbh = K + (size_t)(b * 4 + hkv) * SEQ * 64; const bf16* Vbh = VT + (size_t)(b * 4 + hkv) * 64 * SEQ;
    fb::QState st[2]; unsigned long long selm[2] = {~0ull, ~0ull};
    constexpr int KR = 0, VR = 3 * fb::TILE, QP = (MODE == 0) ? 2 * fb::BUF : 5 * fb::TILE;
    LAS unsigned char* qpark = lds + QP + wave * 8192 + lane * 16;
#pragma unroll
    for (int g = 0; g < 2; ++g) { const size_t row = (size_t)b * SEQ + q0 + 32 * g + r32;
        { fa::bf16x8 qr[4]; fa::load_q(qr, Q + row * DM + head * 64, hi);
#pragma unroll
          for (int d0 = 0; d0 < 4; ++d0) *(LAS fa::bf16x8*)(qpark + (g * 4 + d0) * 1024) = qr[d0]; }
        st[g].o0 = fa::f32x16{}; st[g].o1 = fa::f32x16{};
        if (MODE == 0) { st[g].m = sinks[head] * LOG2E; st[g].l = hi == 0 ? 1.0f : 0.0f; } else { st[g].m = fa::NEGBIG; st[g].l = 0.f; }
        if (MODE == 2) { const unsigned long long sm = ((const unsigned long long*)(ws + WS_SELM))[(size_t)(b * 4 + hkv) * SEQ + q0 + 32 * g + r32];
            unsigned lo_ = (unsigned)sm, hi_ = (unsigned)(sm >> 32), lo2, hi2;
            asm volatile("v_mov_b32 %0, %2\n\tv_mov_b32 %1, %3" : "=&v"(lo2), "=&v"(hi2) : "v"(lo_), "v"(hi_));
            selm[g] = ((unsigned long long)hi2 << 32) | lo2; } }
    const int jlo = (MODE == 2) ? 0 : (c - W / 64 > 0 ? c - W / 64 : 0);
    fb::Stage sg;
    if (MODE != 0) {
        { fb::Stage s1; fb::stage_load2(sg, Kbh, Vbh, SEQ, jlo * 64, jlo * 64, tid); fb::stage_load2(s1, Kbh, Vbh, SEQ, (jlo < c ? jlo + 1 : c) * 64, jlo * 64, tid);
          fb::stage_store2(sg, lds + KR, lds + VR, tid); const int row = tid >> 3, ch = tid & 7; *(LAS v4u*)(lds + KR + fb::TILE + row * fb::PITCH + ch * 16) = s1.k; }
        LDS_WAIT(); __syncthreads();
        fa::bf16x8 fk[8], qa[4];
        fb::frag_load_k(fk, lds + KR, 0, r32, hi);
#pragma unroll
        for (int d0 = 0; d0 < 4; ++d0) qa[d0] = *(const LAS fa::bf16x8*)(qpark + d0 * 1024);
        int ks = 0;
        for (int j = jlo; j <= c; ++j) {
            const int t = j - jlo, ks1 = ks == 2 ? 0 : ks + 1, ks2 = ks1 == 2 ? 0 : ks1 + 1;
            const bool em = (j == c) || (MODE != 2 && j == c - W / 64);
            const int t0 = q0 + r32, t1 = t0 + 32;
            const bool sel0 = (MODE == 2) ? (bool)((selm[0] >> j) & 1ull) : true, sel1 = (MODE == 2) ? (bool)((selm[1] >> j) & 1ull) : true;
            fb::blk3(st[0], st[1], lds + VR + (t & 1) * fb::TILE, lds + KR + ks1 * fb::TILE, r32, qpark, j * 64, hi, sel0, sel1, em, (MODE == 2) ? 0 : t0 - W + 1, t0, (MODE == 2) ? 0 : t1 - W + 1, t1,
                     sg, (j + 2 < c ? j + 2 : c) * 64, (j + 1 < c ? j + 1 : c) * 64, Kbh, Vbh, tid, fk, qa);
            __builtin_amdgcn_sched_barrier(0);
            fb::stage_store2(sg, lds + KR + ks2 * fb::TILE, lds + VR + ((t + 1) & 1) * fb::TILE, tid);
            LDS_WAIT(); __syncthreads();
            ks = ks1;
        }
    } else {
    fb::stage_load(sg, Kbh, Vbh, SEQ, jlo * 64, tid); fb::stage_store(sg, lds, 0, tid);
    LDS_WAIT(); __syncthreads();
    for (int j = jlo; j <= c; ++j) {
        const int buf = (j - jlo) & 1;
        const bool em = (j == c) || (MODE != 2 && j == c - W / 64);
        if (MODE == 0) {
          if (j < c) fb::stage_load(sg, Kbh, Vbh, SEQ, (j + 1) * 64, tid);
#pragma unroll
          for (int g = 0; g < 2; ++g) { const int t = q0 + 32 * g + r32;
              fb::block_step(st[g], lds, buf, r32, qpark + g * 4096, j * 64, hi, true, em, t - W + 1, t);
              __builtin_amdgcn_sched_barrier(0); }
        } else { const int t0 = q0 + r32, t1 = t0 + 32;
          const bool sel0 = (MODE == 2) ? (bool)((selm[0] >> j) & 1ull) : true, sel1 = (MODE == 2) ? (bool)((selm[1] >> j) & 1ull) : true;
          fb::blk2(st[0], st[1], lds, buf, r32, qpark, j * 64, hi, sel0, sel1, em, (MODE == 2) ? 0 : t0 - W + 1, t0, (MODE == 2) ? 0 : t1 - W + 1, t1, sg, j < c, Kbh, Vbh, tid);
          __builtin_amdgcn_sched_barrier(0); }
        if (j < c) fb::stage_store(sg, lds, buf ^ 1, tid);
        LDS_WAIT(); __syncthreads();
    }
    }
#pragma unroll
    for (int g = 0; g < 2; ++g) { const size_t row = (size_t)b * SEQ + q0 + 32 * g + r32; const float inv = fb::finish(st[g]);
        if (MODE != 2) { fa::State so; so.o0 = st[g].o0; so.o1 = st[g].o1; fa::store_o(so, inv, OUT + row * DM + head * 64, hi); }
        else {
            const float* gates = (const float*)(ws + WS_GATES) + row * 96 + head * 3; const float g0 = gates[0], g1 = gates[1] * inv, g2 = gates[2];
            const bf16* oc = (const bf16*)(ws + WS_OCMP) + row * DM + head * 64; const bf16* ow = (const bf16*)(ws + WS_OWIN) + row * DM + head * 64; bf16* od = OUT + row * DM + head * 64;
#pragma unroll
            for (int gp = 0; gp < 2; ++gp)
#pragma unroll
                for (int db = 0; db < 2; ++db) { const int dcol = 32 * db + 16 * gp + 8 * hi; const v4u C = *(const GAS v4u*)(oc + dcol), Wv = *(const GAS v4u*)(ow + dcol);
                    const auto c0 = __builtin_amdgcn_permlane32_swap(C.x, C.z, false, false), c1 = __builtin_amdgcn_permlane32_swap(C.y, C.w, false, false);
                    const auto w0 = __builtin_amdgcn_permlane32_swap(Wv.x, Wv.z, false, false), w1 = __builtin_amdgcn_permlane32_swap(Wv.y, Wv.w, false, false);
                    const fa::f32x16& oo = db ? st[g].o1 : st[g].o0; unsigned px[2], py[2];
#pragma unroll
                    for (int e = 0; e < 2; ++e) { const int gg = 2 * gp + e; const unsigned cx = c0[e], cy = c1[e], wx = w0[e], wy = w1[e];
                        const float v0 = g0 * fa::bflo(cx) + g1 * oo[4 * gg] + g2 * fa::bflo(wx), v1 = g0 * fa::bfhi(cx) + g1 * oo[4 * gg + 1] + g2 * fa::bfhi(wx);
                        const float v2 = g0 * fa::bflo(cy) + g1 * oo[4 * gg + 2] + g2 * fa::bflo(wy), v3 = g0 * fa::bfhi(cy) + g1 * oo[4 * gg + 3] + g2 * fa::bfhi(wy);
                        px[e] = fa::cvtpk(v0, v1); py[e] = fa::cvtpk(v2, v3); }
                    const auto r0 = __builtin_amdgcn_permlane32_swap(px[0], px[1], false, false), r1 = __builtin_amdgcn_permlane32_swap(py[0], py[1], false, false);
                    v4u o; o.x = r0[0]; o.y = r1[0]; o.z = r0[1]; o.w = r1[1]; *(GAS v4u*)(od + dcol) = o; }
        }
    }
}
template <int MODE, int W>
__device__ __forceinline__ void phase_attn64(unsigned char* ws, LAS unsigned char* lds, int vcu, int tid, int wave, int lane, const bf16* Q, const bf16* K, const bf16* VT, bf16* OUT, const float* sinks) {
    const int bh = (vcu >> 5) & 7, x = vcu & 31;
#pragma unroll 1
    for (int i = 0; i < 2; ++i) attn64_unit<MODE, W>(ws, lds, bh >> 2, bh & 3, i ? 63 - x : x, tid, wave, lane, Q, K, VT, OUT, sinks);
}
__device__ __forceinline__ int mk_lane() { int l; asm volatile("v_mbcnt_lo_u32_b32 %0, -1, 0\n\tv_mbcnt_hi_u32_b32 %0, -1, %0" : "=v"(l)); return l; }
typedef const void* const __attribute__((address_space(4))) * karg_ptr_t;
__device__ __forceinline__ void load_in(In& I) {
    karg_ptr_t ap = (karg_ptr_t)__builtin_amdgcn_kernarg_segment_ptr(); asm volatile("" : "+s"(ap));
#define GP(T, k) ((const T*)(const GAS T*)(unsigned long long)ap[k])
    I.x = GP(float, 0); I.c = GP(float, 1); I.positions = GP(int, 2); I.w_ada = GP(float, 3); I.b_ada = GP(float, 4);
    I.swa_w_qkv = GP(float, 5); I.swa_b_qkv = GP(float, 6); I.swa_sinks = GP(float, 7); I.swa_w_o = GP(float, 8);
    I.nsa_w_in = GP(float, 9); I.nsa_pe_k = GP(float, 10); I.nsa_pe_v = GP(float, 11); I.nsa_phi_k1 = GP(float, 12); I.nsa_phi_k2 = GP(float, 13);
    I.nsa_phi_v1 = GP(float, 14); I.nsa_phi_v2 = GP(float, 15); I.nsa_w_o = GP(float, 16);
    I.moe_w_group = GP(float, 17); I.moe_b_group = GP(float, 18); I.moe_w_router = GP(float, 19); I.moe_b_router = GP(float, 20);
    I.moe_w1 = GP(float, 21); I.moe_w3 = GP(float, 22); I.moe_w2 = GP(float, 23);
    I.ln_t_g = GP(float, 24); I.ln_t_b = GP(float, 25); I.ln_c_g = GP(float, 26); I.ln_c_b = GP(float, 27);
#undef GP
}
struct Args { const void* in[28]; float* out; unsigned char* ws; int ph_lo, ph_hi, li, pad; };
__global__ void __launch_bounds__(NWAVES * 64, 2) hyb_fwd(Args args) {
    extern __shared__ __attribute__((aligned(16))) unsigned char lds_raw[];
    LAS unsigned char* lds = (LAS unsigned char*)lds_raw;
    volatile LAS unsigned* MISC = (volatile LAS unsigned*)(lds + MISC_OFF);
    const int wave_s = __builtin_amdgcn_readfirstlane((int)threadIdx.x >> 6);
#define MK_TID() (wave_s * 64 + mk_lane())
    const int G0 = gridDim.x, bx0 = blockIdx.x; const int vcu0 = (G0 % 8 == 0) ? (bx0 % 8) * (G0 / 8) + bx0 / 8 : bx0;
    unsigned char* const ws0 = args.ws; gu32* ctl = (gu32*)(ws0 + WS_CTL);
    for (int u = MK_TID(); u < (LDS_BYTES - LDSCTL_OFF) / 4; u += NWAVES * 64) ((LAS unsigned*)(lds + LDSCTL_OFF))[u] = 0u;
    __syncthreads();
    XcdBarrier bar; bar.bar = (unsigned*)(ctl + CW_BAR); bar.x = 0; bar.st = nullptr;
    if (N_LAUNCHES == 1) bar = xcd_barrier_post((unsigned*)(ctl + CW_BAR), MISC + 8, MK_TID());
#if MK_N_LAUNCHES == 1
    constexpr int lo = 0, hi = NPHASE;
#else
    const int lo = args.ph_lo, hi = args.ph_hi;
#endif
    float* const out0 = args.out;
    if (lo == 0) { In I; load_in(I); rope_table(I.positions, (float*)(ws0 + WS_ROPE), vcu0 * (NWAVES * 64) + MK_TID(), G0 * NWAVES * 64); }
#ifdef FULL_TWICE
#pragma unroll 1
    for (int pass_ = 0; pass_ < 2; ++pass_) {
    if (pass_) { if (bx0 == 0 && MK_TID() < 32) ctl[CW_CNT + MK_TID() * CW_CNT_STRIDE] = 0u; XcdBarrier b3 = bar; asm volatile("" : "+s"(b3.bar)); xcd_barrier(b3, MK_TID()); }
#endif
#pragma unroll 1
    for (int ph = lo; ph < hi; ++ph) {
        if (ph == 6 || ph == 12 || ph == 17 || ph == 19) continue;
#ifdef DOUBLE_MASK
        const int nrep = ((DOUBLE_MASK >> ph) & 1) ? 2 : 1;
#else
        const int nrep = 1;
#endif
#pragma unroll 1
        for (int rep = 0; rep < nrep; ++rep) {
        if (rep) __syncthreads();
        unsigned long long wsi = (unsigned long long)ws0, outi = (unsigned long long)out0; int G = G0, bx = bx0, vcu = vcu0; int phx = ph;
        asm volatile("" : "+s"(wsi), "+s"(G), "+s"(bx), "+s"(vcu), "+s"(outi), "+s"(phx));
        unsigned char* ws = (unsigned char*)(GAS unsigned char*)wsi; float* outp = (float*)(GAS float*)outi;
#ifdef ONLYP
        phx = ONLYP;
#endif
        const int wave = wave_s;
#if defined(FULL_TWICE) && defined(SKIP2_MASK)
        if (pass_ == 1 && ((SKIP2_MASK >> ph) & 1)) phx = 99;
#endif
#if defined(FULL_TWICE) && defined(ABLATE)
        const int ablate_ = pass_ == 1 ? ABLATE : 0;
#else
        const int ablate_ = 0;
#endif
        const int gw = vcu * NWAVES + wave, NGW = G * NWAVES;
        const int layer = phx >= 10 ? 1 : 0, cp = phx - (layer ? 15 : 4);
        switch (phx) {
        case 0: { const int tid = MK_TID(), lane = mk_lane(); (void)tid; (void)lane;
            In I; load_in(I); phase_mod_partial(I.c, I.w_ada, (float*)(ws + WS_MODP), (LAS float*)(lds + wave * 16384), gw, NGW, lane);
        } break;
        case 1: { const int tid = MK_TID(), lane = mk_lane(); (void)tid; (void)lane;
            In I; load_in(I); phase_prologue(I, ws, lds, tid, lane, wave, vcu, G);
        } break;
        case 2: { const int tid = MK_TID(), lane = mk_lane(); (void)tid; (void)lane;
            In I; load_in(I); pg8::Gemm g{(const bf16*)(ws + WS_H), (const bf16*)(ws + WS_WQKV), NTOK, 2560, DM}; pg8::StaticOrder S; S.init(NTOK, 2560, G, bx);
            pg8::EpiQKV E{(bf16*)(ws + WS_Q), (bf16*)(ws + WS_K0), (bf16*)(ws + WS_VT0), I.swa_b_qkv, (const float*)(ws + WS_ROPE), QSCALE};
            pg8::gemm_phase<pg8::EpiQKV, pg8::StaticOrder, true, true>(lds + RING_OFF, g, S, E, tid);
            conv_fill(I, ws, lds, 0, G, tid, wave, lane);
        } break;
        case 3: { const int tid = MK_TID(), lane = mk_lane(); (void)tid; (void)lane;
            In I; load_in(I); conv_drain(I, ws, lds, CV_A + 16 * 2 * 512, tid, wave, lane); phase_attn64<0, 128>(ws, lds, vcu, tid, wave, lane, (const bf16*)(ws + WS_Q), (const bf16*)(ws + WS_K0), (const bf16*)(ws + WS_VT0), (bf16*)(ws + WS_ATT), I.swa_sinks);
        } break;
        case 10: { const int tid = MK_TID(), lane = mk_lane(); (void)tid; (void)lane;
            In I; load_in(I); pg8::Gemm g{(const bf16*)(ws + WS_H), (const bf16*)(ws + WS_WIN), NTOK, 3840, DM}; pg8::StaticOrder S; S.init(NTOK, 3840, G, bx);
            pg8::EpiNSA E{(bf16*)(ws + WS_QRAW), (bf16*)(ws + WS_Q), (bf16*)(ws + WS_KC), (bf16*)(ws + WS_VC), (bf16*)(ws + WS_KS), (bf16*)(ws + WS_VST), (bf16*)(ws + WS_KW), (bf16*)(ws + WS_VWT), (float*)(ws + WS_GATES), (const float*)(ws + WS_ROPE), QSCALE, ablate_};
            pg8::gemm_phase<pg8::EpiNSA, pg8::StaticOrder, true, true>(lds + RING_OFF, g, S, E, tid);
            conv_fill(I, ws, lds, 3, G, tid, wave, lane);
        } break;
        case 11: { const int tid = MK_TID(), lane = mk_lane(); (void)tid; (void)lane;
#pragma unroll 1
            for (int which = 0; which < 2; ++which) {
                pg8::Gemm g{(const bf16*)(ws + (which ? WS_VC : WS_KC)), (const bf16*)(ws + (which ? WS_PHIV : WS_PHIK)), 2048, 512, 1024}; pg8::StaticOrderPub S; S.init(2048, 512, G, which ? (bx + G - 16) % G : bx); S.counter = (unsigned*)(ws + WS_CTL) + CW_UL; S.wave = wave;
                pg8::EpiF32 E{(float*)(ws + (which ? WS_ULV : WS_ULK)), 512, true};
                pg8::gemm_phase<pg8::EpiF32, pg8::StaticOrderPub, false, true>(lds + RING_OFF, g, S, E, tid); }
            phase_attn64<1, 512>(ws, lds, vcu, tid, wave, lane, (const bf16*)(ws + WS_Q), (const bf16*)(ws + WS_KW), (const bf16*)(ws + WS_VWT), (bf16*)(ws + WS_OWIN), nullptr);
            if (wave == 0) { const unsigned* ctl_ = (const unsigned*)(ws + WS_CTL); unsigned sp = 0u;
                while (ld_u32_agent(ctl_ + CW_UL) < 32u * NWAVES) { __builtin_amdgcn_s_sleep(2);
                    if ((++sp & 255u) == 0u) { if (ld_u32_agent(ctl_ + CW_TMO2) != 0u) break; if (sp > (1u << 20)) { __hip_atomic_store((unsigned*)(ws + WS_CTL) + CW_TMO2, 1u, __ATOMIC_RELAXED, __HIP_MEMORY_SCOPE_AGENT); break; } } }
                __builtin_amdgcn_fence(__ATOMIC_ACQUIRE, "agent"); asm volatile("s_waitcnt vmcnt(0)" ::: "memory"); }
            __syncthreads();
            { In I; load_in(I); conv_drain(I, ws, lds, CV_D - 16 * 512, tid, wave, lane);
              phase_cmp2(I, ws, lds, bx >= 32 ? (bx - 32) * NWAVES + wave : 1 << 20, (G - 32) * NWAVES, lane, tid, wave); }
        } break;
        case 12: { const int tid = MK_TID(), lane = mk_lane(); (void)tid; (void)lane;
        } break;
        case 13: { const int tid = MK_TID(), lane = mk_lane(); (void)tid; (void)lane;
            { const int bh = (vcu >> 5) & 7;
              const bf16* kc = (const bf16*)(ws + WS_KCMP) + (size_t)bh * 256 * 64;
              for (int i = tid; i < 256 * 8; i += NWAVES * 64) { const int r = i >> 3, ch = i & 7; *(LAS v4u*)(lds + CMP_K + r * 144 + ch * 16) = *(const GAS v4u*)(kc + (size_t)r * 64 + ch * 8); }
              const bf16* vc = (const bf16*)(ws + WS_VCMPT) + (size_t)bh * 64 * 256;
              for (int i = tid; i < 64 * 32; i += NWAVES * 64) { const int r = i >> 5, ch = i & 31; *(LAS v4u*)(lds + CMP_V + r * CMP_VP + ch * 16) = *(const GAS v4u*)(vc + (size_t)r * 256 + ch * 8); }
              LDS_WAIT(); __syncthreads(); }
            for (int u = vcu; u < 1024; u += G) { const int k_ = u >> 8, x_ = u & 31;
                cmp_unit(ws, lds, (u >> 7) & 1, (u >> 5) & 3, (k_ >> 1) * 64 + ((k_ & 1) ? 63 - x_ : x_), tid, wave, lane); }
        } break;
        case 14: { const int tid = MK_TID(), lane = mk_lane(); (void)tid; (void)lane;
            phase_attn64<2, 0>(ws, lds, vcu, tid, wave, lane, (const bf16*)(ws + WS_Q), (const bf16*)(ws + WS_KS), (const bf16*)(ws + WS_VST), (bf16*)(ws + WS_ATT), nullptr);
        } break;
        default: switch (cp) {
        case 0: { const int tid = MK_TID(), lane = mk_lane(); (void)tid; (void)lane;
            In I; load_in(I); pg8::Gemm g{(const bf16*)(ws + WS_ATT), (const bf16*)(ws + (layer ? WS_WO1 : WS_WO0)), NTOK, DM, DM}; pg8::StaticOrder S; S.init(NTOK, DM, G, bx);
            pg8::EpiWoRes E{layer ? nullptr : I.x, (const bf16*)(ws + WS_XB), (const float*)(ws + WS_MOD) + (size_t)layer * 2 * 12288 + 4096, 12288, (bf16*)(ws + WS_Y), ALPHA_RES};
            pg8::gemm_phase<pg8::EpiWoRes, pg8::StaticOrder, true, true>(lds + RING_OFF, g, S, E, tid);
        } break;
        case 1: { const int tid = MK_TID(), lane = mk_lane(); (void)tid; (void)lane;
            In I; load_in(I); phase_lnt2(I, ws, lds, (LAS int*)(lds + 131072 + 1024), layer, (const bf16*)(ws + WS_Y), gw, lane, tid, wave, vcu);
        } break;
        case 2: { const int tid = MK_TID(), lane = mk_lane(); (void)tid; (void)lane;
        } break;
        case 3: { const int tid = MK_TID(), lane = mk_lane(); (void)tid; (void)lane;
            if (layer == 0) {
                Seg sg; seg_load(sg, (const unsigned*)(ws + WS_CTL) + CW_CNT);
                pg8::Gemm g{(const bf16*)(ws + WS_H), (const bf16*)(ws + WS_W13), NTOK, 0, DM, (const int*)(ws + WS_ROWSRC)}; pg8::EpiUp E{(bf16*)(ws + WS_HE), false};
                pg8::GroupOrder S; build_units(S, sg, 4, G, bx);
                pg8::gemm_phase<pg8::EpiUp, pg8::GroupOrder, true, true, true>(lds + RING_OFF, g, S, E, tid);
                { In I; load_in(I); conv_fill(I, ws, lds, 1, G, tid, wave, lane); conv_drain(I, ws, lds, CV_B, tid, wave, lane); }
            } else {
                { Seg sg; seg_load(sg, (const unsigned*)(ws + WS_CTL) + CW_CNT + 16 * CW_CNT_STRIDE);
                  pg8::Gemm g{(const bf16*)(ws + WS_H), (const bf16*)(ws + WS_W13) + (size_t)16 * 1024 * 2048, NTOK, 0, DM, (const int*)(ws + WS_ROWSRC)}; pg8::EpiUp E{(bf16*)(ws + WS_HE), true};
                  pg8::GroupOrderPub S; build_units(S, sg, 4, G, bx); S.flags = (unsigned*)(ws + WS_CTL) + CW_MT; S.wave = wave;
                  pg8::gemm_phase<pg8::EpiUp, pg8::GroupOrderPub, true, true, true>(lds + RING_OFF, g, S, E, tid); }
                { unsigned char* ws2 = ws;
                  { In I; load_in(I); conv_drain(I, ws2, lds, CV_D, tid, wave, lane); }
                  if (wave == 0) {
                      const unsigned* ctl_ = (const unsigned*)(ws2 + WS_CTL); int nT = 0;
#pragma unroll
                      for (int e = 0; e < 16; ++e) nT += (int)((ld_u32_agent(ctl_ + CW_CNT + (16 + e) * CW_CNT_STRIDE) + 255u) >> 8);
                      const int base = bx < 32 ? 512 : 0, c_ = bx < 32 ? bx : bx - 32, g_ = bx < 32 ? 32 : 224, lim = bx < 32 ? 0x7fffffff : 512;
                      unsigned sp = 0u; bool give_up = false;
#pragma unroll 1
                      for (int i = 0; i < 6; ++i) { const int L = base + i * g_ + c_; if (give_up || L >= nT * 8 || L >= lim) continue;
                          const int pmc = ((L & 7) * nT + (L >> 3)) >> 3;
                          while (ld_u32_agent(ctl_ + CW_MT + 64 * pmc) < 4u || ld_u32_agent(ctl_ + CW_W2) < 16u * 512u) {
                              __builtin_amdgcn_s_sleep(2);
                              if ((++sp & 255u) == 0u) { if (ld_u32_agent(ctl_ + CW_TMO2) != 0u) { give_up = true; break; }
                                  if (sp > (1u << 20)) { __hip_atomic_store((unsigned*)(ws2 + WS_CTL) + CW_TMO2, 1u, __ATOMIC_RELAXED, __HIP_MEMORY_SCOPE_AGENT); give_up = true; break; } } } }
                      __builtin_amdgcn_fence(__ATOMIC_ACQUIRE, "agent"); asm volatile("s_waitcnt vmcnt(0)" ::: "memory"); }
                  __syncthreads(); }
                { unsigned char* ws3 = ws;
                  Seg sg; seg_load(sg, (const unsigned*)(ws3 + WS_CTL) + CW_CNT + 16 * CW_CNT_STRIDE);
                  pg8::GroupOrderSub S; build_units(S, sg, 8, 0, 0);
                  if (bx < 32) { S.base = 512; S.c = bx; S.G = 32; S.limit = 0x7fffffff; } else { S.base = 0; S.c = bx - 32; S.G = 224; S.limit = 512; }
                  pg8::Gemm g2{(const bf16*)(ws3 + WS_HE), (const bf16*)(ws3 + WS_W2) + (size_t)16 * 2048 * 512, 0, 0, DEXP}; pg8::EpiDown E2{(bf16*)(ws3 + WS_YS), (const int*)(ws3 + WS_ROWTOK), (const float*)(ws3 + WS_ROWW)};
                  pg8::gemm_phase<pg8::EpiDown, pg8::GroupOrderSub, true, true>(lds + RING_OFF, g2, S, E2, tid); }
            }
        } break;
        case 4: { const int tid = MK_TID(), lane = mk_lane(); (void)tid; (void)lane;
            Seg sg; seg_load(sg, (const unsigned*)(ws + WS_CTL) + CW_CNT + layer * 16 * CW_CNT_STRIDE); pg8::GroupOrder S; build_units(S, sg, 8, G, bx);
            pg8::Gemm g{(const bf16*)(ws + WS_HE), (const bf16*)(ws + WS_W2) + (size_t)layer * 16 * 2048 * 512, 0, 0, DEXP}; pg8::EpiDown E{(bf16*)(ws + WS_YS), (const int*)(ws + WS_ROWTOK), (const float*)(ws + WS_ROWW)};
            pg8::gemm_phase<pg8::EpiDown, pg8::GroupOrder, true, true>(lds + RING_OFF, g, S, E, tid);
            { In I; load_in(I); conv_fill(I, ws, lds, 2 + 3 * layer, G, tid, wave, lane); }
        } break;
        case 5: { const int tid = MK_TID(), lane = mk_lane(); (void)tid; (void)lane;
            In I; load_in(I); if (layer == 0) conv_drain(I, ws, lds, CV_C, tid, wave, lane);
            lnc_stage(I, ws, (LAS float*)lds, layer, vcu >> 7, tid);
            for (int rb = gw; rb < NTOK / 4; rb += NGW) phase_lnc(I, ws, layer, outp, (bf16*)(ws + WS_XB), layer == 0, rb, lane, (const LAS float*)lds);
        } break;
        default: break; }
        break; }
        }
        if (ph + 1 < hi) { XcdBarrier b2 = bar; asm volatile("" : "+s"(b2.bar)); xcd_barrier(b2, MK_TID()); }
    }
#ifdef FULL_TWICE
    }
#endif
}

extern "C" void kernel_launch(void* const* d_in, const int* in_sizes, int n_in, void* d_out, int out_size, void* d_ws, size_t ws_size, hipStream_t stream) {
    static int grid = 0;
    if (grid == 0) {
        if (n_in != 28 || in_sizes[0] != NTOK * DM || out_size != NTOK * DM || ws_size < WS_END) { fprintf(stderr, "kernel_launch: built for 28 inputs, x/out of %d floats, >= %zu bytes of workspace; got n_in %d, in0 %d, out %d, ws %zu; nothing launched\n", NTOK * DM, (size_t)WS_END, n_in, n_in > 0 ? in_sizes[0] : -1, out_size, ws_size); grid = -1; return; }
        int dev = 0, cus = 0, per_cu = 0;
        if (hipGetDevice(&dev) != hipSuccess || hipDeviceGetAttribute(&cus, hipDeviceAttributeMultiprocessorCount, dev) != hipSuccess) { fprintf(stderr, "kernel_launch: device query failed\n"); grid = -1; return; }
        if (hipFuncSetAttribute((const void*)hyb_fwd, hipFuncAttributeMaxDynamicSharedMemorySize, LDS_BYTES) != hipSuccess) { fprintf(stderr, "kernel_launch: hipFuncSetAttribute failed\n"); grid = -1; return; }
        if (hipOccupancyMaxActiveBlocksPerMultiprocessor(&per_cu, (const void*)hyb_fwd, NWAVES * 64, LDS_BYTES) != hipSuccess || per_cu < 1) { fprintf(stderr, "kernel_launch: occupancy query reports %d workgroups per CU\n", per_cu); }
        (void)hipGetLastError();
        grid = cus;
        if (grid != 256) { fprintf(stderr, "kernel_launch: %d CUs; this kernel is built for exactly 256 workgroups; nothing launched\n", grid); grid = -1; return; }
    }
    if (grid < 0) return;
    if (hipMemsetAsync((char*)d_ws + WS_CTL, 0, CTL_ZERO_BYTES, stream) != hipSuccess) { fprintf(stderr, "kernel_launch: memset failed\n"); return; }
    Args a{};
    for (int i = 0; i < 28; ++i) a.in[i] = d_in[i];
    a.out = (float*)d_out; a.ws = (unsigned char*)d_ws;
    for (int li = 0; li < N_LAUNCHES; ++li) {
        if (N_LAUNCHES == 1) { a.ph_lo = 0; a.ph_hi = NPHASE; } else { a.ph_lo = li; a.ph_hi = li + 1; }
        a.li = li;
        hipLaunchKernelGGL(hyb_fwd, dim3(grid), dim3(NWAVES * 64), LDS_BYTES, stream, a);
        const hipError_t le = hipPeekAtLastError();
        if (le != hipSuccess) { fprintf(stderr, "kernel_launch: launch %d failed: %s\n", li, hipGetErrorName(le)); break; }
    }
}
```
